# Optimizing an MI355X kernel written in HIP

```python
import jax
import jax.numpy as jnp
from jax import lax
import numpy as np

D_MODEL = 2048
BATCH = 4
SEQ = 4096
DEPTH = 2

HEAD_DIM = 64
N_MIX_HEADS = D_MODEL // HEAD_DIM
A_HEADS = 3 * N_MIX_HEADS // 8
B_GROUPS = N_MIX_HEADS // 4
C_HEADS = N_MIX_HEADS - A_HEADS - B_GROUPS
A_WIDTH = A_HEADS * HEAD_DIM
B_WIDTH = B_GROUPS * HEAD_DIM
C_WIDTH = C_HEADS * HEAD_DIM
D_MIX = A_WIDTH + B_WIDTH + C_WIDTH

DILATED_PATTERNS = ((128, 1), (512, 4), (2048, 16))
BLOCK = 128
REL_BUCKETS = 32
REL_MAX_DISTANCE = 2048

CHUNK = 128

W_LORA = 64
A_LORA = 64
G_LORA = 256
C_LORA = W_LORA + A_LORA + G_LORA
C_IN_COLS = 3 * C_WIDTH + C_LORA
RWKV_GN_EPS = 64e-5

MEM_TOKENS = 256
MEM_HEADS = 4
MEM_HEAD_DIM = 128
MEM_INNER = MEM_HEADS * MEM_HEAD_DIM

D_FF = 5632
CONV_WIDTH = 3

IN_COLS = 3 * A_WIDTH + 2 * B_WIDTH + C_IN_COLS
NORM_EPS = 1e-6
NEG_INF = -1e30

kernel_name = 'hybrid_dilated_sgu_rwkv7_block'


def rmsnorm(x, gain):
    xf = x.astype(jnp.float32)
    y = xf * lax.rsqrt(jnp.mean(xf * xf, axis=-1, keepdims=True) + NORM_EPS)
    return (y * gain.astype(jnp.float32)).astype(x.dtype)


def layernorm(x, gain):
    xf = x.astype(jnp.float32)
    xc = xf - jnp.mean(xf, axis=-1, keepdims=True)
    y = xc * lax.rsqrt(jnp.mean(xc * xc, axis=-1, keepdims=True) + NORM_EPS)
    return (y * gain.astype(jnp.float32)).astype(x.dtype)


def t5_causal_bucket(dist):
    max_exact = REL_BUCKETS // 2
    d = np.maximum(dist, 0)
    scaled = np.log(np.maximum(d, 1) / max_exact) / np.log(REL_MAX_DISTANCE / max_exact)
    large = np.minimum(max_exact + (scaled * (REL_BUCKETS - max_exact)).astype(np.int32), REL_BUCKETS - 1)
    return np.where(d < max_exact, d, large).astype(np.int32)


def dilated_pattern(q, k, v, rel_bias_table, window, dilation):
    b, s, h, dh = q.shape
    steps = window // dilation
    sub_len = s // dilation
    n_blk = -(-sub_len // BLOCK)
    pad = n_blk * BLOCK - sub_len

    def strided(z):
        z = z.reshape(b, sub_len, dilation, h, dh).transpose(0, 2, 3, 1, 4)
        z = jnp.pad(z, ((0, 0), (0, 0), (0, 0), (0, pad), (0, 0)))
        return z.reshape(b, dilation, h, n_blk, BLOCK, dh)

    def with_prev(z):
        prev = jnp.pad(z, ((0, 0), (0, 0), (0, 0), (1, 0), (0, 0), (0, 0)))[:, :, :, :-1]
        return jnp.concatenate([prev, z], axis=4)

    qb = strided(q)
    kw = with_prev(strided(k))
    vw = with_prev(strided(v))

    qi = np.arange(BLOCK)[:, None]
    kj = np.arange(2 * BLOCK)[None, :]
    delta = qi + BLOCK - kj
    band = (delta >= 0) & (delta <= steps)
    valid = np.where((np.arange(n_blk) == 0)[:, None, None], band & (kj >= BLOCK), band)
    bucket = t5_causal_bucket(np.clip(delta, 0, steps) * dilation)
    bias = jnp.transpose(rel_bias_table.astype(jnp.float32)[bucket], (2, 0, 1))

    scores = jnp.einsum('brhnqd,brhnkd->brhnqk', qb, kw).astype(jnp.float32) * (dh ** -0.5)
    scores = jnp.where(valid, scores + bias[None, None, :, None], NEG_INF)
    m = jnp.max(scores, axis=-1, keepdims=True)
    p = jnp.exp(scores - m)
    den = jnp.sum(p, axis=-1, keepdims=True)
    o = jnp.einsum('brhnqk,brhnkd->brhnqd', p, vw.astype(jnp.float32)) / den
    lse = (m + jnp.log(den))[..., 0]

    def unstrided(z):
        z = z.reshape(b, dilation, h, n_blk * BLOCK, *z.shape[5:])[:, :, :, :sub_len]
        z = jnp.moveaxis(z, 3, 1)
        return z.reshape(b, s, h, *z.shape[4:])

    return unstrided(o), unstrided(lse)


def dilated_attention(q, k, v, rel_bias_table):
    outs, lses = [], []
    for window, dilation in DILATED_PATTERNS:
        o, lse = dilated_pattern(q, k, v, rel_bias_table, window, dilation)
        outs.append(o)
        lses.append(lse)
    weights = jax.nn.softmax(jnp.stack(lses), axis=0)
    return jnp.sum(weights[..., None] * jnp.stack(outs), axis=0)


def spatial_gating(zb, norm_gain, w_s, b_s):
    b, s, _ = zb.shape
    u, g = jnp.split(jax.nn.gelu(zb), 2, axis=-1)
    g = layernorm(g, norm_gain).reshape(b, s // CHUNK, CHUNK, B_GROUPS, HEAD_DIM)
    w_causal = jnp.where(np.tril(np.ones((CHUNK, CHUNK), dtype=bool)), w_s, 0)
    mixed = jnp.einsum('gij,bcjgd->bcigd', w_causal, g) + b_s.T[None, None, :, :, None]
    return u * mixed.reshape(b, s, B_WIDTH)


def rwkv7_scan(r, decay, k, v, kk, a):
    b, s, h, n = r.shape

    def step(state, inp):
        r_t, w_t, k_t, v_t, kk_t, a_t = inp
        sa = jnp.einsum('bhvk,bhk->bhv', state, -kk_t)
        state = (state * w_t[:, :, None, :] + sa[..., None] * (kk_t * a_t)[:, :, None, :]
                 + v_t[..., None] * k_t[:, :, None, :])
        return state, jnp.einsum('bhvk,bhk->bhv', state, r_t)

    xs = tuple(jnp.moveaxis(z, 1, 0) for z in (r, decay, k, v, kk, a))
    _, ys = lax.scan(step, jnp.zeros((b, h, n, n), jnp.float32), xs)
    return jnp.moveaxis(ys, 0, 1)


def rwkv7_time_mix(zc, mu, w0, w_up, a0, a_up, g_up, k_k, k_a, r_k, ln_gain, ln_bias):
    b, s, _ = zc.shape
    zc = zc.astype(jnp.float32)
    prev = jnp.pad(zc, ((0, 0), (1, 0), (0, 0)))[:, :-1]
    zc = zc + (prev - zc) * mu
    cuts = [C_WIDTH, 2 * C_WIDTH, 3 * C_WIDTH, 3 * C_WIDTH + W_LORA, 3 * C_WIDTH + W_LORA + A_LORA]
    r, k, v, w_lo, a_lo, g_lo = jnp.split(zc, cuts, axis=-1)
    w_log = -jax.nn.softplus(-(w0 + jnp.tanh(w_lo) @ w_up)) - 0.5
    decay = jnp.exp(-jnp.exp(w_log))
    a = jax.nn.sigmoid(a0 + a_lo @ a_up)
    g = jax.nn.sigmoid(g_lo) @ g_up
    kk = k * k_k
    k = k * (1.0 + (a - 1.0) * k_a)

    def heads(z):
        return z.reshape(b, s, C_HEADS, HEAD_DIM)

    r, k, v, kk, a, decay = heads(r), heads(k), heads(v), heads(kk), heads(a), heads(decay)
    kk = kk / jnp.maximum(jnp.linalg.norm(kk, axis=-1, keepdims=True), 1e-12)
    y = rwkv7_scan(r, decay, k, v, kk, a)
    mean = jnp.mean(y, axis=-1, keepdims=True)
    yc = y - mean
    y = yc * lax.rsqrt(jnp.mean(yc * yc, axis=-1, keepdims=True) + RWKV_GN_EPS)
    y = y * ln_gain.reshape(C_HEADS, HEAD_DIM) + ln_bias.reshape(C_HEADS, HEAD_DIM)
    y = y + jnp.sum(r * k * r_k, axis=-1, keepdims=True) * v
    return y.reshape(b, s, C_WIDTH) * g


def hybrid_mixer(h, rel_bias_table, w_in, w_out, attn_out_gain, sgu_norm_gain, sgu_w, sgu_b,
                 sgu_out_gain, rwkv_mu, rwkv_w0, rwkv_w_up, rwkv_a0, rwkv_a_up, rwkv_g_up,
                 rwkv_k_k, rwkv_k_a, rwkv_r_k, rwkv_ln_gain, rwkv_ln_bias):
    b, s, _ = h.shape
    z = h @ w_in
    za, zb, zc = jnp.split(z, [3 * A_WIDTH, 3 * A_WIDTH + 2 * B_WIDTH], axis=-1)
    qkv = za.reshape(b, s, 3, A_HEADS, HEAD_DIM)
    oa = dilated_attention(qkv[:, :, 0], qkv[:, :, 1], qkv[:, :, 2], rel_bias_table)
    oa = rmsnorm(oa.reshape(b, s, A_WIDTH), attn_out_gain).astype(h.dtype)
    ob = rmsnorm(spatial_gating(zb, sgu_norm_gain, sgu_w, sgu_b), sgu_out_gain).astype(h.dtype)
    oc = rwkv7_time_mix(zc, rwkv_mu, rwkv_w0, rwkv_w_up, rwkv_a0, rwkv_a_up, rwkv_g_up,
                        rwkv_k_k, rwkv_k_a, rwkv_r_k, rwkv_ln_gain, rwkv_ln_bias).astype(h.dtype)
    return jnp.concatenate([oa, ob, oc], axis=-1) @ w_out


def memory_cross_attention(h, mem_n, wq, wkv, wo):
    b, s, _ = h.shape
    q = (h @ wq).reshape(b, s, MEM_HEADS, MEM_HEAD_DIM)
    kv = (mem_n @ wkv).reshape(b, mem_n.shape[1], 2, MEM_HEADS, MEM_HEAD_DIM)
    scores = jnp.einsum('bshd,bmhd->bhsm', q, kv[:, :, 0]).astype(jnp.float32) * (MEM_HEAD_DIM ** -0.5)
    p = jax.nn.softmax(scores, axis=-1).astype(h.dtype)
    o = jnp.einsum('bhsm,bmhd->bshd', p, kv[:, :, 1]).reshape(b, s, MEM_INNER)
    return o @ wo


def conv_ffn(h, w_up, conv_w, conv_b, w_down):
    s = h.shape[1]
    up = h @ w_up
    up_pad = jnp.pad(up, ((0, 0), (CONV_WIDTH - 1, 0), (0, 0)))
    conv = conv_b + sum(up_pad[:, j:j + s] * conv_w[j] for j in range(CONV_WIDTH))
    gate, val = jnp.split(conv, 2, axis=-1)
    return (jax.nn.gelu(gate, approximate=True) * val) @ w_down


def setup_inputs(seed: int = 0) -> dict:
    key = jax.random.key(seed)
    keys = jax.random.split(key, 40)
    counter = [0]

    def nxt():
        kk = keys[counter[0]]
        counter[0] += 1
        return kk

    def nrm(shape, scale=1.0):
        return scale * jax.random.normal(nxt(), shape, jnp.float32)

    def gain(shape):
        return 1.0 + nrm(shape, 0.1)

    L = DEPTH
    return {
        'x': nrm((BATCH, SEQ, D_MODEL)),
        'mem': nrm((BATCH, MEM_TOKENS, D_MODEL)),
        'rel_bias_table': nrm((REL_BUCKETS, A_HEADS), 0.5),
        'sandwich_gains': gain((L, 6, D_MODEL)),
        'mem_src_gain': gain((L, D_MODEL)),
        'w_in': nrm((L, D_MODEL, IN_COLS), D_MODEL ** -0.5),
        'w_out': nrm((L, D_MIX, D_MODEL), D_MIX ** -0.5),
        'attn_out_gain': gain((L, A_WIDTH)),
        'sgu_norm_gain': gain((L, B_WIDTH)),
        'sgu_w': nrm((L, B_GROUPS, CHUNK, CHUNK), CHUNK ** -0.5),
        'sgu_b': gain((L, B_GROUPS, CHUNK)),
        'sgu_out_gain': gain((L, B_WIDTH)),
        'rwkv_mu': jax.random.uniform(nxt(), (L, C_IN_COLS), jnp.float32),
        'rwkv_w0': nrm((L, C_WIDTH), 0.5),
        'rwkv_w_up': nrm((L, W_LORA, C_WIDTH), W_LORA ** -0.5),
        'rwkv_a0': nrm((L, C_WIDTH), 0.1),
        'rwkv_a_up': nrm((L, A_LORA, C_WIDTH), A_LORA ** -0.5),
        'rwkv_g_up': nrm((L, G_LORA, C_WIDTH), G_LORA ** -0.5),
        'rwkv_k_k': gain((L, C_WIDTH)),
        'rwkv_k_a': gain((L, C_WIDTH)),
        'rwkv_r_k': nrm((L, C_HEADS, HEAD_DIM), 0.1),
        'rwkv_ln_gain': gain((L, C_WIDTH)),
        'rwkv_ln_bias': nrm((L, C_WIDTH), 0.01),
        'mem_wq': nrm((L, D_MODEL, MEM_INNER), D_MODEL ** -0.5),
        'mem_wkv': nrm((L, D_MODEL, 2 * MEM_INNER), D_MODEL ** -0.5),
        'mem_wo': nrm((L, MEM_INNER, D_MODEL), MEM_INNER ** -0.5),
        'ffn_w_up': nrm((L, D_MODEL, 2 * D_FF), D_MODEL ** -0.5),
        'ffn_conv_w': nrm((L, CONV_WIDTH, 2 * D_FF), CONV_WIDTH ** -0.5),
        'ffn_conv_b': nrm((L, 2 * D_FF), 0.01),
        'ffn_w_down': nrm((L, D_FF, D_MODEL), D_FF ** -0.5),
    }


def reference(x, mem, rel_bias_table, sandwich_gains, mem_src_gain, w_in, w_out, attn_out_gain,
              sgu_norm_gain, sgu_w, sgu_b, sgu_out_gain, rwkv_mu, rwkv_w0, rwkv_w_up, rwkv_a0,
              rwkv_a_up, rwkv_g_up, rwkv_k_k, rwkv_k_a, rwkv_r_k, rwkv_ln_gain, rwkv_ln_bias,
              mem_wq, mem_wkv, mem_wo, ffn_w_up, ffn_conv_w, ffn_conv_b, ffn_w_down):
    for l in range(DEPTH):
        g = sandwich_gains[l]
        h = rmsnorm(x, g[0])
        y = hybrid_mixer(h, rel_bias_table, w_in[l], w_out[l], attn_out_gain[l], sgu_norm_gain[l],
                         sgu_w[l], sgu_b[l], sgu_out_gain[l], rwkv_mu[l], rwkv_w0[l], rwkv_w_up[l],
                         rwkv_a0[l], rwkv_a_up[l], rwkv_g_up[l], rwkv_k_k[l], rwkv_k_a[l], rwkv_r_k[l],
                         rwkv_ln_gain[l], rwkv_ln_bias[l])
        x = x + rmsnorm(y, g[1])
        h = rmsnorm(x, g[2])
        y = memory_cross_attention(h, rmsnorm(mem, mem_src_gain[l]), mem_wq[l], mem_wkv[l], mem_wo[l])
        x = x + rmsnorm(y, g[3])
        h = rmsnorm(x, g[4])
        y = conv_ffn(h, ffn_w_up[l], ffn_conv_w[l], ffn_conv_b[l], ffn_w_down[l])
        x = x + rmsnorm(y, g[5])
    return x
```

```cpp
#include <hip/hip_runtime.h>
#include <hip/hip_cooperative_groups.h>
#include <cstdio>
#include <cstdint>
namespace cg = cooperative_groups;
namespace pg8 {
#define PG8_LAS __attribute__((address_space(3)))
typedef unsigned short bf16_t;
typedef short bf16x8 __attribute__((ext_vector_type(8)));
typedef float f32x4 __attribute__((ext_vector_type(4)));
typedef unsigned u32x4 __attribute__((ext_vector_type(4)));
constexpr int BM = 256, BK = 64, HALF = 128, HTB = HALF * BK * 2  , STAGE_BYTES = 8 * HTB, NXCD = 8, WGM = 8;

__host__ __device__ __forceinline__ int lds_byte(int r, int c) { const int st = (r >> 4) * 2 + (c >> 5), rr = r & 15, cc = c & 31, ob = rr * 64 + cc * 2; return st * 1024 + (ob ^ (((ob >> 9) & 1) << 5)); }
__host__ __device__ __forceinline__ void stage_rc(int b, int& R, int& C) { const int st = b / 1024, sb = b % 1024, swz = sb ^ (((sb >> 9) & 1) << 5); R = (st >> 1) * 16 + swz / 64; C = (st & 1) * 32 + (swz % 64) / 2; }
__host__ __device__ __forceinline__ int perm32(int rho) { const int n = rho >> 4, i = rho & 15; return 8 * (i >> 2) + 4 * n + (i & 3); }

struct Unit { int pm, pn; };
struct Gemm { const bf16_t* A; const bf16_t* Bt; int M, N, K; };

struct StaticOrder {
    int nM, nN, nwg, G, c;
    __host__ __device__ void init(int M, int N, int G_, int c_) { nM = M / BM; nN = N / BM; nwg = nM * nN; G = G_; c = c_; }
    __host__ __device__ bool next(int i, Unit& u) const {
        const long L = (long)i * G + c; if (L >= nwg) return false;
        int wgid = (int)L; { const int q = nwg / NXCD, r = nwg % NXCD, xcd = wgid % NXCD, off = wgid / NXCD; wgid = (xcd < r ? xcd * (q + 1) : r * (q + 1) + (xcd - r) * q) + off; }
        const int nig = WGM * nN, gid = wgid / nig, fm = gid * WGM, gsz = (nM - fm) < WGM ? (nM - fm) : WGM;
        u.pm = fm + ((wgid % nig) % gsz); u.pn = (wgid % nig) / gsz; return true;
    }
    __device__ __forceinline__ void a_ready(const Unit&) const {}
    __device__ __forceinline__ void done(const Unit&) const {}
};
__device__ __forceinline__ unsigned cvt_pk_bf16(float lo, float hi) { unsigned r; asm volatile("v_cvt_pk_bf16_f32 %0, %1, %2" : "=v"(r) : "v"(lo), "v"(hi)); return r; }
struct EpiF32 {
    static constexpr bool PERM = false, AFTER_DRAIN = false;
    float* C; int ldc; const float* bias;
    __device__ __forceinline__ void operator()(const f32x4 (&acc)[2][2][4][2], const Unit& u, int wr, int wc, int fr, int fq) const {
        const int row0 = u.pm * BM + wr * 64 + fr, col0 = u.pn * BM + wc * 32 + 4 * fq;
        f32x4 bv[2][2];
#pragma unroll
        for (int bj = 0; bj < 2; ++bj)
#pragma unroll
            for (int n = 0; n < 2; ++n) bv[bj][n] = bias ? *(const f32x4*)(bias + col0 + bj * HALF + n * 16) : (f32x4){0.f, 0.f, 0.f, 0.f};
#pragma unroll
        for (int ai = 0; ai < 2; ++ai)
#pragma unroll
            for (int m = 0; m < 4; ++m) { float* rowp = C + (size_t)(row0 + ai * HALF + m * 16) * ldc + col0;
#pragma unroll
                for (int bj = 0; bj < 2; ++bj)
#pragma unroll
                    for (int n = 0; n < 2; ++n) *(f32x4*)(rowp + bj * HALF + n * 16) = acc[ai][bj][m][n] + bv[bj][n]; }
    }
};
struct EpiBf16 {
    static constexpr bool PERM = true, AFTER_DRAIN = false;
    bf16_t* O; int ldc;
    __device__ __forceinline__ void operator()(const f32x4 (&acc)[2][2][4][2], const Unit& u, int wr, int wc, int fr, int fq) const {
        const int row0 = u.pm * BM + wr * 64 + fr; const int col0 = u.pn * BM + wc * 32 + 8 * fq;
#pragma unroll
        for (int ai = 0; ai < 2; ++ai)
#pragma unroll
            for (int m = 0; m < 4; ++m) { bf16_t* rowp = O + (size_t)(row0 + ai * HALF + m * 16) * ldc + col0;
#pragma unroll
                for (int bj = 0; bj < 2; ++bj) { const f32x4 v0 = acc[ai][bj][m][0], v1 = acc[ai][bj][m][1];
                    u32x4 w; w.x = cvt_pk_bf16(v0[0], v0[1]); w.y = cvt_pk_bf16(v0[2], v0[3]); w.z = cvt_pk_bf16(v1[0], v1[1]); w.w = cvt_pk_bf16(v1[2], v1[3]);
                    *(u32x4*)(rowp + bj * HALF) = w; } }
    }
};
template <class Epi, class Sched, bool STAMP = false>
__device__ __forceinline__ void gemm_phase(const int tid_in, PG8_LAS unsigned char* lds, const Gemm g, const Sched& S, const Epi& E, unsigned long long* stamps) {
    const int tid = tid_in, wid = __builtin_amdgcn_readfirstlane(tid >> 6), lane = tid & 63, wr = wid >> 2, wc = wid & 3, fr = lane & 15, fq = lane >> 4;
    const int K = g.K, nt = K / BK;
    int ts_lo = 0, ts_hi = 0, nts = 0; const unsigned long long rt_entry = STAMP ? (unsigned long long)wall_clock64() : 0ull;
#define PG8_STAMP() do { if (STAMP && wid == 0 && nts < 64) { const unsigned long long _c = (unsigned long long)clock64(); \
        ts_lo = (lane == nts) ? (int)(unsigned)_c : ts_lo; ts_hi = (lane == nts) ? (int)(unsigned)(_c >> 32) : ts_hi; ++nts; } } while (0)
    PG8_STAMP();
    unsigned voffA[2], voffB[2];
#pragma unroll
    for (int i = 0; i < 2; ++i) { int R, C; stage_rc(tid * 16 + i * 8192, R, C); const int Rb = Epi::PERM ? ((R & ~31) + perm32(R & 31)) : R;
        voffA[i] = (unsigned)(R * K + C) * 2u; voffB[i] = (unsigned)(Rb * K + C) * 2u; }
    const size_t kstep = (size_t)(BK * 2);
    const size_t hstep = (size_t)HALF * K * 2;
    const size_t tstep = 2 * hstep;
    const unsigned ldsw = (unsigned)wid * 1024u;
    const int aoff = lds_byte(wr * 64 + fr, fq * 8), boff = lds_byte(wc * 32 + fr, fq * 8);
#define PG8_SA(b, h) (((b) * 2 + (h)) * HTB)
#define PG8_SB(b, h) ((4 + (b) * 2 + (h)) * HTB)
#define PG8_STAGE(bufoff, gbase, voff) do { _Pragma("unroll") for (int _i = 0; _i < 2; ++_i) \
        __builtin_amdgcn_global_load_lds((const unsigned*)((const char*)(gbase) + (voff)[_i]), (PG8_LAS unsigned*)(lds + (bufoff) + ldsw + _i * 8192), 16, 0, 0); } while (0)
#define PG8_LDA(dst, b, h) do { _Pragma("unroll") for (int m = 0; m < 4; ++m) _Pragma("unroll") for (int k = 0; k < 2; ++k) dst[m][k] = *(const PG8_LAS bf16x8*)(lds + PG8_SA(b, h) + aoff + m * 2048 + k * 1024); } while (0)
#define PG8_LDB(dst, b, h) do { _Pragma("unroll") for (int n = 0; n < 2; ++n) _Pragma("unroll") for (int k = 0; k < 2; ++k) dst[n][k] = *(const PG8_LAS bf16x8*)(lds + PG8_SB(b, h) + boff + n * 2048 + k * 1024); } while (0)
#define PG8_MMA(ai, bj, At, Bt) do { __builtin_amdgcn_s_setprio(1); _Pragma("unroll") for (int m = 0; m < 4; ++m) _Pragma("unroll") for (int n = 0; n < 2; ++n) _Pragma("unroll") for (int k = 0; k < 2; ++k) \
        acc[ai][bj][m][n] = __builtin_amdgcn_mfma_f32_16x16x32_bf16(Bt[n][k], At[m][k], acc[ai][bj][m][n], 0, 0, 0); __builtin_amdgcn_s_setprio(0); } while (0)
#define PG8_WAIT_V(n) asm volatile("s_waitcnt vmcnt(" #n ")" ::: "memory")
#define PG8_WAIT_L(n) asm volatile("s_waitcnt lgkmcnt(" #n ")" ::: "memory")
#define PG8_BAR __builtin_amdgcn_s_barrier()
#define PG8_SCHED __builtin_amdgcn_sched_barrier(0)
    Unit cur, nxt; int ui = 0;
    if (!S.next(0, cur)) return;
    f32x4 acc[2][2][4][2];
#pragma unroll
    for (int a = 0; a < 2; ++a)
#pragma unroll
        for (int b = 0; b < 2; ++b)
#pragma unroll
            for (int m = 0; m < 4; ++m)
#pragma unroll
                for (int n = 0; n < 2; ++n) acc[a][b][m][n] = (f32x4){0.f, 0.f, 0.f, 0.f};
    bf16x8 At[4][2], B0[2][2], B1[2][2];
    const char* cA = (const char*)g.A + (size_t)cur.pm * tstep; const char* cB = (const char*)g.Bt + (size_t)cur.pn * tstep;
    S.a_ready(cur);
    PG8_STAGE(PG8_SB(0, 0), cB, voffB); PG8_STAGE(PG8_SA(0, 0), cA, voffA); PG8_STAGE(PG8_SB(0, 1), cB + hstep, voffB); PG8_STAGE(PG8_SA(0, 1), cA + hstep, voffA);
    if (wr == 1) PG8_BAR;
    PG8_WAIT_V(4); PG8_BAR;
    PG8_STAGE(PG8_SB(1, 0), cB + kstep, voffB); PG8_STAGE(PG8_SA(1, 0), cA + kstep, voffA); PG8_STAGE(PG8_SB(1, 1), cB + hstep + kstep, voffB);
    PG8_WAIT_V(6); PG8_BAR;
    PG8_STAMP();
    for (;;) {
        const bool has_next = S.next(ui + 1, nxt);
        const char* nA = has_next ? (const char*)g.A + (size_t)nxt.pm * tstep : cA; const char* nB = has_next ? (const char*)g.Bt + (size_t)nxt.pn * tstep : cB;
        for (int t = 0; t < nt; t += 2) {
            const bool last = (t == nt - 2);
            const char* a1 = cA + (size_t)(t + 1) * kstep;
            const char* a2 = last ? nA : cA + (size_t)(t + 2) * kstep; const char* b2 = last ? nB : cB + (size_t)(t + 2) * kstep;
            const char* a3 = a2 + kstep; const char* b3 = b2 + kstep;
            if (last && has_next) S.a_ready(nxt);
            PG8_LDB(B0, 0, 0); PG8_SCHED; PG8_LDA(At, 0, 0); PG8_STAGE(PG8_SA(1, 1), a1 + hstep, voffA);
            PG8_WAIT_L(8); PG8_BAR; PG8_WAIT_L(0); PG8_MMA(0, 0, At, B0); PG8_BAR; PG8_SCHED;
            PG8_LDB(B1, 0, 1); PG8_STAGE(PG8_SB(0, 0), b2, voffB);
            PG8_BAR; PG8_WAIT_L(0); PG8_MMA(0, 1, At, B1); PG8_BAR;
            PG8_LDA(At, 0, 1); PG8_STAGE(PG8_SA(0, 0), a2, voffA);
            PG8_BAR; PG8_WAIT_L(0); PG8_MMA(1, 0, At, B0); PG8_BAR; PG8_SCHED;
            PG8_STAGE(PG8_SB(0, 1), b2 + hstep, voffB);
            PG8_WAIT_V(6); PG8_BAR; PG8_MMA(1, 1, At, B1); PG8_BAR;
            PG8_LDB(B0, 1, 0); PG8_SCHED; PG8_LDA(At, 1, 0); PG8_STAGE(PG8_SA(0, 1), a2 + hstep, voffA);
            PG8_WAIT_L(8); PG8_BAR; PG8_WAIT_L(0); PG8_MMA(0, 0, At, B0); PG8_BAR; PG8_SCHED;
            PG8_LDB(B1, 1, 1); PG8_STAGE(PG8_SB(1, 0), b3, voffB);
            PG8_BAR; PG8_WAIT_L(0); PG8_MMA(0, 1, At, B1); PG8_BAR;
            PG8_LDA(At, 1, 1); PG8_STAGE(PG8_SA(1, 0), a3, voffA);
            PG8_BAR; PG8_WAIT_L(0); PG8_MMA(1, 0, At, B0); PG8_BAR; PG8_SCHED;
            PG8_STAGE(PG8_SB(1, 1), b3 + hstep, voffB);
            PG8_WAIT_V(6); PG8_BAR; PG8_MMA(1, 1, At, B1); PG8_BAR;
        }
        PG8_STAMP();
        if constexpr (!Epi::AFTER_DRAIN) { E(acc, cur, wr, wc, fr, fq); S.done(cur); }
        PG8_STAMP();
        if (!has_next) break;
#pragma unroll
        for (int a = 0; a < 2; ++a)
#pragma unroll
            for (int b = 0; b < 2; ++b)
#pragma unroll
                for (int m = 0; m < 4; ++m)
#pragma unroll
                    for (int n = 0; n < 2; ++n) acc[a][b][m][n] = (f32x4){0.f, 0.f, 0.f, 0.f};
        cur = nxt; cA = nA; cB = nB; ++ui;
    }
    PG8_WAIT_V(0);
    if (wr == 0) PG8_BAR;
    PG8_BAR;
    if constexpr (Epi::AFTER_DRAIN) { E.fused(acc, cur, wr, wc, fr, fq, lds, wid, lane); S.done(cur); }
    PG8_STAMP();
    if (STAMP && wid == 0) { stamps[lane] = lane < nts ? (((unsigned long long)(unsigned)ts_hi << 32) | (unsigned)ts_lo) : 0ull;
        if (lane == 62) stamps[62] = rt_entry; if (lane == 63) stamps[63] = (unsigned long long)wall_clock64(); }
#undef PG8_STAMP
#undef PG8_SA
#undef PG8_SB
#undef PG8_STAGE
#undef PG8_LDA
#undef PG8_LDB
#undef PG8_MMA
#undef PG8_WAIT_V
#undef PG8_WAIT_L
#undef PG8_BAR
#undef PG8_SCHED
}
}
typedef unsigned short bf16_t;
typedef pg8::bf16x8 bf16x8;
typedef pg8::f32x4 f32x4;
typedef unsigned u32x2 __attribute__((ext_vector_type(2)));
typedef unsigned u32x4 __attribute__((ext_vector_type(4)));
typedef float f32x2 __attribute__((ext_vector_type(2)));
#define DI __device__ __forceinline__
#define LAS __attribute__((address_space(3)))

constexpr int T = 16384, DM = 2048, SEQ = 4096, NIN = 6016, NINP = 6144, DFF = 5632, NUP = 11264;
constexpr int NPL = 18;
constexpr int LDS_BYTES = 147456;
constexpr int SCAN_BLOCKS = 96;
constexpr size_t al256(size_t x) { return (x + 255) & ~(size_t)255; }
constexpr size_t OFF_WIN = 0;
constexpr size_t OFF_WOUT = OFF_WIN + (size_t)NINP * DM * 2;
constexpr size_t OFF_WQ = OFF_WOUT + (size_t)DM * DM * 2;
constexpr size_t OFF_WKV = OFF_WQ + (size_t)512 * DM * 2;
constexpr size_t OFF_WO = OFF_WKV + (size_t)1024 * DM * 2;
constexpr size_t OFF_WUP = OFF_WO + (size_t)DM * 512 * 2;
constexpr size_t OFF_WDN = OFF_WUP + (size_t)NUP * DM * 2;
constexpr size_t OFF_LW = OFF_WDN + (size_t)DM * DFF * 2;
constexpr size_t OFF_LA = OFF_LW + (size_t)768 * 64 * 2;
constexpr size_t OFF_LG = OFF_LA + (size_t)768 * 64 * 2;
constexpr size_t OFF_WS = OFF_LG + (size_t)768 * 256 * 2;
constexpr size_t OFF_BT = OFF_WS + (size_t)8 * 128 * 128 * 2;
constexpr size_t OFF_MEMN = al256(OFF_BT + 3 * 12 * 132 * 4);
constexpr size_t OFF_HB = OFF_MEMN + (size_t)1024 * DM * 2;
constexpr size_t OFF_R = OFF_HB + (size_t)T * DM * 2;
constexpr size_t OFF_Z = OFF_R;
constexpr size_t OFF_AP = OFF_Z + (size_t)T * NINP * 2;
constexpr size_t OFF_LSE = OFF_AP + (size_t)3 * T * 768 * 2;
constexpr size_t OFF_RWA = OFF_LSE + (size_t)3 * T * 12 * 4;
constexpr size_t OFF_RWD = OFF_RWA + (size_t)T * 768 * 4;
constexpr size_t OFF_RWG = OFF_RWD + (size_t)T * 768 * 4;
constexpr size_t OFF_YR = OFF_RWG + (size_t)T * 768 * 2;
constexpr size_t OFF_BON = OFF_YR + (size_t)T * 768 * 4;
constexpr size_t OFF_MIX = OFF_BON + (size_t)T * 12 * 4;
constexpr size_t OFF_END1 = OFF_MIX + (size_t)T * DM * 2;
constexpr size_t OFF_Y = OFF_R;
constexpr size_t OFF_Q = OFF_Y + (size_t)T * DM * 4;
constexpr size_t OFF_O = OFF_Q + (size_t)T * 512 * 2;
constexpr size_t OFF_KV = OFF_O + (size_t)T * 512 * 2;
constexpr size_t OFF_UP = OFF_Y + (size_t)T * DM * 4;
constexpr size_t OFF_ACT = OFF_UP + (size_t)8192 * NUP * 2;
constexpr size_t OFF_END2 = OFF_ACT + (size_t)8192 * DFF * 2;
constexpr size_t WS_NEED = OFF_END1 > OFF_END2 ? OFF_END1 : OFF_END2;
static_assert(OFF_Y + (size_t)T * DM * 4 <= OFF_MIX, "Y must not overlap MIX");

struct Params { const float* in[30]; float* out; unsigned char* ws; };
struct InArr { const Params* pp; size_t zero; DI const float* operator[](int i) const { return pp->in[i] + zero; } };
struct PView { InArr in; float* out; unsigned char* ws; };

DI float bf2f(unsigned b) { return __uint_as_float(b << 16); }
DI float bflo(unsigned w) { return __uint_as_float(w << 16); }
DI float bfhi(unsigned w) { return __uint_as_float(w & 0xffff0000u); }
typedef __bf16 bf16x2_t __attribute__((ext_vector_type(2)));
DI unsigned pack2(float lo, float hi) { const f32x2 v = {lo, hi}; const bf16x2_t r = __builtin_convertvector(v, bf16x2_t); return __builtin_bit_cast(unsigned, r); }
DI bf16_t f2bf(float f) { return (bf16_t)(pack2(f, 0.f) & 0xffffu); }
DI float wsum(float v) {
#pragma unroll
    for (int o = 32; o >= 1; o >>= 1) v += __shfl_xor(v, o);
    return v; }
template <int C> DI float dppf(float x) { return __int_as_float(__builtin_amdgcn_update_dpp(0, __float_as_int(x), C, 0xF, 0xF, true)); }
DI float rsum16(float x) { x += dppf<0xB1>(x); x += dppf<0x4E>(x); x += dppf<0x141>(x); x += dppf<0x140>(x); return x; }
DI float gelu_t(float x) { const float u = 0.7978845608028654f * (x + 0.044715f * x * x * x); return x / (1.0f + __expf(-2.0f * u)); }
DI float sigm(float x) { return 1.0f / (1.0f + __expf(-x)); }
DI void unpack8(const uint4 w, float (&f)[8]) { f[0] = bflo(w.x); f[1] = bfhi(w.x); f[2] = bflo(w.y); f[3] = bfhi(w.y); f[4] = bflo(w.z); f[5] = bfhi(w.z); f[6] = bflo(w.w); f[7] = bfhi(w.w); }
DI uint4 pack8(const float (&f)[8]) { uint4 w; w.x = pack2(f[0], f[1]); w.y = pack2(f[2], f[3]); w.z = pack2(f[4], f[5]); w.w = pack2(f[6], f[7]); return w; }

DI void cvt_job(const int ctx_tid, const int ctx_bid, const int ctx_g, const float* W, bf16_t* Bt, int K, int N, int Npad, int mode, int& tile_base, LAS float* tile) {
    const int tk = K / 64, tn = Npad / 64, nt = tk * tn, G = ctx_g, tid = ctx_tid;
    int first = ((int)ctx_bid - (tile_base % G) + G) % G;
    for (int ti = first; ti < nt; ti += G) {
        const int ik = ti % tk, in_ = ti / tk, n0 = in_ * 64, k0 = ik * 64;
        int src = n0; bool valid = n0 < N;
        if (mode == 1) { const int pn = n0 / 256, bj = (n0 % 256) / 128, off = n0 % 128; src = bj * DFF + pn * 128 + off; valid = true; }
        if (valid) {
            const int r = tid >> 4, c4 = (tid & 15) * 4;
#pragma unroll
            for (int h = 0; h < 2; ++h) { const float4 v = *(const float4*)(W + (size_t)(k0 + r + 32 * h) * N + src + c4);
                LAS float* d = tile + (r + 32 * h) * 65 + c4; d[0] = v.x; d[1] = v.y; d[2] = v.z; d[3] = v.w; }
        }
        __syncthreads();
        { const int n = tid >> 3, ks = tid & 7; float f[8];
#pragma unroll
          for (int j = 0; j < 8; ++j) f[j] = valid ? tile[(ks * 8 + j) * 65 + n] : 0.f;
          *(uint4*)(Bt + (size_t)(n0 + n) * K + k0 + ks * 8) = pack8(f); }
        __syncthreads();
    }
    tile_base += nt;
}
DI void rmsnorm_rows_bf16(const int ctx_tid, const int ctx_bid, const int ctx_g, const float* X, const float* gain, bf16_t* O, int rows) {
    const int lane = ctx_tid & 63, gw = ctx_bid * 8 + (ctx_tid >> 6), nw = ctx_g * 8;
    for (int r = gw; r < rows; r += nw) {
        const float* x = X + (size_t)r * DM; float4 v[8]; float ss = 0.f;
#pragma unroll
        for (int i = 0; i < 8; ++i) { v[i] = *(const float4*)(x + (i * 64 + lane) * 4); ss += v[i].x * v[i].x + v[i].y * v[i].y + v[i].z * v[i].z + v[i].w * v[i].w; }
        const float rs = rsqrtf(wsum(ss) * (1.0f / DM) + 1e-6f);
#pragma unroll
        for (int i = 0; i < 8; ++i) { const float4 g = *(const float4*)(gain + (i * 64 + lane) * 4); uint2 w; w.x = pack2(v[i].x * rs * g.x, v[i].y * rs * g.y); w.y = pack2(v[i].z * rs * g.z, v[i].w * rs * g.w);
            *(uint2*)(O + (size_t)r * DM + (i * 64 + lane) * 4) = w; }
    }
}
DI int t5_bucket(int dist) {
    if (dist < 16) return dist;
    const double scaled = log((double)dist / 16.0) / log(2048.0 / 16.0);
    int large = 16 + (int)(scaled * 16.0); return large < 31 ? large : 31;
}
DI void phase_cvt(const int ctx_tid, const int ctx_bid, const int ctx_g, const PView& p, int l, LAS unsigned char* lds) {
#ifdef NO_CVT
    return;
#endif
    unsigned char* ws = p.ws; LAS float* tile = (LAS float*)lds; int tb = 0;
    cvt_job(ctx_tid, ctx_bid, ctx_g, p.in[5] + (size_t)l * DM * NIN, (bf16_t*)(ws + OFF_WIN), DM, NIN, NINP, 0, tb, tile);
    cvt_job(ctx_tid, ctx_bid, ctx_g, p.in[26] + (size_t)l * DM * NUP, (bf16_t*)(ws + OFF_WUP), DM, NUP, NUP, 1, tb, tile);
    cvt_job(ctx_tid, ctx_bid, ctx_g, p.in[29] + (size_t)l * DFF * DM, (bf16_t*)(ws + OFF_WDN), DFF, DM, DM, 0, tb, tile);
    cvt_job(ctx_tid, ctx_bid, ctx_g, p.in[6] + (size_t)l * DM * DM, (bf16_t*)(ws + OFF_WOUT), DM, DM, DM, 0, tb, tile);
    cvt_job(ctx_tid, ctx_bid, ctx_g, p.in[23] + (size_t)l * DM * 512, (bf16_t*)(ws + OFF_WQ), DM, 512, 512, 0, tb, tile);
    cvt_job(ctx_tid, ctx_bid, ctx_g, p.in[24] + (size_t)l * DM * 1024, (bf16_t*)(ws + OFF_WKV), DM, 1024, 1024, 0, tb, tile);
    cvt_job(ctx_tid, ctx_bid, ctx_g, p.in[25] + (size_t)l * 512 * DM, (bf16_t*)(ws + OFF_WO), 512, DM, DM, 0, tb, tile);
    cvt_job(ctx_tid, ctx_bid, ctx_g, p.in[14] + (size_t)l * 64 * 768, (bf16_t*)(ws + OFF_LW), 64, 768, 768, 0, tb, tile);
    cvt_job(ctx_tid, ctx_bid, ctx_g, p.in[16] + (size_t)l * 64 * 768, (bf16_t*)(ws + OFF_LA), 64, 768, 768, 0, tb, tile);
    cvt_job(ctx_tid, ctx_bid, ctx_g, p.in[17] + (size_t)l * 256 * 768, (bf16_t*)(ws + OFF_LG), 256, 768, 768, 0, tb, tile);
    const int gt = ctx_bid * 512 + ctx_tid, ng = ctx_g * 512;
    { const float* sw = p.in[9] + (size_t)l * 8 * 128 * 128; bf16_t* o = (bf16_t*)(ws + OFF_WS);
      for (int i = gt; i < 8 * 128 * 128; i += ng) { const int jj = i & 127, ii = (i >> 7) & 127; o[i] = f2bf(jj <= ii ? sw[i] : 0.f); } }
    if (l == 0) { float* bt = (float*)(ws + OFF_BT);
      for (int i = gt; i < 3 * 12 * 129; i += ng) { const int delta = i % 129, h = (i / 129) % 12, pp = i / (129 * 12); const int d = pp == 0 ? 1 : (pp == 1 ? 4 : 16);
        bt[(pp * 12 + h) * 132 + delta] = p.in[2][t5_bucket(delta * d) * 12 + h]; } }
    rmsnorm_rows_bf16(ctx_tid, ctx_bid, ctx_g, p.in[1], p.in[4] + (size_t)l * DM, (bf16_t*)(ws + OFF_MEMN), 1024);
    if (l == 0) rmsnorm_rows_bf16(ctx_tid, ctx_bid, ctx_g, p.in[0], p.in[3], (bf16_t*)(ws + OFF_HB), T);
}

DI void phase_resid(const int ctx_tid, const int ctx_bid, const int ctx_g, const float* Y, const float* xi, float* xo, const float* ga, const float* gb, bf16_t* HB) {
#ifdef NO_RESID
    return;
#endif
    const int lane = ctx_tid & 63, gw = ctx_bid * 8 + (ctx_tid >> 6), nw = ctx_g * 8;
    for (int r = gw; r < T; r += nw) {
        float4 xv[8]; float ss = 0.f;
#pragma unroll
        for (int i = 0; i < 8; ++i) { const float4 y = *(const float4*)(Y + (size_t)r * DM + (i * 64 + lane) * 4); xv[i] = y; ss += y.x * y.x + y.y * y.y + y.z * y.z + y.w * y.w; }
        const float rs = rsqrtf(wsum(ss) * (1.0f / DM) + 1e-6f); float s2 = 0.f;
#pragma unroll
        for (int i = 0; i < 8; ++i) { const int c = (i * 64 + lane) * 4; const float4 g = *(const float4*)(ga + c); const float4 x = *(const float4*)(xi + (size_t)r * DM + c);
            float4 o; o.x = x.x + xv[i].x * rs * g.x; o.y = x.y + xv[i].y * rs * g.y; o.z = x.z + xv[i].z * rs * g.z; o.w = x.w + xv[i].w * rs * g.w;
            *(float4*)(xo + (size_t)r * DM + c) = o; xv[i] = o; s2 += o.x * o.x + o.y * o.y + o.z * o.z + o.w * o.w; }
        if (gb) { const float r2 = rsqrtf(wsum(s2) * (1.0f / DM) + 1e-6f);
#pragma unroll
            for (int i = 0; i < 8; ++i) { const int c = (i * 64 + lane) * 4; const float4 g = *(const float4*)(gb + c); uint2 w; w.x = pack2(xv[i].x * r2 * g.x, xv[i].y * r2 * g.y); w.y = pack2(xv[i].z * r2 * g.z, xv[i].w * r2 * g.w);
                *(uint2*)(HB + (size_t)r * DM + c) = w; } }
    }
}

DI void phase_rwkv_prep(const int ctx_tid, const int ctx_bid, const int ctx_g, const PView& p, int l, LAS unsigned char* lds) {
#ifdef NO_PREP
    return;
#endif
    unsigned char* ws = p.ws; const bf16_t* Z = (const bf16_t*)(ws + OFF_Z);
    const float* mu = p.in[12] + (size_t)l * 2688 + 2304; const float* w0 = p.in[13] + (size_t)l * 768; const float* a0 = p.in[15] + (size_t)l * 768;
    const bf16_t* LW = (const bf16_t*)(ws + OFF_LW); const bf16_t* LA = (const bf16_t*)(ws + OFF_LA); const bf16_t* LG = (const bf16_t*)(ws + OFF_LG);
    float* RWA = (float*)(ws + OFF_RWA); float* RWD = (float*)(ws + OFF_RWD); bf16_t* RWG = (bf16_t*)(ws + OFF_RWG);
    const int tid = ctx_tid, lane = tid & 63, w = tid >> 6, fr = lane & 15, fq = lane >> 4;
    constexpr int AST = 392;
    LAS bf16_t* A = (LAS bf16_t*)lds;
    for (int item = ctx_bid; item < T / 16; item += ctx_g) {
        { const int row = tid >> 5, cs = (tid & 31) * 12; const int t = item * 16 + row; const bool hasp = (t % SEQ) != 0;
          const bf16_t* zr = Z + (size_t)t * NINP + 5632 + cs;
#pragma unroll
          for (int q = 0; q < 3; ++q) { const uint2 cur = *(const uint2*)(zr + q * 4); uint2 prv = make_uint2(0u, 0u); if (hasp) prv = *(const uint2*)(zr - NINP + q * 4);
            float c4[4] = {bflo(cur.x), bfhi(cur.x), bflo(cur.y), bfhi(cur.y)}, p4[4] = {bflo(prv.x), bfhi(prv.x), bflo(prv.y), bfhi(prv.y)};
#pragma unroll
            for (int e = 0; e < 4; ++e) { const int c = cs + q * 4 + e; float v = c4[e] + (p4[e] - c4[e]) * mu[c];
                if (c < 64) v = tanhf(v); else if (c >= 128) v = sigm(v);
                A[row * AST + c] = f2bf(v); } } }
        __syncthreads();
        const int t0 = item * 16;
#pragma unroll 1
        for (int nt = 0; nt < 6; ++nt) {
            const int n0 = w * 96 + nt * 16, c = n0 + fr;
            { f32x4 acc = {0.f, 0.f, 0.f, 0.f};
#pragma unroll
              for (int ks = 0; ks < 2; ++ks) { const bf16x8 a = *(const LAS bf16x8*)(A + fr * AST + ks * 32 + fq * 8); const bf16x8 b = *(const bf16x8*)(LW + (size_t)(n0 + fr) * 64 + ks * 32 + fq * 8);
                  acc = __builtin_amdgcn_mfma_f32_16x16x32_bf16(a, b, acc, 0, 0, 0); }
              const float wz = w0[c];
#pragma unroll
              for (int j = 0; j < 4; ++j) { const float u = wz + acc[j]; const float nu = -u; const float sp = fmaxf(nu, 0.f) + log1pf(__expf(-fabsf(nu))); const float wl = -sp - 0.5f;
                  RWD[(size_t)(t0 + fq * 4 + j) * 768 + c] = __expf(-__expf(wl)); } }
            { f32x4 acc = {0.f, 0.f, 0.f, 0.f};
#pragma unroll
              for (int ks = 0; ks < 2; ++ks) { const bf16x8 a = *(const LAS bf16x8*)(A + fr * AST + 64 + ks * 32 + fq * 8); const bf16x8 b = *(const bf16x8*)(LA + (size_t)(n0 + fr) * 64 + ks * 32 + fq * 8);
                  acc = __builtin_amdgcn_mfma_f32_16x16x32_bf16(a, b, acc, 0, 0, 0); }
              const float az = a0[c];
#pragma unroll
              for (int j = 0; j < 4; ++j) RWA[(size_t)(t0 + fq * 4 + j) * 768 + c] = sigm(az + acc[j]); }
            { f32x4 acc = {0.f, 0.f, 0.f, 0.f};
#pragma unroll
              for (int ks = 0; ks < 8; ++ks) { const bf16x8 a = *(const LAS bf16x8*)(A + fr * AST + 128 + ks * 32 + fq * 8); const bf16x8 b = *(const bf16x8*)(LG + (size_t)(n0 + fr) * 256 + ks * 32 + fq * 8);
                  acc = __builtin_amdgcn_mfma_f32_16x16x32_bf16(a, b, acc, 0, 0, 0); }
#pragma unroll
              for (int j = 0; j < 4; ++j) RWG[(size_t)(t0 + fq * 4 + j) * 768 + c] = f2bf(acc[j]); }
        }
        __syncthreads();
    }
}

template <int DH, int NSTEP, bool MASK>
DI void attn_wave(const int ctx_tid, const int ctx_bid, const int ctx_g, const LAS unsigned char* Kl, int KS, const LAS unsigned char* Vl, int VS, const bf16_t* qrow, int step0, float scale,
                  int qi, bool first_block, const LAS float* btab, bf16_t* orow, float* lse_out) {
    const int lane = ctx_tid & 63, fr = lane & 15, fq = lane >> 4;
    bf16x8 qf[DH / 32];
#pragma unroll
    for (int ks = 0; ks < DH / 32; ++ks) qf[ks] = *(const bf16x8*)(qrow + ks * 32 + fq * 8);
    f32x4 s[NSTEP][2];
#pragma unroll
    for (int st = 0; st < NSTEP; ++st)
#pragma unroll
        for (int hf = 0; hf < 2; ++hf) {
            const int key0 = (step0 + st) * 32 + hf * 16; f32x4 acc = {0.f, 0.f, 0.f, 0.f};
#pragma unroll
            for (int ks = 0; ks < DH / 32; ++ks) { const bf16x8 kf = *(const LAS bf16x8*)(Kl + (key0 + fr) * KS + (ks * 32 + fq * 8) * 2);
                acc = __builtin_amdgcn_mfma_f32_16x16x32_bf16(kf, qf[ks], acc, 0, 0, 0); }
            s[st][hf] = acc;
        }
    float m = -3.0e38f;
#pragma unroll
    for (int st = 0; st < NSTEP; ++st)
#pragma unroll
        for (int hf = 0; hf < 2; ++hf)
#pragma unroll
            for (int j = 0; j < 4; ++j) {
                float v = s[st][hf][j] * scale;
                if (MASK) { const int kj = (step0 + st) * 32 + hf * 16 + fq * 4 + j; const int delta = qi + 128 - kj;
                    const bool valid = (delta >= 0) && (delta <= 128) && (!first_block || kj >= 128);
                    const int dc = delta < 0 ? 0 : (delta > 128 ? 128 : delta);
                    v = valid ? v + btab[dc] : -1e30f; }
                s[st][hf][j] = v; m = fmaxf(m, v);
            }
    m = fmaxf(m, __shfl_xor(m, 16)); m = fmaxf(m, __shfl_xor(m, 32));
    float den = 0.f;
#pragma unroll
    for (int st = 0; st < NSTEP; ++st)
#pragma unroll
        for (int hf = 0; hf < 2; ++hf)
#pragma unroll
            for (int j = 0; j < 4; ++j) { const float e = __expf(s[st][hf][j] - m); s[st][hf][j] = e; den += e; }
    den += __shfl_xor(den, 16); den += __shfl_xor(den, 32);
    f32x4 o[DH / 16];
#pragma unroll
    for (int dt = 0; dt < DH / 16; ++dt) o[dt] = (f32x4){0.f, 0.f, 0.f, 0.f};
#pragma unroll
    for (int st = 0; st < NSTEP; ++st) {
        uint4 pw; pw.x = pack2(s[st][0][0], s[st][0][1]); pw.y = pack2(s[st][0][2], s[st][0][3]); pw.z = pack2(s[st][1][0], s[st][1][1]); pw.w = pack2(s[st][1][2], s[st][1][3]);
        const bf16x8 pf = __builtin_bit_cast(bf16x8, pw);
        const int kb = (step0 + st) * 32;
#pragma unroll
        for (int dt = 0; dt < DH / 16; ++dt) {
            const LAS unsigned char* vr = Vl + (dt * 16 + fr) * VS + (kb + fq * 4) * 2;
            const u32x2 v0 = *(const LAS u32x2*)vr; const u32x2 v1 = *(const LAS u32x2*)(vr + 32);
            u32x4 vw; vw.x = v0.x; vw.y = v0.y; vw.z = v1.x; vw.w = v1.y;
            o[dt] = __builtin_amdgcn_mfma_f32_16x16x32_bf16(__builtin_bit_cast(bf16x8, vw), pf, o[dt], 0, 0, 0);
        }
    }
    const float inv = 1.0f / den;
#pragma unroll
    for (int dt = 0; dt < DH / 16; ++dt) { uint2 w; w.x = pack2(o[dt][0] * inv, o[dt][1] * inv); w.y = pack2(o[dt][2] * inv, o[dt][3] * inv); *(uint2*)(orow + dt * 16 + fq * 4) = w; }
    if (lse_out && fq == 0) *lse_out = m + __logf(den);
}

DI void dil_item(const int ctx_tid, const int ctx_bid, const int ctx_g, const PView& p, int item, LAS unsigned char* lds) {
#ifdef NO_DIL
    return;
#endif
    unsigned char* ws = p.ws; const bf16_t* Z = (const bf16_t*)(ws + OFF_Z);
    const int tid = ctx_tid, w = tid >> 6, lane = tid & 63;
    const int sub = item & 31, pp = (item >> 5) % 3, bh = item / 96, b = bh / 12, h = bh % 12;
    int d, r, nb; if (pp == 0) { d = 1; r = 0; nb = sub; } else if (pp == 1) { d = 4; r = sub >> 3; nb = sub & 7; } else { d = 16; r = sub >> 1; nb = sub & 1; }
    constexpr int KS = 144, VS = 528;
    LAS unsigned char* Kl = lds; LAS unsigned char* Vl = lds + 256 * KS; LAS float* btl = (LAS float*)(lds + 256 * KS + 64 * VS);
    if (tid < 132) btl[tid] = ((const float*)(ws + OFF_BT))[(pp * 12 + h) * 132 + tid];
    { const int key = tid >> 1, hf = tid & 1; const int mk = 128 * (nb - 1) + key;
      uint4 kq[4], vq[4];
      if (mk >= 0) { const bf16_t* zr = Z + (size_t)(b * SEQ + mk * d + r) * NINP + h * 64 + hf * 32;
#pragma unroll
        for (int i = 0; i < 4; ++i) { kq[i] = *(const uint4*)(zr + 768 + i * 8); vq[i] = *(const uint4*)(zr + 1536 + i * 8); } }
      else {
#pragma unroll
        for (int i = 0; i < 4; ++i) { kq[i] = make_uint4(0u, 0u, 0u, 0u); vq[i] = make_uint4(0u, 0u, 0u, 0u); } }
#pragma unroll
      for (int i = 0; i < 4; ++i) *(LAS u32x4*)(Kl + key * KS + hf * 64 + i * 16) = (u32x4){kq[i].x, kq[i].y, kq[i].z, kq[i].w};
#pragma unroll
      for (int i = 0; i < 4; ++i) { const unsigned ww[4] = {vq[i].x, vq[i].y, vq[i].z, vq[i].w};
#pragma unroll
        for (int e = 0; e < 4; ++e) { const int dim = hf * 32 + i * 8 + e * 2;
            *(LAS bf16_t*)(Vl + dim * VS + key * 2) = (bf16_t)(ww[e] & 0xffffu); *(LAS bf16_t*)(Vl + (dim + 1) * VS + key * 2) = (bf16_t)(ww[e] >> 16); } } }
    __syncthreads();
    { const int qi = 16 * w + (lane & 15); const int tq = b * SEQ + (128 * nb + qi) * d + r;
      bf16_t* AP = (bf16_t*)(ws + OFF_AP); float* LSE = (float*)(ws + OFF_LSE);
      attn_wave<64, 5, true>(ctx_tid, ctx_bid, ctx_g, Kl, KS, Vl, VS, Z + (size_t)tq * NINP + h * 64, w >> 1, 0.125f, qi, nb == 0, btl,
                             AP + ((size_t)pp * T + tq) * 768 + h * 64, LSE + ((size_t)pp * T + tq) * 12 + h); }
    __syncthreads();
}
DI void cross_item(const int ctx_tid, const int ctx_bid, const int ctx_g, const PView& p, int item, LAS unsigned char* lds) {
#ifdef NO_CROSS
    return;
#endif
    unsigned char* ws = p.ws; const bf16_t* KV = (const bf16_t*)(ws + OFF_KV); const bf16_t* Q = (const bf16_t*)(ws + OFF_Q); bf16_t* O = (bf16_t*)(ws + OFF_O);
    const int tid = ctx_tid, w = tid >> 6, lane = tid & 63;
    const int qb = item & 31, mh = (item >> 5) & 3, b = item >> 7;
    constexpr int KS = 272, VS = 528;
    LAS unsigned char* Kl = lds; LAS unsigned char* Vl = lds + 256 * KS;
    { const int key = tid >> 1, hf = tid & 1; const bf16_t* kr = KV + (size_t)(b * 256 + key) * 1024 + mh * 128 + hf * 64;
#pragma unroll
      for (int i = 0; i < 8; ++i) { const uint4 kq = *(const uint4*)(kr + i * 8); *(LAS u32x4*)(Kl + key * KS + hf * 128 + i * 16) = (u32x4){kq.x, kq.y, kq.z, kq.w}; }
#pragma unroll
      for (int i = 0; i < 8; ++i) { const uint4 vq = *(const uint4*)(kr + 512 + i * 8); const unsigned ww[4] = {vq.x, vq.y, vq.z, vq.w};
#pragma unroll
        for (int e = 0; e < 4; ++e) { const int dim = hf * 64 + i * 8 + e * 2;
            *(LAS bf16_t*)(Vl + dim * VS + key * 2) = (bf16_t)(ww[e] & 0xffffu); *(LAS bf16_t*)(Vl + (dim + 1) * VS + key * 2) = (bf16_t)(ww[e] >> 16); } } }
    __syncthreads();
    { const int tq = b * SEQ + qb * 128 + 16 * w + (lane & 15);
      attn_wave<128, 8, false>(ctx_tid, ctx_bid, ctx_g, Kl, KS, Vl, VS, Q + (size_t)tq * 512 + mh * 128, 0, 0.08838834764831845f, 0, false, nullptr, O + (size_t)tq * 512 + mh * 128, nullptr); }
    __syncthreads();
}

DI void sgu_item(const int ctx_tid, const int ctx_bid, const int ctx_g, const PView& p, int l, int chunk, LAS unsigned char* lds) {
#ifdef NO_SGU
    return;
#endif
    unsigned char* ws = p.ws; const bf16_t* Z = (const bf16_t*)(ws + OFF_Z); bf16_t* MIX = (bf16_t*)(ws + OFF_MIX); const bf16_t* WS = (const bf16_t*)(ws + OFF_WS);
    const float* ng = p.in[8] + (size_t)l * 512; const float* sb = p.in[10] + (size_t)l * 1024; const float* og = p.in[11] + (size_t)l * 512;
    const int tid = ctx_tid, w = tid >> 6, lane = tid & 63, fr = lane & 15, fq = lane >> 4;
    constexpr int GS = 520;
    constexpr int GT = 136;
    LAS bf16_t* G = (LAS bf16_t*)lds;
    float gain8[8];
#pragma unroll
    for (int e = 0; e < 8; ++e) gain8[e] = ng[lane + 64 * e];
    for (int i = 0; i < 16; ++i) { const int j = 16 * w + i; const size_t tok = (size_t)chunk * 128 + j;
        float f[8]; float s = 0.f;
#pragma unroll
        for (int e = 0; e < 8; ++e) { f[e] = gelu_t(bf2f(Z[tok * NINP + 2816 + lane + 64 * e])); s += f[e]; }
        const float mean = wsum(s) * (1.0f / 512.0f); float q = 0.f;
#pragma unroll
        for (int e = 0; e < 8; ++e) { f[e] -= mean; q += f[e] * f[e]; }
        const float rs = rsqrtf(wsum(q) * (1.0f / 512.0f) + 1e-6f);
#pragma unroll
        for (int e = 0; e < 8; ++e) G[(lane + 64 * e) * GT + j] = f2bf(f[e] * rs * gain8[e]); }
    __syncthreads();
    bf16x8 bfr[4][4];
#pragma unroll
    for (int nt = 0; nt < 4; ++nt)
#pragma unroll
        for (int ks = 0; ks < 4; ++ks) bfr[nt][ks] = *(const LAS bf16x8*)(G + (w * 64 + nt * 16 + fr) * GT + ks * 32 + fq * 8);
    __syncthreads();
#pragma unroll 1
    for (int it = 0; it < 8; ++it) {
        f32x4 acc[4];
#pragma unroll
        for (int nt = 0; nt < 4; ++nt) acc[nt] = (f32x4){0.f, 0.f, 0.f, 0.f};
#pragma unroll
        for (int ks = 0; ks < 4; ++ks) if (ks * 32 <= it * 16 + 15) {
            const bf16x8 a = *(const bf16x8*)(WS + (size_t)(w * 128 + it * 16 + fr) * 128 + ks * 32 + fq * 8);
#pragma unroll
            for (int nt = 0; nt < 4; ++nt) acc[nt] = __builtin_amdgcn_mfma_f32_16x16x32_bf16(a, bfr[nt][ks], acc[nt], 0, 0, 0); }
#pragma unroll
        for (int j = 0; j < 4; ++j) { const int i = it * 16 + fq * 4 + j; const size_t tok = (size_t)chunk * 128 + i; const float bias = sb[w * 128 + i];
#pragma unroll
            for (int nt = 0; nt < 4; ++nt) { const int c = w * 64 + nt * 16 + fr; const float u = gelu_t(bf2f(Z[tok * NINP + 2304 + c]));
                G[i * GS + c] = f2bf(u * (acc[nt][j] + bias)); } }
    }
    __syncthreads();
    float og8[8];
#pragma unroll
    for (int e = 0; e < 8; ++e) og8[e] = og[lane * 8 + e];
    for (int i = 0; i < 16; ++i) { const int j = 16 * w + i; const size_t tok = (size_t)chunk * 128 + j;
        float f[8]; { const u32x4 lv = *(const LAS u32x4*)(G + j * GS + lane * 8); unpack8(make_uint4(lv.x, lv.y, lv.z, lv.w), f); } float q = 0.f;
#pragma unroll
        for (int e = 0; e < 8; ++e) q += f[e] * f[e];
        const float rs = rsqrtf(wsum(q) * (1.0f / 512.0f) + 1e-6f);
#pragma unroll
        for (int e = 0; e < 8; ++e) f[e] = f[e] * rs * og8[e];
        *(uint4*)(MIX + tok * DM + 768 + lane * 8) = pack8(f); }
    __syncthreads();
}

struct ScanRegs { uint2 zr, zrp, zk, zkp, zv, zvp; float4 a, w; };
constexpr int SSTEP = 392;
DI void scan_load(ScanRegs& R, const bf16_t* Z, const float* RWA, const float* RWD, int b, int h, int t, int l16) {
    const size_t tok = (size_t)b * SEQ + t; const bf16_t* zr = Z + tok * NINP + 3328 + h * 64 + l16 * 4;
    R.zr = *(const uint2*)(zr); R.zk = *(const uint2*)(zr + 768); R.zv = *(const uint2*)(zr + 1536);
    if (t > 0) { R.zrp = *(const uint2*)(zr - NINP); R.zkp = *(const uint2*)(zr - NINP + 768); R.zvp = *(const uint2*)(zr - NINP + 1536); }
    else { R.zrp = make_uint2(0u, 0u); R.zkp = R.zrp; R.zvp = R.zrp; }
    R.a = *(const float4*)(RWA + tok * 768 + h * 64 + l16 * 4); R.w = *(const float4*)(RWD + tok * 768 + h * 64 + l16 * 4);
}
DI void lerp4(const uint2 c, const uint2 pv, const float* mu, float (&o)[4]) {
    const float cc[4] = {bflo(c.x), bfhi(c.x), bflo(c.y), bfhi(c.y)}, pp[4] = {bflo(pv.x), bfhi(pv.x), bflo(pv.y), bfhi(pv.y)};
#pragma unroll
    for (int e = 0; e < 4; ++e) o[e] = cc[e] + (pp[e] - cc[e]) * mu[e];
}
DI void phase_scan(const int ctx_tid, const int ctx_bid, const int ctx_g, const PView& p, int l, int sb, LAS unsigned char* lds) {
#ifdef NO_SCAN
    return;
#endif
    unsigned char* ws = p.ws; const bf16_t* Z = (const bf16_t*)(ws + OFF_Z); const float* RWA = (const float*)(ws + OFF_RWA); const float* RWD = (const float*)(ws + OFF_RWD);
    float* YR = (float*)(ws + OFF_YR); float* BON = (float*)(ws + OFF_BON);
    const int tid = ctx_tid, w = tid >> 6, lane = tid & 63, l16 = lane & 15;
    const int half = sb & 1, bh = sb >> 1, b = bh / 12, h = bh % 12;
    const int ts = tid >> 4;
    const int row = half * 32 + w * 4 + (lane >> 4);
    const float* mub = p.in[12] + (size_t)l * 2688 + h * 64 + l16 * 4;
    float mur[4], muk[4], muv[4], kk4[4], ka4[4], rk4[4];
#pragma unroll
    for (int e = 0; e < 4; ++e) { mur[e] = mub[e]; muk[e] = mub[768 + e]; muv[e] = mub[1536 + e];
        kk4[e] = p.in[18][(size_t)l * 768 + h * 64 + l16 * 4 + e]; ka4[e] = p.in[19][(size_t)l * 768 + h * 64 + l16 * 4 + e]; rk4[e] = p.in[20][(size_t)l * 768 + h * 64 + l16 * 4 + e]; }
    LAS float* buf = (LAS float*)lds;
    LAS float* ybuf = (LAS float*)(lds + 2 * 32 * SSTEP * 4);
    float S[4] = {0.f, 0.f, 0.f, 0.f};
    ScanRegs R;
    auto process = [&](int stage, int t) {
        float r4[4], k4[4], v4[4]; lerp4(R.zr, R.zrp, mur, r4); lerp4(R.zk, R.zkp, muk, k4); lerp4(R.zv, R.zvp, muv, v4);
        const float a4[4] = {R.a.x, R.a.y, R.a.z, R.a.w}, w4[4] = {R.w.x, R.w.y, R.w.z, R.w.w};
        float kkv[4], n2 = 0.f;
#pragma unroll
        for (int e = 0; e < 4; ++e) { kkv[e] = k4[e] * kk4[e]; n2 += kkv[e] * kkv[e]; }
        n2 = rsum16(n2); const float inv = 1.0f / fmaxf(sqrtf(n2), 1e-12f);
        float kp[4], bb[4], nk[4], wr[4], br = 0.f, kr = 0.f, bon = 0.f;
#pragma unroll
        for (int e = 0; e < 4; ++e) { const float kh = kkv[e] * inv; nk[e] = -kh; bb[e] = kh * a4[e]; kp[e] = k4[e] * (1.0f + (a4[e] - 1.0f) * ka4[e]); wr[e] = w4[e] * r4[e];
            br += bb[e] * r4[e]; kr += kp[e] * r4[e]; bon += r4[e] * kp[e] * rk4[e]; }
        br = rsum16(br); kr = rsum16(kr); bon = rsum16(bon);
        LAS float* d = buf + (stage * 32 + ts) * SSTEP + l16 * 4;
        *(LAS f32x4*)(d) = (f32x4){w4[0], w4[1], w4[2], w4[3]}; *(LAS f32x4*)(d + 64) = (f32x4){nk[0], nk[1], nk[2], nk[3]};
        *(LAS f32x4*)(d + 128) = (f32x4){bb[0], bb[1], bb[2], bb[3]}; *(LAS f32x4*)(d + 192) = (f32x4){kp[0], kp[1], kp[2], kp[3]};
        *(LAS f32x4*)(d + 256) = (f32x4){wr[0], wr[1], wr[2], wr[3]}; *(LAS f32x4*)(d + 320) = (f32x4){v4[0], v4[1], v4[2], v4[3]};
        if (l16 == 0) { d[384] = br; d[385] = kr; if (half == 0) BON[((size_t)b * SEQ + t) * 12 + h] = bon; }
    };
    scan_load(R, Z, RWA, RWD, b, h, ts, l16);
    process(0, ts);
    __syncthreads();
    for (int ci = 0; ci < SEQ / 32; ++ci) {
        const int t0 = ci * 32;
        if (ci + 1 < SEQ / 32) scan_load(R, Z, RWA, RWD, b, h, t0 + 32 + ts, l16);
        const LAS float* sbuf = buf + (ci & 1) * 32 * SSTEP;
#pragma unroll 4
        for (int s = 0; s < 32; ++s) {
            const LAS float* d = sbuf + s * SSTEP + l16 * 4;
            const f32x4 W = *(const LAS f32x4*)(d), NK = *(const LAS f32x4*)(d + 64), B = *(const LAS f32x4*)(d + 128), KP = *(const LAS f32x4*)(d + 192), WR = *(const LAS f32x4*)(d + 256);
            const float vv = sbuf[s * SSTEP + 320 + row]; const float br = sbuf[s * SSTEP + 384], kr = sbuf[s * SSTEP + 385];
            float d1 = S[0] * NK.x + S[1] * NK.y + S[2] * NK.z + S[3] * NK.w;
            float d2 = S[0] * WR.x + S[1] * WR.y + S[2] * WR.z + S[3] * WR.w;
            d1 = rsum16(d1); d2 = rsum16(d2);
            const float sa = d1; const float y = d2 + sa * br + vv * kr;
            S[0] = S[0] * W.x + (sa * B.x + vv * KP.x); S[1] = S[1] * W.y + (sa * B.y + vv * KP.y); S[2] = S[2] * W.z + (sa * B.z + vv * KP.z); S[3] = S[3] * W.w + (sa * B.w + vv * KP.w);
            if (l16 == 0) ybuf[s * 32 + (row & 31)] = y;
        }
        __syncthreads();
        { const int s = tid >> 4, rr = (tid & 15) * 2; const f32x2 yv = *(const LAS f32x2*)(ybuf + s * 32 + rr);
          *(f32x2*)(YR + ((size_t)b * SEQ + t0 + s) * 768 + h * 64 + half * 32 + rr) = yv; }
        if (ci + 1 < SEQ / 32) process((ci + 1) & 1, t0 + 32 + ts);
        __syncthreads();
    }
}

DI void phase_mixpost(const int ctx_tid, const int ctx_bid, const int ctx_g, const PView& p, int l) {
#ifdef NO_POST
    return;
#endif
    unsigned char* ws = p.ws; const bf16_t* Z = (const bf16_t*)(ws + OFF_Z); const bf16_t* AP = (const bf16_t*)(ws + OFF_AP); const float* LSE = (const float*)(ws + OFF_LSE);
    const bf16_t* RWG = (const bf16_t*)(ws + OFF_RWG); const float* YR = (const float*)(ws + OFF_YR); const float* BON = (const float*)(ws + OFF_BON); bf16_t* MIX = (bf16_t*)(ws + OFF_MIX);
    const float* aog = p.in[7] + (size_t)l * 768; const float* muv = p.in[12] + (size_t)l * 2688 + 1536; const float* lg = p.in[21] + (size_t)l * 768; const float* lb = p.in[22] + (size_t)l * 768;
    const int lane = ctx_tid & 63, gw = ctx_bid * 8 + (ctx_tid >> 6), nw = ctx_g * 8;
    for (int t = gw; t < T; t += nw) {
        float oa[12]; float ss = 0.f;
#pragma unroll
        for (int j = 0; j < 12; ++j) {
            const float l0 = LSE[((size_t)0 * T + t) * 12 + j], l1 = LSE[((size_t)1 * T + t) * 12 + j], l2 = LSE[((size_t)2 * T + t) * 12 + j];
            const float mx = fmaxf(l0, fmaxf(l1, l2)); const float e0 = __expf(l0 - mx), e1 = __expf(l1 - mx), e2 = __expf(l2 - mx); const float inv = 1.0f / (e0 + e1 + e2);
            const float o0 = bf2f(AP[((size_t)0 * T + t) * 768 + j * 64 + lane]), o1 = bf2f(AP[((size_t)1 * T + t) * 768 + j * 64 + lane]), o2 = bf2f(AP[((size_t)2 * T + t) * 768 + j * 64 + lane]);
            oa[j] = (e0 * o0 + e1 * o1 + e2 * o2) * inv; ss += oa[j] * oa[j]; }
        const float rs = rsqrtf(wsum(ss) * (1.0f / 768.0f) + 1e-6f);
#pragma unroll
        for (int j = 0; j < 12; ++j) MIX[(size_t)t * DM + j * 64 + lane] = f2bf(oa[j] * rs * aog[j * 64 + lane]);
        const bool hasp = (t % SEQ) != 0;
#pragma unroll
        for (int j = 0; j < 12; ++j) { const int c = j * 64 + lane;
            const float y = YR[(size_t)t * 768 + c]; const float mean = wsum(y) * (1.0f / 64.0f); const float yc = y - mean; const float var = wsum(yc * yc) * (1.0f / 64.0f);
            float yn = yc * rsqrtf(var + 64e-5f) * lg[c] + lb[c];
            const float vc = bf2f(Z[(size_t)t * NINP + 4864 + c]); const float vp = hasp ? bf2f(Z[(size_t)(t - 1) * NINP + 4864 + c]) : 0.f; const float vs = vc + (vp - vc) * muv[c];
            yn += BON[(size_t)t * 12 + j] * vs;
            MIX[(size_t)t * DM + 1280 + c] = f2bf(yn * bf2f(RWG[(size_t)t * 768 + c])); }
    }
}

DI void phase_conv(const int ctx_tid, const int ctx_bid, const int ctx_g, const PView& p, int l) {
#ifdef NO_CONV
    return;
#endif
    unsigned char* ws = p.ws; const bf16_t* UP = (const bf16_t*)(ws + OFF_UP); bf16_t* ACT = (bf16_t*)(ws + OFF_ACT);
    const float* cw = p.in[27] + (size_t)l * 3 * NUP; const float* cb = p.in[28] + (size_t)l * NUP;
    const int lane = ctx_tid & 63, gw = ctx_bid * 8 + (ctx_tid >> 6), nw = ctx_g * 8;
    constexpr int TG = 16;
    for (int item = gw; item < (8192 / TG) * 11; item += nw) {
        const int cg_ = item % 11, tg = item / 11; const int c0 = cg_ * 512 + lane * 8;
        const int colp = (c0 >> 7) * 256 + (c0 & 127);
        float wg[3][8], wv[3][8], bg[8], bv[8];
#pragma unroll
        for (int e = 0; e < 8; ++e) { bg[e] = cb[c0 + e]; bv[e] = cb[DFF + c0 + e];
#pragma unroll
            for (int j = 0; j < 3; ++j) { wg[j][e] = cw[j * NUP + c0 + e]; wv[j][e] = cw[j * NUP + DFF + c0 + e]; } }
        float g1[8], g2[8], v1[8], v2[8];
        const int t0 = tg * TG;
        if ((t0 % SEQ) == 0) {
#pragma unroll
            for (int e = 0; e < 8; ++e) { g1[e] = 0.f; g2[e] = 0.f; v1[e] = 0.f; v2[e] = 0.f; } }
        else { unpack8(*(const uint4*)(UP + (size_t)(t0 - 1) * NUP + colp), g1); unpack8(*(const uint4*)(UP + (size_t)(t0 - 2) * NUP + colp), g2);
               unpack8(*(const uint4*)(UP + (size_t)(t0 - 1) * NUP + colp + 128), v1); unpack8(*(const uint4*)(UP + (size_t)(t0 - 2) * NUP + colp + 128), v2); }
#pragma unroll 2
        for (int i = 0; i < TG; ++i) { const int t = t0 + i; float g0[8], v0[8], o[8];
            unpack8(*(const uint4*)(UP + (size_t)t * NUP + colp), g0); unpack8(*(const uint4*)(UP + (size_t)t * NUP + colp + 128), v0);
#pragma unroll
            for (int e = 0; e < 8; ++e) { const float gc = bg[e] + wg[0][e] * g2[e] + wg[1][e] * g1[e] + wg[2][e] * g0[e]; const float vc = bv[e] + wv[0][e] * v2[e] + wv[1][e] * v1[e] + wv[2][e] * v0[e];
                o[e] = gelu_t(gc) * vc; g2[e] = g1[e]; g1[e] = g0[e]; v2[e] = v1[e]; v1[e] = v0[e]; }
            *(uint4*)(ACT + (size_t)t * DFF + c0) = pack8(o); }
    }
}

DI void run_gemm_bf16(const int ctx_tid, const int ctx_bid, const int ctx_g, LAS unsigned char* lds, const bf16_t* A, const bf16_t* Bt, int M, int N, int K, bf16_t* O, int ldc, int G, int c) {
#ifdef NO_GEMM
    return;
#endif
    pg8::Gemm g{A, Bt, M, N, K}; pg8::StaticOrder S; S.init(M, N, G, c); pg8::EpiBf16 E{O, ldc};
    pg8::gemm_phase<pg8::EpiBf16, pg8::StaticOrder, false>(ctx_tid, lds, g, S, E, nullptr);
}
DI void run_gemm_f32(const int ctx_tid, const int ctx_bid, const int ctx_g, LAS unsigned char* lds, const bf16_t* A, const bf16_t* Bt, int M, int N, int K, float* C, int ldc, int G, int c) {
#ifdef NO_GEMM
    return;
#endif
    pg8::Gemm g{A, Bt, M, N, K}; pg8::StaticOrder S; S.init(M, N, G, c); pg8::EpiF32 E{C, ldc, nullptr};
    pg8::gemm_phase<pg8::EpiF32, pg8::StaticOrder, false>(ctx_tid, lds, g, S, E, nullptr);
}

__global__ __launch_bounds__(512, 2) void mega(Params pin, int ph_lo, int ph_hi) {
    extern __shared__ __attribute__((aligned(16))) unsigned char shm[];
    LAS unsigned char* lds = (LAS unsigned char*)shm;
    const int gridDim_x0 = (int)gridDim.x;
    for (int ph = ph_lo; ph < ph_hi; ++ph) {
        if (ph > ph_lo) cg::this_grid().sync();
        const int l = ph / NPL, lp = ph % NPL;
        size_t zero = 0; asm volatile("" : "+s"(zero));
        int ctx_tid = threadIdx.x; asm volatile("" : "+v"(ctx_tid));
        int ctx_bid = blockIdx.x; asm volatile("" : "+s"(ctx_bid));
        int ctx_g = (int)gridDim_x0; asm volatile("" : "+s"(ctx_g));
        const int bid = ctx_bid, G = ctx_g;
        PView p; p.in.pp = &pin; p.in.zero = zero; p.out = pin.out + zero; p.ws = pin.ws + zero;
        unsigned char* ws = p.ws; bf16_t* HB = (bf16_t*)(ws + OFF_HB);
        const float* gains = p.in[3] + (size_t)l * 6 * DM;
        int gk = 0; const bf16_t* gA = nullptr; const bf16_t* gB = nullptr; int gM = 0, gN = 0, gK = 0, gld = 0, gG = G, gc = bid; void* gO = nullptr;
        switch (lp) {
        case 0: phase_cvt(ctx_tid, ctx_bid, ctx_g, p, l, lds); break;
        case 1: gk = 1; gA = HB; gB = (const bf16_t*)(ws + OFF_WIN); gM = T; gN = NINP; gK = DM; gO = ws + OFF_Z; gld = NINP; break;
        case 2: phase_rwkv_prep(ctx_tid, ctx_bid, ctx_g, p, l, lds); break;
        case 3:
            if (bid < SCAN_BLOCKS) phase_scan(ctx_tid, ctx_bid, ctx_g, p, l, bid, lds);
            else { const int nb = G - SCAN_BLOCKS;
                for (int it = bid - SCAN_BLOCKS; it < 128 + 4608; it += nb) { if (it < 128) sgu_item(ctx_tid, ctx_bid, ctx_g, p, l, it, lds); else dil_item(ctx_tid, ctx_bid, ctx_g, p, it - 128, lds); } }
            break;
        case 4: phase_mixpost(ctx_tid, ctx_bid, ctx_g, p, l); break;
        case 5: gk = 2; gA = (const bf16_t*)(ws + OFF_MIX); gB = (const bf16_t*)(ws + OFF_WOUT); gM = T; gN = DM; gK = DM; gO = ws + OFF_Y; gld = DM; break;
        case 6: phase_resid(ctx_tid, ctx_bid, ctx_g, (const float*)(ws + OFF_Y), l == 0 ? p.in[0] : p.out, p.out, gains + DM, gains + 2 * DM, HB); break;
        case 7: { const int nh = G / 2;
            if (bid < nh) { gk = 1; gA = HB; gB = (const bf16_t*)(ws + OFF_WQ); gM = T; gN = 512; gK = DM; gO = ws + OFF_Q; gld = 512; gG = nh; gc = bid; }
            else { gk = 1; gA = (const bf16_t*)(ws + OFF_MEMN); gB = (const bf16_t*)(ws + OFF_WKV); gM = 1024; gN = 1024; gK = DM; gO = ws + OFF_KV; gld = 1024; gG = G - nh; gc = bid - nh; } } break;
        case 8: for (int it = bid; it < 512; it += G) cross_item(ctx_tid, ctx_bid, ctx_g, p, it, lds); break;
        case 9: gk = 2; gA = (const bf16_t*)(ws + OFF_O); gB = (const bf16_t*)(ws + OFF_WO); gM = T; gN = DM; gK = 512; gO = ws + OFF_Y; gld = DM; break;
        case 10: phase_resid(ctx_tid, ctx_bid, ctx_g, (const float*)(ws + OFF_Y), p.out, p.out, gains + 3 * DM, gains + 4 * DM, HB); break;
        case 11: case 14: { const int ch = lp == 11 ? 0 : 1; gk = 1; gA = HB + (size_t)ch * 8192 * DM; gB = (const bf16_t*)(ws + OFF_WUP); gM = 8192; gN = NUP; gK = DM; gO = ws + OFF_UP; gld = NUP; } break;
        case 12: case 15: phase_conv(ctx_tid, ctx_bid, ctx_g, p, l); break;
        case 13: case 16: { const int ch = lp == 13 ? 0 : 1; gk = 2; gA = (const bf16_t*)(ws + OFF_ACT); gB = (const bf16_t*)(ws + OFF_WDN); gM = 8192; gN = DM; gK = DFF; gO = (float*)(ws + OFF_Y) + (size_t)ch * 8192 * DM; gld = DM; } break;
        case 17: phase_resid(ctx_tid, ctx_bid, ctx_g, (const float*)(ws + OFF_Y), p.out, p.out, gains + 5 * DM, l + 1 < 2 ? gains + 6 * DM : nullptr, HB); break;
        }
        if (gk == 1) run_gemm_bf16(ctx_tid, ctx_bid, ctx_g, lds, gA, gB, gM, gN, gK, (bf16_t*)gO, gld, gG, gc);
        else if (gk == 2) run_gemm_f32(ctx_tid, ctx_bid, ctx_g, lds, gA, gB, gM, gN, gK, (float*)gO, gld, gG, gc);
    }
}

#ifndef MK_SINGLE
#define MK_SINGLE 0
#endif
extern "C" void kernel_launch(void* const* d_in, const int* in_sizes, int n_in, void* d_out, int out_size, void* d_ws, size_t ws_size, hipStream_t stream) {
    (void)in_sizes; (void)out_size;
    if (n_in < 30 || ws_size < WS_NEED) { fprintf(stderr, "kernel_launch: bad arguments (n_in %d, ws %zu < %zu)\n", n_in, ws_size, (size_t)WS_NEED); return; }
    Params p{};
    for (int i = 0; i < 30; ++i) p.in[i] = (const float*)d_in[i];
    p.out = (float*)d_out; p.ws = (unsigned char*)d_ws;
    hipFuncSetAttribute((const void*)mega, hipFuncAttributeMaxDynamicSharedMemorySize, LDS_BYTES);
    int dev = 0, cus = 0, per_cu = 0;
    hipGetDevice(&dev); hipDeviceGetAttribute(&cus, hipDeviceAttributeMultiprocessorCount, dev);
    hipOccupancyMaxActiveBlocksPerMultiprocessor(&per_cu, mega, 512, LDS_BYTES);
    if (per_cu < 1) per_cu = 1;
    int grid = cus * per_cu; if (grid > 256) grid = 256; if (grid < 128) grid = 128;
#if MK_SINGLE
    int lo = 0, hi = 2 * NPL; void* args[] = {&p, &lo, &hi};
    hipError_t e = hipLaunchCooperativeKernel((void*)mega, dim3(grid), dim3(512), args, LDS_BYTES, stream);
    if (e != hipSuccess) fprintf(stderr, "cooperative launch failed: %s (grid %d)\n", hipGetErrorString(e), grid);
#else
    for (int ph = 0; ph < 2 * NPL; ++ph) hipLaunchKernelGGL(mega, dim3(grid), dim3(512), LDS_BYTES, stream, p, ph, ph + 1);
#endif
}
```

```cpp
#include <hip/hip_runtime.h>
#include <hip/hip_cooperative_groups.h>
#include <cstdio>
#include <cstdint>
namespace cg = cooperative_groups;
namespace pg8 {
#define PG8_LAS __attribute__((address_space(3)))
typedef unsigned short bf16_t;
typedef short bf16x8 __attribute__((ext_vector_type(8)));
typedef float f32x4 __attribute__((ext_vector_type(4)));
typedef unsigned u32x4 __attribute__((ext_vector_type(4)));
constexpr int BM = 256, BK = 64, HALF = 128, HTB = HALF * BK * 2  , STAGE_BYTES = 8 * HTB, NXCD = 8, WGM = 4;

__host__ __device__ __forceinline__ int lds_byte(int r, int c) { const int st = (r >> 4) * 2 + (c >> 5), rr = r & 15, cc = c & 31, ob = rr * 64 + cc * 2; return st * 1024 + (ob ^ (((ob >> 9) & 1) << 5)); }
__host__ __device__ __forceinline__ void stage_rc(int b, int& R, int& C) { const int st = b / 1024, sb = b % 1024, swz = sb ^ (((sb >> 9) & 1) << 5); R = (st >> 1) * 16 + swz / 64; C = (st & 1) * 32 + (swz % 64) / 2; }
__host__ __device__ __forceinline__ int perm32(int rho) { const int n = rho >> 4, i = rho & 15; return 8 * (i >> 2) + 4 * n + (i & 3); }

struct Unit { int pm, pn; };
struct Gemm { const bf16_t* A; const bf16_t* Bt; int M, N, K; };

struct StaticOrder {
    int nM, nN, nwg, G, c;
    __host__ __device__ void init(int M, int N, int G_, int c_) { nM = M / BM; nN = N / BM; nwg = nM * nN; G = G_; c = c_; }
    __host__ __device__ bool next(int i, Unit& u) const {
        const long L = (long)i * G + c; if (L >= nwg) return false;
        int wgid = (int)L; { const int q = nwg / NXCD, r = nwg % NXCD, xcd = wgid % NXCD, off = wgid / NXCD; wgid = (xcd < r ? xcd * (q + 1) : r * (q + 1) + (xcd - r) * q) + off; }
        const int nig = WGM * nN, gid = wgid / nig, fm = gid * WGM, gsz = (nM - fm) < WGM ? (nM - fm) : WGM;
        u.pm = fm + ((wgid % nig) % gsz); u.pn = (wgid % nig) / gsz; return true;
    }
    __device__ __forceinline__ void a_ready(const Unit&) const {}
    __device__ __forceinline__ void done(const Unit&) const {}
};
__device__ __forceinline__ unsigned cvt_pk_bf16(float lo, float hi) { unsigned r; asm volatile("v_cvt_pk_bf16_f32 %0, %1, %2" : "=v"(r) : "v"(lo), "v"(hi)); return r; }
struct EpiF32 {
    static constexpr bool PERM = false, AFTER_DRAIN = false, TOKPERM = false;
    float* C; int ldc; const float* bias;
    __device__ __forceinline__ void operator()(const f32x4 (&acc)[2][2][4][2], const Unit& u, int wr, int wc, int fr, int fq) const {
        const int row0 = u.pm * BM + wr * 64 + fr, col0 = u.pn * BM + wc * 32 + 4 * fq;
        f32x4 bv[2][2];
#pragma unroll
        for (int bj = 0; bj < 2; ++bj)
#pragma unroll
            for (int n = 0; n < 2; ++n) bv[bj][n] = bias ? *(const f32x4*)(bias + col0 + bj * HALF + n * 16) : (f32x4){0.f, 0.f, 0.f, 0.f};
#pragma unroll
        for (int ai = 0; ai < 2; ++ai)
#pragma unroll
            for (int m = 0; m < 4; ++m) { float* rowp = C + (size_t)(row0 + ai * HALF + m * 16) * ldc + col0;
#pragma unroll
                for (int bj = 0; bj < 2; ++bj)
#pragma unroll
                    for (int n = 0; n < 2; ++n) *(f32x4*)(rowp + bj * HALF + n * 16) = acc[ai][bj][m][n] + bv[bj][n]; }
    }
};
struct EpiBf16 {
    static constexpr bool PERM = true, AFTER_DRAIN = false, TOKPERM = false;
    bf16_t* O; int ldc;
    __device__ __forceinline__ void operator()(const f32x4 (&acc)[2][2][4][2], const Unit& u, int wr, int wc, int fr, int fq) const {
        const int row0 = u.pm * BM + wr * 64 + fr; const int col0 = u.pn * BM + wc * 32 + 8 * fq;
#pragma unroll
        for (int ai = 0; ai < 2; ++ai)
#pragma unroll
            for (int m = 0; m < 4; ++m) { bf16_t* rowp = O + (size_t)(row0 + ai * HALF + m * 16) * ldc + col0;
#pragma unroll
                for (int bj = 0; bj < 2; ++bj) { const f32x4 v0 = acc[ai][bj][m][0], v1 = acc[ai][bj][m][1];
                    u32x4 w; w.x = cvt_pk_bf16(v0[0], v0[1]); w.y = cvt_pk_bf16(v0[2], v0[3]); w.z = cvt_pk_bf16(v1[0], v1[1]); w.w = cvt_pk_bf16(v1[2], v1[3]);
                    *(u32x4*)(rowp + bj * HALF) = w; } }
    }
};

typedef unsigned u32x2 __attribute__((ext_vector_type(2)));
template <int CTRL> __device__ __forceinline__ float epi_dpp(float x) { return __int_as_float(__builtin_amdgcn_update_dpp(0, __float_as_int(x), CTRL, 0xF, 0xF, true)); }
__device__ __forceinline__ float epi_gelu_t(float x) { const float u = 0.7978845608028654f * (x + 0.044715f * x * x * x); return x * __builtin_amdgcn_rcpf(1.0f + __expf(-2.0f * u)); }
struct EpiConv {
    static constexpr bool PERM = true, AFTER_DRAIN = false, TOKPERM = true;
    bf16_t* ACT; const float* cw; const float* cb; float* HALO; float* PARTB; int dff, nup;
    __device__ __forceinline__ void operator()(const f32x4 (&acc)[2][2][4][2], const Unit& u, int wr, int wc, int fr, int fq) const {
        const int tok0 = u.pm * BM + (wr * 16 + fr) * 8;
        const int grp = u.pm * 2 + wr;
        const int cl = wc * 32 + fq * 8;
#pragma unroll
        for (int n = 0; n < 2; ++n) {
            const int ch = u.pn * 128 + cl + 4 * n;
            const int colp = u.pn * 256 + cl + 4 * n;
            const f32x4 bg = *(const f32x4*)(cb + ch), bv = *(const f32x4*)(cb + dff + ch);
            f32x4 wg[3], wv[3];
#pragma unroll
            for (int j = 0; j < 3; ++j) { wg[j] = *(const f32x4*)(cw + (size_t)j * nup + ch); wv[j] = *(const f32x4*)(cw + (size_t)j * nup + dff + ch); }
            f32x4 hg6, hg7, hv6, hv7;
#pragma unroll
            for (int e = 0; e < 4; ++e) { hg6[e] = epi_dpp<0x111>(acc[1][0][2][n][e]); hg7[e] = epi_dpp<0x111>(acc[1][0][3][n][e]); hv6[e] = epi_dpp<0x111>(acc[1][1][2][n][e]); hv7[e] = epi_dpp<0x111>(acc[1][1][3][n][e]); }
            if (fr == 15) {
                float* h = HALO + ((size_t)grp * 2) * nup + colp;
                *(f32x4*)(h) = acc[1][0][2][n]; *(f32x4*)(h + 128) = acc[1][1][2][n]; *(f32x4*)(h + nup) = acc[1][0][3][n]; *(f32x4*)(h + nup + 128) = acc[1][1][3][n]; }
            if (fr == 0) {
                float* q = PARTB + ((size_t)grp * 2) * nup + colp;
                *(f32x4*)(q) = bg + wg[2] * acc[0][0][0][n]; *(f32x4*)(q + 128) = bv + wv[2] * acc[0][1][0][n];
                *(f32x4*)(q + nup) = bg + wg[2] * acc[0][0][1][n] + wg[1] * acc[0][0][0][n]; *(f32x4*)(q + nup + 128) = bv + wv[2] * acc[0][1][1][n] + wv[1] * acc[0][1][0][n]; }
#pragma unroll
            for (int j = 0; j < 8; ++j) {
                const f32x4 g0 = acc[j >> 2][0][j & 3][n], v0 = acc[j >> 2][1][j & 3][n];
                const f32x4 g1 = j >= 1 ? acc[(j - 1 < 0 ? 0 : j - 1) >> 2][0][(j - 1 < 0 ? 0 : j - 1) & 3][n] : hg7, v1 = j >= 1 ? acc[(j - 1 < 0 ? 0 : j - 1) >> 2][1][(j - 1 < 0 ? 0 : j - 1) & 3][n] : hv7;
                const f32x4 g2 = j >= 2 ? acc[(j - 2 < 0 ? 0 : j - 2) >> 2][0][(j - 2 < 0 ? 0 : j - 2) & 3][n] : (j == 1 ? hg7 : hg6), v2 = j >= 2 ? acc[(j - 2 < 0 ? 0 : j - 2) >> 2][1][(j - 2 < 0 ? 0 : j - 2) & 3][n] : (j == 1 ? hv7 : hv6);
                const f32x4 gc = bg + wg[0] * g2 + wg[1] * g1 + wg[2] * g0, vc = bv + wv[0] * v2 + wv[1] * v1 + wv[2] * v0;
                if (j >= 2 || fr != 0) { u32x2 w; w.x = cvt_pk_bf16(epi_gelu_t(gc[0]) * vc[0], epi_gelu_t(gc[1]) * vc[1]); w.y = cvt_pk_bf16(epi_gelu_t(gc[2]) * vc[2], epi_gelu_t(gc[3]) * vc[3]);
                    *(u32x2*)(ACT + (size_t)(tok0 + j) * dff + ch) = w; }
            }
        }
    }
};
template <class Epi, class Sched, bool STAMP = false>
__device__ __forceinline__ void gemm_phase(const int tid_in, PG8_LAS unsigned char* lds, const Gemm g, const Sched& S, const Epi& E, unsigned long long* stamps) {
    const int tid = tid_in, wid = __builtin_amdgcn_readfirstlane(tid >> 6), lane = tid & 63, wr = wid >> 2, wc = wid & 3, fr = lane & 15, fq = lane >> 4;
    const int K = g.K, nt = K / BK;
    int ts_lo = 0, ts_hi = 0, nts = 0; const unsigned long long rt_entry = STAMP ? (unsigned long long)wall_clock64() : 0ull;
#define PG8_STAMP() do { if (STAMP && wid == 0 && nts < 64) { const unsigned long long _c = (unsigned long long)clock64(); \
        ts_lo = (lane == nts) ? (int)(unsigned)_c : ts_lo; ts_hi = (lane == nts) ? (int)(unsigned)(_c >> 32) : ts_hi; ++nts; } } while (0)
    PG8_STAMP();
    unsigned voffA[2], voffB[2];
#pragma unroll
    for (int i = 0; i < 2; ++i) { int R, C; stage_rc(tid * 16 + i * 8192, R, C); const int Rb = Epi::PERM ? ((R & ~31) + perm32(R & 31)) : R;
        const int Ra = Epi::TOKPERM ? ((((R >> 6) * 16 + (R & 15)) * 8) + ((R >> 4) & 3)) : R;
        voffA[i] = (unsigned)(Ra * K + C) * 2u; voffB[i] = (unsigned)(Rb * K + C) * 2u; }
    const size_t kstep = (size_t)(BK * 2);
    const size_t hstep = (size_t)HALF * K * 2;
    const size_t hstepA = Epi::TOKPERM ? (size_t)4 * K * 2 : hstep;
    const size_t tstep = 2 * hstep;
    const unsigned ldsw = (unsigned)wid * 1024u;
    const int aoff = lds_byte(wr * 64 + fr, fq * 8), boff = lds_byte(wc * 32 + fr, fq * 8);
#define PG8_SA(b, h) (((b) * 2 + (h)) * HTB)
#define PG8_SB(b, h) ((4 + (b) * 2 + (h)) * HTB)
#define PG8_STAGE(bufoff, gbase, voff) do { _Pragma("unroll") for (int _i = 0; _i < 2; ++_i) \
        __builtin_amdgcn_global_load_lds((const unsigned*)((const char*)(gbase) + (voff)[_i]), (PG8_LAS unsigned*)(lds + (bufoff) + ldsw + _i * 8192), 16, 0, 0); } while (0)
#define PG8_LDA(dst, b, h) do { _Pragma("unroll") for (int m = 0; m < 4; ++m) _Pragma("unroll") for (int k = 0; k < 2; ++k) dst[m][k] = *(const PG8_LAS bf16x8*)(lds + PG8_SA(b, h) + aoff + m * 2048 + k * 1024); } while (0)
#define PG8_LDB(dst, b, h) do { _Pragma("unroll") for (int n = 0; n < 2; ++n) _Pragma("unroll") for (int k = 0; k < 2; ++k) dst[n][k] = *(const PG8_LAS bf16x8*)(lds + PG8_SB(b, h) + boff + n * 2048 + k * 1024); } while (0)
#define PG8_MMA(ai, bj, At, Bt) do { __builtin_amdgcn_s_setprio(1); _Pragma("unroll") for (int m = 0; m < 4; ++m) _Pragma("unroll") for (int n = 0; n < 2; ++n) _Pragma("unroll") for (int k = 0; k < 2; ++k) \
        acc[ai][bj][m][n] = __builtin_amdgcn_mfma_f32_16x16x32_bf16(Bt[n][k], At[m][k], acc[ai][bj][m][n], 0, 0, 0); __builtin_amdgcn_s_setprio(0); } while (0)
#define PG8_WAIT_V(n) asm volatile("s_waitcnt vmcnt(" #n ")" ::: "memory")
#define PG8_WAIT_L(n) asm volatile("s_waitcnt lgkmcnt(" #n ")" ::: "memory")
#define PG8_BAR __builtin_amdgcn_s_barrier()
#define PG8_SCHED __builtin_amdgcn_sched_barrier(0)
    Unit cur, nxt; int ui = 0;
    if (!S.next(0, cur)) return;
    f32x4 acc[2][2][4][2];
#pragma unroll
    for (int a = 0; a < 2; ++a)
#pragma unroll
        for (int b = 0; b < 2; ++b)
#pragma unroll
            for (int m = 0; m < 4; ++m)
#pragma unroll
                for (int n = 0; n < 2; ++n) acc[a][b][m][n] = (f32x4){0.f, 0.f, 0.f, 0.f};
    bf16x8 At[4][2], B0[2][2], B1[2][2];
    const char* cA = (const char*)g.A + (size_t)cur.pm * tstep; const char* cB = (const char*)g.Bt + (size_t)cur.pn * tstep;
    S.a_ready(cur);
    PG8_STAGE(PG8_SB(0, 0), cB, voffB); PG8_STAGE(PG8_SA(0, 0), cA, voffA); PG8_STAGE(PG8_SB(0, 1), cB + hstep, voffB); PG8_STAGE(PG8_SA(0, 1), cA + hstepA, voffA);
    if (wr == 1) PG8_BAR;
    PG8_WAIT_V(4); PG8_BAR;
    PG8_STAGE(PG8_SB(1, 0), cB + kstep, voffB); PG8_STAGE(PG8_SA(1, 0), cA + kstep, voffA); PG8_STAGE(PG8_SB(1, 1), cB + hstep + kstep, voffB);
    PG8_WAIT_V(6); PG8_BAR;
    PG8_STAMP();
    for (;;) {
        const bool has_next = S.next(ui + 1, nxt);
        const char* nA = has_next ? (const char*)g.A + (size_t)nxt.pm * tstep : cA; const char* nB = has_next ? (const char*)g.Bt + (size_t)nxt.pn * tstep : cB;
        for (int t = 0; t < nt; t += 2) {
            const bool last = (t == nt - 2);
            const char* a1 = cA + (size_t)(t + 1) * kstep;
            const char* a2 = last ? nA : cA + (size_t)(t + 2) * kstep; const char* b2 = last ? nB : cB + (size_t)(t + 2) * kstep;
            const char* a3 = a2 + kstep; const char* b3 = b2 + kstep;
            if (last && has_next) S.a_ready(nxt);
            PG8_LDB(B0, 0, 0); PG8_SCHED; PG8_LDA(At, 0, 0); PG8_STAGE(PG8_SA(1, 1), a1 + hstepA, voffA);
            PG8_WAIT_L(8); PG8_BAR; PG8_WAIT_L(0); PG8_MMA(0, 0, At, B0); PG8_BAR; PG8_SCHED;
            PG8_LDB(B1, 0, 1); PG8_STAGE(PG8_SB(0, 0), b2, voffB);
            PG8_BAR; PG8_WAIT_L(0); PG8_MMA(0, 1, At, B1); PG8_BAR;
            PG8_LDA(At, 0, 1); PG8_STAGE(PG8_SA(0, 0), a2, voffA);
            PG8_BAR; PG8_WAIT_L(0); PG8_MMA(1, 0, At, B0); PG8_BAR; PG8_SCHED;
            PG8_STAGE(PG8_SB(0, 1), b2 + hstep, voffB);
            PG8_WAIT_V(6); PG8_BAR; PG8_MMA(1, 1, At, B1); PG8_BAR;
            PG8_LDB(B0, 1, 0); PG8_SCHED; PG8_LDA(At, 1, 0); PG8_STAGE(PG8_SA(0, 1), a2 + hstepA, voffA);
            PG8_WAIT_L(8); PG8_BAR; PG8_WAIT_L(0); PG8_MMA(0, 0, At, B0); PG8_BAR; PG8_SCHED;
            PG8_LDB(B1, 1, 1); PG8_STAGE(PG8_SB(1, 0), b3, voffB);
            PG8_BAR; PG8_WAIT_L(0); PG8_MMA(0, 1, At, B1); PG8_BAR;
            PG8_LDA(At, 1, 1); PG8_STAGE(PG8_SA(1, 0), a3, voffA);
            PG8_BAR; PG8_WAIT_L(0); PG8_MMA(1, 0, At, B0); PG8_BAR; PG8_SCHED;
            PG8_STAGE(PG8_SB(1, 1), b3 + hstep, voffB);
            PG8_WAIT_V(6); PG8_BAR; PG8_MMA(1, 1, At, B1); PG8_BAR;
        }
        PG8_STAMP();
        if constexpr (!Epi::AFTER_DRAIN) { E(acc, cur, wr, wc, fr, fq); S.done(cur); }
        PG8_STAMP();
        if (!has_next) break;
#pragma unroll
        for (int a = 0; a < 2; ++a)
#pragma unroll
            for (int b = 0; b < 2; ++b)
#pragma unroll
                for (int m = 0; m < 4; ++m)
#pragma unroll
                    for (int n = 0; n < 2; ++n) acc[a][b][m][n] = (f32x4){0.f, 0.f, 0.f, 0.f};
        cur = nxt; cA = nA; cB = nB; ++ui;
    }
    PG8_WAIT_V(0);
    if (wr == 0) PG8_BAR;
    PG8_BAR;
    if constexpr (Epi::AFTER_DRAIN) { E.fused(acc, cur, wr, wc, fr, fq, lds, wid, lane); S.done(cur); }
    PG8_STAMP();
    if (STAMP && wid == 0) { stamps[lane] = lane < nts ? (((unsigned long long)(unsigned)ts_hi << 32) | (unsigned)ts_lo) : 0ull;
        if (lane == 62) stamps[62] = rt_entry; if (lane == 63) stamps[63] = (unsigned long long)wall_clock64(); }
#undef PG8_STAMP
#undef PG8_SA
#undef PG8_SB
#undef PG8_STAGE
#undef PG8_LDA
#undef PG8_LDB
#undef PG8_MMA
#undef PG8_WAIT_V
#undef PG8_WAIT_L
#undef PG8_BAR
#undef PG8_SCHED
}
}
#ifndef REP_MASK
#define REP_MASK 0
#endif
#ifndef P3_MODE
#define P3_MODE 0
#endif
typedef unsigned short bf16_t;
typedef pg8::bf16x8 bf16x8;
typedef pg8::f32x4 f32x4;
typedef pg8::u32x2 u32x2;
typedef unsigned u32x4 __attribute__((ext_vector_type(4)));
typedef float f32x2 __attribute__((ext_vector_type(2)));
#define DI __device__ __forceinline__
#define LAS __attribute__((address_space(3)))

constexpr int T = 16384, DM = 2048, SEQ = 4096, NIN = 6016, NINP = 6144, DFF = 5632, NUP = 11264;
constexpr int NPL = 15;
constexpr int LDS_BYTES = 147456;
constexpr int SCAN_BLOCKS = 96;
constexpr size_t al256(size_t x) { return (x + 255) & ~(size_t)255; }
constexpr size_t OFF_CTL = 0;
constexpr size_t CTL_BYTES = 16384;
constexpr size_t OFF_WIN = OFF_CTL + CTL_BYTES;
constexpr size_t OFF_WOUT = OFF_WIN + (size_t)NINP * DM * 2;
constexpr size_t OFF_WQ = OFF_WOUT + (size_t)DM * DM * 2;
constexpr size_t OFF_WKV = OFF_WQ + (size_t)512 * DM * 2;
constexpr size_t OFF_WO = OFF_WKV + (size_t)1024 * DM * 2;
constexpr size_t OFF_WUP = OFF_WO + (size_t)DM * 512 * 2;
constexpr size_t OFF_WDN = OFF_WUP + (size_t)NUP * DM * 2;
constexpr size_t OFF_LW = OFF_WDN + (size_t)DM * DFF * 2;
constexpr size_t OFF_LA = OFF_LW + (size_t)768 * 64 * 2;
constexpr size_t OFF_LG = OFF_LA + (size_t)768 * 64 * 2;
constexpr size_t OFF_WS = OFF_LG + (size_t)768 * 256 * 2;
constexpr size_t OFF_BT = OFF_WS + (size_t)8 * 128 * 128 * 2;
constexpr size_t OFF_MEMN = al256(OFF_BT + 3 * 12 * 132 * 4);
constexpr size_t OFF_HB = OFF_MEMN + (size_t)1024 * DM * 2;
constexpr size_t OFF_XB = OFF_HB + (size_t)T * DM * 2;
constexpr size_t OFF_R = OFF_XB + (size_t)T * DM * 2;
constexpr size_t OFF_Z = OFF_R;
constexpr size_t OFF_AP = OFF_Z + (size_t)T * NINP * 2;
constexpr size_t OFF_LSE = OFF_AP + (size_t)3 * T * 768 * 2;
constexpr size_t OFF_RWA = OFF_LSE + (size_t)3 * T * 12 * 4;
constexpr size_t OFF_RWD = OFF_RWA + (size_t)T * 768 * 2;
constexpr size_t OFF_RWG = OFF_RWD + (size_t)T * 768 * 2;
constexpr size_t OFF_YR = OFF_RWG + (size_t)T * 768 * 2;
constexpr size_t OFF_BON = OFF_YR + (size_t)T * 768 * 4;
constexpr size_t OFF_MIX = OFF_BON + (size_t)T * 12 * 4;
constexpr size_t OFF_END1 = OFF_MIX + (size_t)T * DM * 2;
constexpr size_t OFF_Y = OFF_R;
constexpr size_t OFF_Q = OFF_Y + (size_t)T * DM * 4;
constexpr size_t OFF_O = OFF_Q + (size_t)T * 512 * 2;
constexpr size_t OFF_KV = OFF_O + (size_t)T * 512 * 2;
constexpr size_t OFF_ACT = OFF_Y + (size_t)T * DM * 4;
constexpr size_t OFF_HALO = OFF_ACT + (size_t)T * DFF * 2;
constexpr size_t OFF_PART = OFF_HALO + (size_t)(T / 128) * 2 * NUP * 4;
constexpr size_t OFF_END2 = OFF_PART + (size_t)(T / 128) * 2 * NUP * 4;
constexpr size_t WS_NEED = OFF_END1 > OFF_END2 ? OFF_END1 : OFF_END2;
static_assert(OFF_Y + (size_t)T * DM * 4 <= OFF_MIX, "Y must not overlap MIX");

struct Params { const float* in[30]; float* out; unsigned char* ws; };
struct InArr { const Params* pp; size_t zero; DI const float* operator[](int i) const { return pp->in[i] + zero; } };
struct PView { InArr in; float* out; unsigned char* ws; };

DI float bf2f(unsigned b) { return __uint_as_float(b << 16); }
DI float bflo(unsigned w) { return __uint_as_float(w << 16); }
DI float bfhi(unsigned w) { return __uint_as_float(w & 0xffff0000u); }
typedef __bf16 bf16x2_t __attribute__((ext_vector_type(2)));
DI unsigned pack2(float lo, float hi) { const f32x2 v = {lo, hi}; const bf16x2_t r = __builtin_convertvector(v, bf16x2_t); return __builtin_bit_cast(unsigned, r); }
DI bf16_t f2bf(float f) { return (bf16_t)(pack2(f, 0.f) & 0xffffu); }

template <int C> DI float dppf(float x) { return __int_as_float(__builtin_amdgcn_update_dpp(0, __float_as_int(x), C, 0xF, 0xF, true)); }
DI float rsum16(float x) { x += dppf<0xB1>(x); x += dppf<0x4E>(x); x += dppf<0x141>(x); x += dppf<0x140>(x); return x; }
DI float swz16(float x) { return __int_as_float(__builtin_amdgcn_ds_swizzle(__float_as_int(x), 0x401F)); }
DI float wsum(float x) { x = rsum16(x); x += swz16(x); return __int_as_float(__builtin_amdgcn_readlane(__float_as_int(x), 0)) + __int_as_float(__builtin_amdgcn_readlane(__float_as_int(x), 32)); }
DI float xor32(float x, int tid) { return __int_as_float(__builtin_amdgcn_ds_bpermute(((tid ^ 32) & 63) << 2, __float_as_int(x))); }
DI float gelu_t(float x) { const float u = 0.7978845608028654f * (x + 0.044715f * x * x * x); return x * __builtin_amdgcn_rcpf(1.0f + __expf(-2.0f * u)); }
DI float sigm(float x) { return __builtin_amdgcn_rcpf(1.0f + __expf(-x)); }
DI void unpack8(const uint4 w, float (&f)[8]) { f[0] = bflo(w.x); f[1] = bfhi(w.x); f[2] = bflo(w.y); f[3] = bfhi(w.y); f[4] = bflo(w.z); f[5] = bfhi(w.z); f[6] = bflo(w.w); f[7] = bfhi(w.w); }
DI uint4 pack8(const float (&f)[8]) { uint4 w; w.x = pack2(f[0], f[1]); w.y = pack2(f[2], f[3]); w.z = pack2(f[4], f[5]); w.w = pack2(f[6], f[7]); return w; }

template <int KT>
DI void cvt_job(const int ctx_tid, const int ctx_bid, const int ctx_g, const float* W, bf16_t* Bt, int K, int N, int Npad, int mode, int& tile_base, LAS float* tile) {
    constexpr int NL = KT / 32;
    const int tk = K / KT, tn = Npad / 64, nt = tk * tn, G = ctx_g, tid = ctx_tid, w = tid >> 6, lane = tid & 63;
    const int first = (ctx_bid - (tile_base % G) + G) % G;
    const int r = tid >> 4, c4 = (tid & 15) * 4;
    auto tile_src = [&](int ti, int& n0, int& k0, int& src, bool& valid) { const int ik = ti % tk, in_ = ti / tk; n0 = in_ * 64; k0 = ik * KT; src = n0; valid = n0 < N;
        if (mode == 1) { const int pn = n0 / 256, bj = (n0 % 256) / 128, off = n0 % 128; src = bj * DFF + pn * 128 + off; valid = true; } };
    float4 cur[NL], nxt[NL], nx2[NL];
    auto tile_load = [&](int ti, float4 (&v)[NL]) { int n0, k0, src; bool valid; tile_src(ti < nt ? ti : first, n0, k0, src, valid);
#pragma unroll
        for (int i = 0; i < NL; ++i) { if (valid) { const f32x4 t = __builtin_nontemporal_load((const f32x4*)(W + (size_t)(k0 + r + 32 * i) * N + src + c4)); v[i] = make_float4(t.x, t.y, t.z, t.w); } else v[i] = make_float4(0.f, 0.f, 0.f, 0.f); } };
    if (first < nt) { tile_load(first, cur); tile_load(first + G, nxt); }
    for (int ti = first; ti < nt; ti += G) {
        int n0, k0, src; bool valid; tile_src(ti, n0, k0, src, valid);
        tile_load(ti + 2 * G, nx2);
#pragma unroll
        for (int i = 0; i < NL; ++i) { LAS float* d = tile + (r + 32 * i) * 65 + c4; d[0] = cur[i].x; d[1] = cur[i].y; d[2] = cur[i].z; d[3] = cur[i].w; }
        __syncthreads();
        { constexpr int KW = KT / 8;
          bf16_t* o = Bt + (size_t)(n0 + lane) * K + k0 + w * KW;
#pragma unroll
          for (int q = 0; q < KW / 8; ++q) { float f[8];
#pragma unroll
            for (int j = 0; j < 8; ++j) f[j] = tile[(w * KW + q * 8 + j) * 65 + lane];
            *(uint4*)(o + q * 8) = pack8(f); } }
        __syncthreads();
#pragma unroll
        for (int i = 0; i < NL; ++i) { cur[i] = nxt[i]; nxt[i] = nx2[i]; }
    }
    tile_base += nt;
}
DI int xcd_row(const int bid, const int wave, const int G, const int i) {
    if (G == 256) return i < 8 ? 2048 * (bid & 7) + ((bid >> 3) * 8 + wave) + 256 * i : T;
    return bid * 8 + wave + i * G * 8;
}
DI void rmsnorm_rows_bf16(const int ctx_tid, const int ctx_bid, const int ctx_g, const float* X, const float* gain, bf16_t* O, int rows) {
    const int lane = ctx_tid & 63, wv = ctx_tid >> 6; const bool xm = (rows == T) && (ctx_g == 256);
    for (int ri = 0; ; ++ri) { const int r = xm ? xcd_row(ctx_bid, wv, 256, ri) : ctx_bid * 8 + wv + ri * ctx_g * 8; if (r >= rows) break;
        const float* x = X + (size_t)r * DM; float4 v[8]; float ss = 0.f;
#pragma unroll
        for (int i = 0; i < 8; ++i) { v[i] = *(const float4*)(x + (i * 64 + lane) * 4); ss += v[i].x * v[i].x + v[i].y * v[i].y + v[i].z * v[i].z + v[i].w * v[i].w; }
        const float rs = rsqrtf(wsum(ss) * (1.0f / DM) + 1e-6f);
#pragma unroll
        for (int i = 0; i < 8; ++i) { const float4 g = *(const float4*)(gain + (i * 64 + lane) * 4); uint2 w; w.x = pack2(v[i].x * rs * g.x, v[i].y * rs * g.y); w.y = pack2(v[i].z * rs * g.z, v[i].w * rs * g.w);
            *(uint2*)(O + (size_t)r * DM + (i * 64 + lane) * 4) = w; }
    }
}
DI int t5_bucket(int dist) {
    if (dist < 16) return dist;
    int bkt = 16;
    bkt += dist >= 22; bkt += dist >= 30; bkt += dist >= 40; bkt += dist >= 54; bkt += dist >= 73; bkt += dist >= 99; bkt += dist >= 134; bkt += dist >= 182;
    bkt += dist >= 246; bkt += dist >= 332; bkt += dist >= 450; bkt += dist >= 609; bkt += dist >= 825; bkt += dist >= 1117; bkt += dist >= 1513;
    return bkt;
}
DI void phase_cvt(const int ctx_tid, const int ctx_bid, const int ctx_g, const PView& p, int l, LAS unsigned char* lds) {
#ifdef NO_CVT
    return;
#endif
    unsigned char* ws = p.ws; LAS float* tile = (LAS float*)lds; int tb = 0;
    cvt_job<256>(ctx_tid, ctx_bid, ctx_g, p.in[5] + (size_t)l * DM * NIN, (bf16_t*)(ws + OFF_WIN), DM, NIN, NINP, 0, tb, tile);
    cvt_job<256>(ctx_tid, ctx_bid, ctx_g, p.in[26] + (size_t)l * DM * NUP, (bf16_t*)(ws + OFF_WUP), DM, NUP, NUP, 1, tb, tile);
    cvt_job<256>(ctx_tid, ctx_bid, ctx_g, p.in[29] + (size_t)l * DFF * DM, (bf16_t*)(ws + OFF_WDN), DFF, DM, DM, 0, tb, tile);
    cvt_job<256>(ctx_tid, ctx_bid, ctx_g, p.in[6] + (size_t)l * DM * DM, (bf16_t*)(ws + OFF_WOUT), DM, DM, DM, 0, tb, tile);
    cvt_job<256>(ctx_tid, ctx_bid, ctx_g, p.in[23] + (size_t)l * DM * 512, (bf16_t*)(ws + OFF_WQ), DM, 512, 512, 0, tb, tile);
    cvt_job<256>(ctx_tid, ctx_bid, ctx_g, p.in[24] + (size_t)l * DM * 1024, (bf16_t*)(ws + OFF_WKV), DM, 1024, 1024, 0, tb, tile);
    cvt_job<256>(ctx_tid, ctx_bid, ctx_g, p.in[25] + (size_t)l * 512 * DM, (bf16_t*)(ws + OFF_WO), 512, DM, DM, 0, tb, tile);
    cvt_job<64>(ctx_tid, ctx_bid, ctx_g, p.in[14] + (size_t)l * 64 * 768, (bf16_t*)(ws + OFF_LW), 64, 768, 768, 0, tb, tile);
    cvt_job<64>(ctx_tid, ctx_bid, ctx_g, p.in[16] + (size_t)l * 64 * 768, (bf16_t*)(ws + OFF_LA), 64, 768, 768, 0, tb, tile);
    cvt_job<256>(ctx_tid, ctx_bid, ctx_g, p.in[17] + (size_t)l * 256 * 768, (bf16_t*)(ws + OFF_LG), 256, 768, 768, 0, tb, tile);
    const int gt = ctx_bid * 512 + ctx_tid, ng = ctx_g * 512;
    { const float* sw = p.in[9] + (size_t)l * 8 * 128 * 128; bf16_t* o = (bf16_t*)(ws + OFF_WS);
      for (int i = gt; i < 8 * 128 * 128; i += ng) { const int jj = i & 127, ii = (i >> 7) & 127; o[i] = f2bf(jj <= ii ? sw[i] : 0.f); } }
    if (l == 0) { float* bt = (float*)(ws + OFF_BT);
      for (int i = gt; i < 3 * 12 * 129; i += ng) { const int delta = i % 129, h = (i / 129) % 12, pp = i / (129 * 12); const int d = pp == 0 ? 1 : (pp == 1 ? 4 : 16);
        bt[(pp * 12 + h) * 132 + delta] = p.in[2][t5_bucket(delta * d) * 12 + h]; } }
    rmsnorm_rows_bf16(ctx_tid, ctx_bid, ctx_g, p.in[1], p.in[4] + (size_t)l * DM, (bf16_t*)(ws + OFF_MEMN), 1024);
    if (l == 0) rmsnorm_rows_bf16(ctx_tid, ctx_bid, ctx_g, p.in[0], p.in[3], (bf16_t*)(ws + OFF_HB), T);
}

template <bool XIN_F32, bool XOUT_F32>
DI void phase_resid(const int ctx_tid, const int ctx_bid, const int ctx_g, const bf16_t* Y, const void* xi_, void* xo_, const float* ga, const float* gb, bf16_t* HB) {
#ifdef NO_RESID
    return;
#endif
    const int lane = ctx_tid & 63, wv = ctx_tid >> 6;
    for (int ri = 0, r = xcd_row(ctx_bid, wv, ctx_g, 0); r < T; r = xcd_row(ctx_bid, wv, ctx_g, ++ri)) {
        float4 xv[8], xin[8]; float ss = 0.f;
#pragma unroll
        for (int i = 0; i < 8; ++i) { const int c = (i * 64 + lane) * 4; const u32x2 yq = __builtin_nontemporal_load((const u32x2*)(Y + (size_t)r * DM + c)); float4 y; y.x = bflo(yq.x); y.y = bfhi(yq.x); y.z = bflo(yq.y); y.w = bfhi(yq.y); xv[i] = y; ss += y.x * y.x + y.y * y.y + y.z * y.z + y.w * y.w;
            if (XIN_F32) { const f32x4 t = __builtin_nontemporal_load((const f32x4*)((const float*)xi_ + (size_t)r * DM + c)); xin[i] = make_float4(t.x, t.y, t.z, t.w); }
            else { const u32x2 xq = __builtin_nontemporal_load((const u32x2*)((const bf16_t*)xi_ + (size_t)r * DM + c)); xin[i].x = bflo(xq.x); xin[i].y = bfhi(xq.x); xin[i].z = bflo(xq.y); xin[i].w = bfhi(xq.y); } }
        const float rs = rsqrtf(wsum(ss) * (1.0f / DM) + 1e-6f); float s2 = 0.f;
#pragma unroll
        for (int i = 0; i < 8; ++i) { const int c = (i * 64 + lane) * 4; const float4 g = *(const float4*)(ga + c); const float4 x = xin[i];
            float4 o; o.x = x.x + xv[i].x * rs * g.x; o.y = x.y + xv[i].y * rs * g.y; o.z = x.z + xv[i].z * rs * g.z; o.w = x.w + xv[i].w * rs * g.w;
            if (XOUT_F32) __builtin_nontemporal_store((f32x4){o.x, o.y, o.z, o.w}, (f32x4*)((float*)xo_ + (size_t)r * DM + c));
            else { uint2 w; w.x = pack2(o.x, o.y); w.y = pack2(o.z, o.w); *(uint2*)((bf16_t*)xo_ + (size_t)r * DM + c) = w; }
            xv[i] = o; s2 += o.x * o.x + o.y * o.y + o.z * o.z + o.w * o.w; }
        if (gb) { const float r2 = rsqrtf(wsum(s2) * (1.0f / DM) + 1e-6f);
#pragma unroll
            for (int i = 0; i < 8; ++i) { const int c = (i * 64 + lane) * 4; const float4 g = *(const float4*)(gb + c); uint2 w; w.x = pack2(xv[i].x * r2 * g.x, xv[i].y * r2 * g.y); w.y = pack2(xv[i].z * r2 * g.z, xv[i].w * r2 * g.w);
                *(uint2*)(HB + (size_t)r * DM + c) = w; } }
    }
}

DI void phase_rwkv_prep(const int ctx_tid, const int ctx_bid, const int ctx_g, const PView& p, int l, LAS unsigned char* lds) {
#ifdef NO_PREP
    return;
#endif
    unsigned char* ws = p.ws; const bf16_t* Z = (const bf16_t*)(ws + OFF_Z);
    const float* mu = p.in[12] + (size_t)l * 2688 + 2304; const float* w0 = p.in[13] + (size_t)l * 768; const float* a0 = p.in[15] + (size_t)l * 768;
    const bf16_t* LW = (const bf16_t*)(ws + OFF_LW); const bf16_t* LA = (const bf16_t*)(ws + OFF_LA); const bf16_t* LG = (const bf16_t*)(ws + OFF_LG);
    bf16_t* RWA = (bf16_t*)(ws + OFF_RWA); bf16_t* RWD = (bf16_t*)(ws + OFF_RWD); bf16_t* RWG = (bf16_t*)(ws + OFF_RWG);
    const int tid = ctx_tid, lane = tid & 63, w = tid >> 6, fr = lane & 15, fq = lane >> 4;
    constexpr int AST = 392;
    LAS bf16_t* A = (LAS bf16_t*)lds;
    for (int item = ctx_bid; item < T / 64; item += ctx_g) {
        { uint2 cur[4][3], prv[4][3];
#pragma unroll
          for (int r = 0; r < 4; ++r) { const int idx = tid + 512 * r, row = idx >> 5, cs = (idx & 31) * 12; const int t = item * 64 + row; const bool hasp = (t % SEQ) != 0;
            const bf16_t* zr = Z + (size_t)t * NINP + 5632 + cs;
#pragma unroll
            for (int q = 0; q < 3; ++q) { cur[r][q] = *(const uint2*)(zr + q * 4); prv[r][q] = make_uint2(0u, 0u); if (hasp) prv[r][q] = *(const uint2*)(zr - NINP + q * 4); } }
#pragma unroll
          for (int r = 0; r < 4; ++r) { const int idx = tid + 512 * r, row = idx >> 5, cs = (idx & 31) * 12;
#pragma unroll
            for (int q = 0; q < 3; ++q) { const float c4[4] = {bflo(cur[r][q].x), bfhi(cur[r][q].x), bflo(cur[r][q].y), bfhi(cur[r][q].y)}, p4[4] = {bflo(prv[r][q].x), bfhi(prv[r][q].x), bflo(prv[r][q].y), bfhi(prv[r][q].y)};
#pragma unroll
              for (int e = 0; e < 4; ++e) { const int c = cs + q * 4 + e; float v = c4[e] + (p4[e] - c4[e]) * mu[c];
                  if (c < 64) v = 1.0f - 2.0f * __builtin_amdgcn_rcpf(__expf(2.0f * v) + 1.0f); else if (c >= 128) v = sigm(v);
                  A[row * AST + c] = f2bf(v); } } } }
        __syncthreads();
        const int t0 = item * 64;
        bf16x8 bc[12]; float wz, az;
#pragma unroll 1
        for (int nt = 0; nt < 6; ++nt) {
            const int n0 = w * 96 + nt * 16, c = n0 + fr;
#pragma unroll
            for (int ks = 0; ks < 2; ++ks) { bc[ks] = *(const bf16x8*)(LW + (size_t)(n0 + fr) * 64 + ks * 32 + fq * 8); bc[2 + ks] = *(const bf16x8*)(LA + (size_t)(n0 + fr) * 64 + ks * 32 + fq * 8); }
#pragma unroll
            for (int ks = 0; ks < 8; ++ks) bc[4 + ks] = *(const bf16x8*)(LG + (size_t)(n0 + fr) * 256 + ks * 32 + fq * 8);
            wz = w0[c]; az = a0[c];
#pragma unroll 1
            for (int mt = 0; mt < 4; ++mt) {
                const LAS bf16_t* Ar = A + (mt * 16 + fr) * AST + fq * 8; const int tb = t0 + mt * 16 + fq * 4;
                f32x4 accw = {0.f, 0.f, 0.f, 0.f}, acca = {0.f, 0.f, 0.f, 0.f}, accg = {0.f, 0.f, 0.f, 0.f};
#pragma unroll
                for (int ks = 0; ks < 2; ++ks) { accw = __builtin_amdgcn_mfma_f32_16x16x32_bf16(*(const LAS bf16x8*)(Ar + ks * 32), bc[ks], accw, 0, 0, 0);
                                                 acca = __builtin_amdgcn_mfma_f32_16x16x32_bf16(*(const LAS bf16x8*)(Ar + 64 + ks * 32), bc[2 + ks], acca, 0, 0, 0); }
#pragma unroll
                for (int ks = 0; ks < 8; ++ks) accg = __builtin_amdgcn_mfma_f32_16x16x32_bf16(*(const LAS bf16x8*)(Ar + 128 + ks * 32), bc[4 + ks], accg, 0, 0, 0);
#pragma unroll
                for (int j = 0; j < 4; ++j) { const float u = wz + accw[j];
                    RWD[(size_t)(tb + j) * 768 + c] = f2bf(0.6065306597126334f * sigm(u)); RWA[(size_t)(tb + j) * 768 + c] = f2bf(sigm(az + acca[j])); RWG[(size_t)(tb + j) * 768 + c] = f2bf(accg[j]); }
            }
        }
        __syncthreads();
    }
}

template <int DH, int NSTEP, bool MASK>
DI void attn_wave(const int ctx_tid, const int ctx_bid, const int ctx_g, const LAS unsigned char* Kl, int KS, const LAS unsigned char* Vl, int VS, const bf16x8 (&qf)[DH / 32], int step0, float scale,
                  int qi, bool first_block, const LAS float* btab, bf16_t* orow, float* lse_out) {
    const int lane = ctx_tid & 63, fr = lane & 15, fq = lane >> 4;
    f32x4 s[NSTEP][2];
#pragma unroll
    for (int st = 0; st < NSTEP; ++st)
#pragma unroll
        for (int hf = 0; hf < 2; ++hf) {
            const int key0 = (step0 + st) * 32 + hf * 16; f32x4 acc = {0.f, 0.f, 0.f, 0.f};
#pragma unroll
            for (int ks = 0; ks < DH / 32; ++ks) { const bf16x8 kf = *(const LAS bf16x8*)(Kl + (key0 + fr) * KS + (ks * 32 + fq * 8) * 2);
                acc = __builtin_amdgcn_mfma_f32_16x16x32_bf16(kf, qf[ks], acc, 0, 0, 0); }
            s[st][hf] = acc;
        }
    float m = -3.0e38f;
    const int kjb = step0 * 32 + fq * 4, tb0 = kjb - qi + 31;
#pragma unroll
    for (int st = 0; st < NSTEP; ++st)
#pragma unroll
        for (int hf = 0; hf < 2; ++hf)
#pragma unroll
            for (int j = 0; j < 4; ++j) {
                float v = s[st][hf][j] * scale;
                if (MASK) v += btab[tb0 + st * 32 + hf * 16 + j];
                s[st][hf][j] = v;
            }
    if (MASK && first_block) {
#pragma unroll
        for (int st = 0; st < NSTEP; ++st)
#pragma unroll
            for (int hf = 0; hf < 2; ++hf)
#pragma unroll
                for (int j = 0; j < 4; ++j) s[st][hf][j] = (kjb + (st * 32 + hf * 16 + j) >= 128) ? s[st][hf][j] : -1e30f; }
#pragma unroll
    for (int st = 0; st < NSTEP; ++st)
#pragma unroll
        for (int hf = 0; hf < 2; ++hf)
#pragma unroll
            for (int j = 0; j < 4; ++j) m = fmaxf(m, s[st][hf][j]);
    m = fmaxf(m, swz16(m)); m = fmaxf(m, xor32(m, ctx_tid));
    float den = 0.f;
#pragma unroll
    for (int st = 0; st < NSTEP; ++st)
#pragma unroll
        for (int hf = 0; hf < 2; ++hf)
#pragma unroll
            for (int j = 0; j < 4; ++j) { const float e = __expf(s[st][hf][j] - m); s[st][hf][j] = e; den += e; }
    den += swz16(den); den += xor32(den, ctx_tid);
    f32x4 o[DH / 16];
#pragma unroll
    for (int dt = 0; dt < DH / 16; ++dt) o[dt] = (f32x4){0.f, 0.f, 0.f, 0.f};
#pragma unroll
    for (int st = 0; st < NSTEP; ++st) {
        uint4 pw; pw.x = pack2(s[st][0][0], s[st][0][1]); pw.y = pack2(s[st][0][2], s[st][0][3]); pw.z = pack2(s[st][1][0], s[st][1][1]); pw.w = pack2(s[st][1][2], s[st][1][3]);
        const bf16x8 pf = __builtin_bit_cast(bf16x8, pw);
        const int kb = (step0 + st) * 32;
#pragma unroll
        for (int dt = 0; dt < DH / 16; ++dt) {
            const LAS unsigned char* vr = Vl + (dt * 16 + fr) * VS + (kb + fq * 4) * 2;
            const u32x2 v0 = *(const LAS u32x2*)vr; const u32x2 v1 = *(const LAS u32x2*)(vr + 32);
            u32x4 vw; vw.x = v0.x; vw.y = v0.y; vw.z = v1.x; vw.w = v1.y;
            o[dt] = __builtin_amdgcn_mfma_f32_16x16x32_bf16(__builtin_bit_cast(bf16x8, vw), pf, o[dt], 0, 0, 0);
        }
    }
    const float inv = 1.0f / den;
#pragma unroll
    for (int dt = 0; dt < DH / 16; ++dt) { uint2 w; w.x = pack2(o[dt][0] * inv, o[dt][1] * inv); w.y = pack2(o[dt][2] * inv, o[dt][3] * inv); *(uint2*)(orow + dt * 16 + fq * 4) = w; }
    if (lse_out && fq == 0) *lse_out = m + __logf(den);
}

struct DilItem { int b, h, pp, d, r, nb; };
DI DilItem dil_decode(int item) { DilItem I; const int sub = item & 31; I.pp = (item >> 5) % 3; const int bh = item / 96; I.b = bh / 12; I.h = bh % 12;
    if (I.pp == 0) { I.d = 1; I.r = 0; I.nb = sub; } else if (I.pp == 1) { I.d = 4; I.r = sub >> 3; I.nb = sub & 7; } else { I.d = 16; I.r = sub >> 1; I.nb = sub & 1; } return I; }
DI void dil_load(const int ctx_tid, const PView& p, int item, u32x4 (&kq)[4], u32x2 (&vq)[8], bf16x8 (&qf)[2], float& btv) {
    const char* Zb = (const char*)(p.ws + OFF_Z); const DilItem I = dil_decode(item);
    const unsigned strideB = (unsigned)I.d * (unsigned)(NINP * 2);
    const unsigned base0 = ((unsigned)(I.b * SEQ + I.r) * (unsigned)NINP + (unsigned)(I.h * 64)) * 2u;
    const int m0 = 128 * (I.nb - 1);
    { const int w = ctx_tid >> 6, lane = ctx_tid & 63; const int qi = 16 * w + (lane & 15);
      const char* qrow = Zb + (base0 + (unsigned)(m0 + 128 + qi) * strideB + (unsigned)((lane >> 4) * 16)); qf[0] = *(const bf16x8*)(qrow); qf[1] = *(const bf16x8*)(qrow + 64); }
    { const int u = ctx_tid - 31; const int uc = u < 0 ? 0 : (u > 128 ? 128 : u); const float bv = ((const float*)(p.ws + OFF_BT))[(I.pp * 12 + I.h) * 132 + (128 - uc)]; btv = (u >= 0 && u <= 128) ? bv : -1e30f; }
    { const int key = ctx_tid >> 1, hf = ctx_tid & 1; const int mk = m0 + key; const unsigned msk = mk < 0 ? 0u : 0xffffffffu;
      const char* zr = Zb + (base0 + (unsigned)(mk < 0 ? 0 : mk) * strideB + (unsigned)((768 + hf * 32) * 2));
#pragma unroll
      for (int i = 0; i < 4; ++i) kq[i] = *(const u32x4*)(zr + i * 16) & msk; }
    { const int kg = ctx_tid >> 4, dg = ctx_tid & 15; const int mk0 = m0 + kg * 8; const unsigned msk = mk0 < 0 ? 0u : 0xffffffffu;
      const char* zv = Zb + (base0 + (unsigned)(mk0 < 0 ? 0 : mk0) * strideB + (unsigned)((1536 + dg * 4) * 2));
#pragma unroll
      for (int k = 0; k < 8; ++k) vq[k] = *(const u32x2*)(zv + (unsigned)k * strideB) & msk; }
}
DI void dil_stage(const int ctx_tid, const PView& p, int item, const u32x4 (&kq)[4], const u32x2 (&vq)[8], const float btv, LAS unsigned char* lds) {
    constexpr int KS = 144, VS = 528; const DilItem I = dil_decode(item);
    LAS unsigned char* Kl = lds; LAS unsigned char* Vl = lds + 256 * KS; LAS float* btl = (LAS float*)(lds + 256 * KS + 64 * VS);
    const int tid = ctx_tid, key = tid >> 1, hf = tid & 1;
    if (tid < 192) btl[tid] = btv;
#pragma unroll
    for (int i = 0; i < 4; ++i) *(LAS u32x4*)(Kl + key * KS + hf * 64 + i * 16) = kq[i];
    { const int kg = tid >> 4, dg = tid & 15; u32x4 o[4];
#pragma unroll
      for (int i = 0; i < 4; ++i) {
          o[0][i] = __builtin_amdgcn_perm(vq[2 * i + 1].x, vq[2 * i].x, 0x05040100u); o[1][i] = __builtin_amdgcn_perm(vq[2 * i + 1].x, vq[2 * i].x, 0x07060302u);
          o[2][i] = __builtin_amdgcn_perm(vq[2 * i + 1].y, vq[2 * i].y, 0x05040100u); o[3][i] = __builtin_amdgcn_perm(vq[2 * i + 1].y, vq[2 * i].y, 0x07060302u); }
#pragma unroll
      for (int d = 0; d < 4; ++d) *(LAS u32x4*)(Vl + (dg * 4 + d) * VS + kg * 16) = o[d]; }
}
DI void dil_compute(const int ctx_tid, const int ctx_bid, const int ctx_g, const PView& p, int item, const bf16x8 (&qf)[2], LAS unsigned char* lds) {
    constexpr int KS = 144, VS = 528; const DilItem I = dil_decode(item);
    unsigned char* ws = p.ws; const bf16_t* Z = (const bf16_t*)(ws + OFF_Z);
    LAS unsigned char* Kl = lds; LAS unsigned char* Vl = lds + 256 * KS; LAS float* btl = (LAS float*)(lds + 256 * KS + 64 * VS);
    const int w = ctx_tid >> 6, lane = ctx_tid & 63;
    const int qi = 16 * w + (lane & 15); const int tq = I.b * SEQ + (128 * I.nb + qi) * I.d + I.r;
    bf16_t* AP = (bf16_t*)(ws + OFF_AP); float* LSE = (float*)(ws + OFF_LSE);
    attn_wave<64, 5, true>(ctx_tid, ctx_bid, ctx_g, Kl, KS, Vl, VS, qf, w >> 1, 0.125f, qi, I.nb == 0, btl,
                           AP + ((size_t)I.pp * T + tq) * 768 + I.h * 64, LSE + ((size_t)I.pp * T + tq) * 12 + I.h);
}
DI void cross_item(const int ctx_tid, const int ctx_bid, const int ctx_g, const PView& p, int item, const bool restage, LAS unsigned char* lds) {
#ifdef NO_CROSS
    return;
#endif
    unsigned char* ws = p.ws; const bf16_t* KV = (const bf16_t*)(ws + OFF_KV); const bf16_t* Q = (const bf16_t*)(ws + OFF_Q); bf16_t* O = (bf16_t*)(ws + OFF_O);
    const int tid = ctx_tid, w = tid >> 6, lane = tid & 63;
    const int kv = item & 15, qb = item >> 4, b = kv >> 2, mh = kv & 3;
    constexpr int KS = 272, VS = 528;
    LAS unsigned char* Kl = lds; LAS unsigned char* Vl = lds + 256 * KS;
    const int tq = b * SEQ + qb * 128 + 16 * w + (lane & 15);
    bf16x8 qf[4];
#pragma unroll
    for (int ks = 0; ks < 4; ++ks) qf[ks] = *(const bf16x8*)(Q + (size_t)tq * 512 + mh * 128 + ks * 32 + (lane >> 4) * 8);
    if (restage) {
        { const int key = tid >> 1, hf = tid & 1; const bf16_t* kr = KV + (size_t)(b * 256 + key) * 1024 + mh * 128 + hf * 64;
          u32x4 kq[8];
#pragma unroll
          for (int i = 0; i < 8; ++i) kq[i] = *(const u32x4*)(kr + i * 8);
          const int kg = tid >> 4, dg = tid & 15; u32x4 vq[8];
#pragma unroll
          for (int k = 0; k < 8; ++k) vq[k] = *(const u32x4*)(KV + (size_t)(b * 256 + kg * 8 + k) * 1024 + 512 + mh * 128 + dg * 8);
#pragma unroll
          for (int i = 0; i < 8; ++i) *(LAS u32x4*)(Kl + key * KS + hf * 128 + i * 16) = kq[i];
#pragma unroll
          for (int c = 0; c < 4; ++c) {
              u32x4 lo, hi;
#pragma unroll
              for (int i = 0; i < 4; ++i) { lo[i] = __builtin_amdgcn_perm(vq[2 * i + 1][c], vq[2 * i][c], 0x05040100u); hi[i] = __builtin_amdgcn_perm(vq[2 * i + 1][c], vq[2 * i][c], 0x07060302u); }
              *(LAS u32x4*)(Vl + (dg * 8 + 2 * c) * VS + kg * 16) = lo; *(LAS u32x4*)(Vl + (dg * 8 + 2 * c + 1) * VS + kg * 16) = hi; } }
        __syncthreads();
    }
    attn_wave<128, 8, false>(ctx_tid, ctx_bid, ctx_g, Kl, KS, Vl, VS, qf, 0, 0.08838834764831845f, 0, false, nullptr, O + (size_t)tq * 512 + mh * 128, nullptr);
    __syncthreads();
}

DI void sgu_item(const int ctx_tid, const int ctx_bid, const int ctx_g, const PView& p, int l, int chunk, LAS unsigned char* lds) {
#ifdef NO_SGU
    return;
#endif
    unsigned char* ws = p.ws; const bf16_t* Z = (const bf16_t*)(ws + OFF_Z); bf16_t* MIX = (bf16_t*)(ws + OFF_MIX); const bf16_t* WS = (const bf16_t*)(ws + OFF_WS);
    const float* ng = p.in[8] + (size_t)l * 512; const float* sb = p.in[10] + (size_t)l * 1024; const float* og = p.in[11] + (size_t)l * 512;
    const int tid = ctx_tid, w = tid >> 6, lane = tid & 63, fr = lane & 15, fq = lane >> 4;
    constexpr int GS = 520;
    constexpr int GT = 136;
    LAS bf16_t* G = (LAS bf16_t*)lds;
    float gain8[8];
#pragma unroll
    for (int e = 0; e < 8; ++e) gain8[e] = ng[lane + 64 * e];
#pragma unroll 1
    for (int i0 = 0; i0 < 16; i0 += 4) {
        unsigned short raw[4][8];
#pragma unroll
        for (int ii = 0; ii < 4; ++ii) { const size_t tok = (size_t)chunk * 128 + 16 * w + i0 + ii;
#pragma unroll
            for (int e = 0; e < 8; ++e) raw[ii][e] = Z[tok * NINP + 2816 + lane + 64 * e]; }
#pragma unroll
        for (int ii = 0; ii < 4; ++ii) { const int j = 16 * w + i0 + ii;
            float f[8]; float s = 0.f;
#pragma unroll
            for (int e = 0; e < 8; ++e) { f[e] = gelu_t(bf2f(raw[ii][e])); s += f[e]; }
            const float mean = wsum(s) * (1.0f / 512.0f); float q = 0.f;
#pragma unroll
            for (int e = 0; e < 8; ++e) { f[e] -= mean; q += f[e] * f[e]; }
            const float rs = rsqrtf(wsum(q) * (1.0f / 512.0f) + 1e-6f);
#pragma unroll
            for (int e = 0; e < 8; ++e) G[(lane + 64 * e) * GT + j] = f2bf(f[e] * rs * gain8[e]); } }
    __syncthreads();
    bf16x8 bfr[4][4];
#pragma unroll
    for (int nt = 0; nt < 4; ++nt)
#pragma unroll
        for (int ks = 0; ks < 4; ++ks) bfr[nt][ks] = *(const LAS bf16x8*)(G + (w * 64 + nt * 16 + fr) * GT + ks * 32 + fq * 8);
    __syncthreads();
    unsigned short uc[4][4], un[4][4]; float bc4[4], bn4[4];
#pragma unroll
    for (int j = 0; j < 4; ++j) { const int i = fq * 4 + j; const size_t tok = (size_t)chunk * 128 + i; bc4[j] = sb[w * 128 + i];
#pragma unroll
        for (int nt = 0; nt < 4; ++nt) uc[j][nt] = Z[tok * NINP + 2304 + w * 64 + nt * 16 + fr]; }
#pragma unroll 1
    for (int it = 0; it < 8; ++it) {
        { const int itn = it < 7 ? it + 1 : 7;
#pragma unroll
          for (int j = 0; j < 4; ++j) { const int i = itn * 16 + fq * 4 + j; const size_t tok = (size_t)chunk * 128 + i; bn4[j] = sb[w * 128 + i];
#pragma unroll
            for (int nt = 0; nt < 4; ++nt) un[j][nt] = Z[tok * NINP + 2304 + w * 64 + nt * 16 + fr]; } }
        f32x4 acc[4];
#pragma unroll
        for (int nt = 0; nt < 4; ++nt) acc[nt] = (f32x4){0.f, 0.f, 0.f, 0.f};
#pragma unroll
        for (int ks = 0; ks < 4; ++ks) if (ks * 32 <= it * 16 + 15) {
            const bf16x8 a = *(const bf16x8*)(WS + (size_t)(w * 128 + it * 16 + fr) * 128 + ks * 32 + fq * 8);
#pragma unroll
            for (int nt = 0; nt < 4; ++nt) acc[nt] = __builtin_amdgcn_mfma_f32_16x16x32_bf16(a, bfr[nt][ks], acc[nt], 0, 0, 0); }
#pragma unroll
        for (int j = 0; j < 4; ++j) { const int i = it * 16 + fq * 4 + j;
#pragma unroll
            for (int nt = 0; nt < 4; ++nt) { const int c = w * 64 + nt * 16 + fr; const float u = gelu_t(bf2f(uc[j][nt]));
                G[i * GS + c] = f2bf(u * (acc[nt][j] + bc4[j])); } }
#pragma unroll
        for (int j = 0; j < 4; ++j) { bc4[j] = bn4[j];
#pragma unroll
            for (int nt = 0; nt < 4; ++nt) uc[j][nt] = un[j][nt]; }
    }
    __syncthreads();
    float og8[8];
#pragma unroll
    for (int e = 0; e < 8; ++e) og8[e] = og[lane * 8 + e];
    for (int i = 0; i < 16; ++i) { const int j = 16 * w + i; const size_t tok = (size_t)chunk * 128 + j;
        float f[8]; { const u32x4 lv = *(const LAS u32x4*)(G + j * GS + lane * 8); unpack8(make_uint4(lv.x, lv.y, lv.z, lv.w), f); } float q = 0.f;
#pragma unroll
        for (int e = 0; e < 8; ++e) q += f[e] * f[e];
        const float rs = rsqrtf(wsum(q) * (1.0f / 512.0f) + 1e-6f);
#pragma unroll
        for (int e = 0; e < 8; ++e) f[e] = f[e] * rs * og8[e];
        *(uint4*)(MIX + tok * DM + 768 + lane * 8) = pack8(f); }
    __syncthreads();
}

struct ScanRegs { u32x4 zr, zrp, zk, zkp, zv, zvp, aq, eq; };
constexpr int SSTEP = 392;
DI float rsum8(float x) { x += dppf<0xB1>(x); x += dppf<0x4E>(x); x += dppf<0x141>(x); return x; }
DI void scan_load(ScanRegs& R, const bf16_t* Z, const bf16_t* RWA, const bf16_t* RWD, int b, int h, int t, int l8) {
    const size_t tok = (size_t)b * SEQ + t; const bf16_t* zr = Z + tok * NINP + 3328 + h * 64 + l8 * 8;
    const bf16_t* zq = t > 0 ? zr - NINP : zr;
    R.zr = *(const u32x4*)(zr); R.zk = *(const u32x4*)(zr + 768); R.zv = *(const u32x4*)(zr + 1536);
    const unsigned msk = t > 0 ? 0xffffffffu : 0u;
    R.zrp = *(const u32x4*)(zq) & msk; R.zkp = *(const u32x4*)(zq + 768) & msk; R.zvp = *(const u32x4*)(zq + 1536) & msk;
    R.aq = *(const u32x4*)(RWA + tok * 768 + h * 64 + l8 * 8); R.eq = *(const u32x4*)(RWD + tok * 768 + h * 64 + l8 * 8);
}
DI void unpack8v(const u32x4 w, float (&f)[8]) { f[0] = bflo(w.x); f[1] = bfhi(w.x); f[2] = bflo(w.y); f[3] = bfhi(w.y); f[4] = bflo(w.z); f[5] = bfhi(w.z); f[6] = bflo(w.w); f[7] = bfhi(w.w); }
DI void lerp8(const u32x4 c, const u32x4 pv, const float* mu, float (&o)[8]) {
    float cc[8], pp[8]; unpack8v(c, cc); unpack8v(pv, pp);
#pragma unroll
    for (int e = 0; e < 8; ++e) o[e] = cc[e] + (pp[e] - cc[e]) * mu[e];
}
DI void phase_scan(const int ctx_tid, const int ctx_bid, const int ctx_g, const PView& p, int l, int sb, LAS unsigned char* lds) {
#ifdef NO_SCAN
    return;
#endif
    unsigned char* ws = p.ws; const bf16_t* Z = (const bf16_t*)(ws + OFF_Z); const bf16_t* RWA = (const bf16_t*)(ws + OFF_RWA); const bf16_t* RWD = (const bf16_t*)(ws + OFF_RWD);
    float* YR = (float*)(ws + OFF_YR); float* BON = (float*)(ws + OFF_BON);
    const int tid = ctx_tid, w = tid >> 6, lane = tid & 63, l8 = lane & 7;
    const int part = sb & 1, bh = sb >> 1, b = bh / 12, h = bh % 12;
    const int row0 = part * 32, nscan = 4;
    const bool scanner = w < nscan;
    const int half = part;
    const int ts = (tid & 255) >> 3;
    const int row = row0 + (w & 3) * 8 + (lane >> 3);
    LAS float* buf = (LAS float*)lds;
    if (w >= 4) {
        const float* mub = p.in[12] + (size_t)l * 2688 + h * 64 + l8 * 8;
        float mur[8], muk[8], muv[8], kk8[8], ka8[8], rk8[8];
#pragma unroll
        for (int e = 0; e < 8; ++e) { mur[e] = mub[e]; muk[e] = mub[768 + e]; muv[e] = mub[1536 + e];
            kk8[e] = p.in[18][(size_t)l * 768 + h * 64 + l8 * 8 + e]; ka8[e] = p.in[19][(size_t)l * 768 + h * 64 + l8 * 8 + e]; rk8[e] = p.in[20][(size_t)l * 768 + h * 64 + l8 * 8 + e]; }
        ScanRegs R;
        auto process = [&](int stage, int t) {
            float r8[8], k8[8], v8[8]; lerp8(R.zr, R.zrp, mur, r8); lerp8(R.zk, R.zkp, muk, k8); lerp8(R.zv, R.zvp, muv, v8);
            float a8[8], w8[8]; unpack8v(R.aq, a8); unpack8v(R.eq, w8);
#pragma unroll
            for (int e = 0; e < 8; ++e) w8[e] = __expf(-w8[e]);
            float kkv[8], n2 = 0.f;
#pragma unroll
            for (int e = 0; e < 8; ++e) { kkv[e] = k8[e] * kk8[e]; n2 += kkv[e] * kkv[e]; }
            n2 = rsum8(n2); const float inv = 1.0f / fmaxf(sqrtf(n2), 1e-12f);
            float kp[8], bb[8], nk[8], bon = 0.f;
#pragma unroll
            for (int e = 0; e < 8; ++e) { const float kh = kkv[e] * inv; nk[e] = -kh; bb[e] = kh * a8[e]; kp[e] = k8[e] * (1.0f + (a8[e] - 1.0f) * ka8[e]);
                bon += r8[e] * kp[e] * rk8[e]; }
            bon = rsum8(bon);
            LAS float* d = buf + (stage * 32 + ts) * SSTEP + l8 * 8;
#pragma unroll
            for (int q = 0; q < 2; ++q) {
                *(LAS f32x4*)(d + q * 4) = (f32x4){w8[q * 4], w8[q * 4 + 1], w8[q * 4 + 2], w8[q * 4 + 3]}; *(LAS f32x4*)(d + 64 + q * 4) = (f32x4){nk[q * 4], nk[q * 4 + 1], nk[q * 4 + 2], nk[q * 4 + 3]};
                *(LAS f32x4*)(d + 128 + q * 4) = (f32x4){bb[q * 4], bb[q * 4 + 1], bb[q * 4 + 2], bb[q * 4 + 3]}; *(LAS f32x4*)(d + 192 + q * 4) = (f32x4){kp[q * 4], kp[q * 4 + 1], kp[q * 4 + 2], kp[q * 4 + 3]};
                *(LAS f32x4*)(d + 256 + q * 4) = (f32x4){r8[q * 4], r8[q * 4 + 1], r8[q * 4 + 2], r8[q * 4 + 3]}; *(LAS f32x4*)(d + 320 + q * 4) = (f32x4){v8[q * 4], v8[q * 4 + 1], v8[q * 4 + 2], v8[q * 4 + 3]}; }
            if (l8 == 0 && half == 0) BON[((size_t)b * SEQ + t) * 12 + h] = bon;
        };
        scan_load(R, Z, RWA, RWD, b, h, ts, l8);
        process(0, ts);
        scan_load(R, Z, RWA, RWD, b, h, 32 + ts, l8);
        __syncthreads();
        for (int ci = 0; ci < SEQ / 32; ++ci) {
            if (ci + 1 < SEQ / 32) { process((ci + 1) & 1, (ci + 1) * 32 + ts); if (ci + 2 < SEQ / 32) scan_load(R, Z, RWA, RWD, b, h, (ci + 2) * 32 + ts, l8); }
            __syncthreads();
        }
    } else if (!scanner) {
        __syncthreads();
        for (int ci = 0; ci < SEQ / 32; ++ci) __syncthreads();
    } else {
        __builtin_amdgcn_s_setprio(3);
        f32x2 S[4];
#pragma unroll
        for (int i = 0; i < 4; ++i) S[i] = (f32x2){0.f, 0.f};
        __syncthreads();
        for (int ci = 0; ci < SEQ / 32; ++ci) {
            const int t0 = ci * 32;
            const LAS float* sbuf = buf + (ci & 1) * 32 * SSTEP;
            float yk[4];
            const LAS float* d0 = sbuf + l8 * 8;
            f32x4 W0 = *(const LAS f32x4*)(d0), W1 = *(const LAS f32x4*)(d0 + 4), N0 = *(const LAS f32x4*)(d0 + 64), N1 = *(const LAS f32x4*)(d0 + 68), B0 = *(const LAS f32x4*)(d0 + 128), B1 = *(const LAS f32x4*)(d0 + 132),
                  K0 = *(const LAS f32x4*)(d0 + 192), K1 = *(const LAS f32x4*)(d0 + 196), R0 = *(const LAS f32x4*)(d0 + 256), R1 = *(const LAS f32x4*)(d0 + 260);
            float vv = sbuf[320 + row];
            const bool b0 = (l8 & 1) != 0, b1 = (l8 & 2) != 0, b2 = (l8 & 4) != 0;
#pragma unroll
            for (int hh = 0; hh < 4; ++hh) {
                float pp[8];
#pragma unroll
                for (int s8 = 0; s8 < 8; ++s8) {
                    const int s = hh * 8 + s8; const int sn = s < 31 ? s + 1 : 31;
                    const LAS float* dn = sbuf + sn * SSTEP + l8 * 8;
                    const f32x4 nW0 = *(const LAS f32x4*)(dn), nW1 = *(const LAS f32x4*)(dn + 4), nN0 = *(const LAS f32x4*)(dn + 64), nN1 = *(const LAS f32x4*)(dn + 68), nB0 = *(const LAS f32x4*)(dn + 128), nB1 = *(const LAS f32x4*)(dn + 132),
                                nK0 = *(const LAS f32x4*)(dn + 192), nK1 = *(const LAS f32x4*)(dn + 196), nR0 = *(const LAS f32x4*)(dn + 256), nR1 = *(const LAS f32x4*)(dn + 260);
                    const float nvv = sbuf[sn * SSTEP + 320 + row];
                    const f32x2 d1v = (S[0] * (f32x2){N0.x, N0.y} + S[1] * (f32x2){N0.z, N0.w}) + (S[2] * (f32x2){N1.x, N1.y} + S[3] * (f32x2){N1.z, N1.w});
                    const float sa = rsum8(d1v.x + d1v.y);
                    const f32x2 sa2 = {sa, sa}, vv2 = {vv, vv};
                    S[0] = S[0] * (f32x2){W0.x, W0.y} + (sa2 * (f32x2){B0.x, B0.y} + vv2 * (f32x2){K0.x, K0.y});
                    S[1] = S[1] * (f32x2){W0.z, W0.w} + (sa2 * (f32x2){B0.z, B0.w} + vv2 * (f32x2){K0.z, K0.w});
                    S[2] = S[2] * (f32x2){W1.x, W1.y} + (sa2 * (f32x2){B1.x, B1.y} + vv2 * (f32x2){K1.x, K1.y});
                    S[3] = S[3] * (f32x2){W1.z, W1.w} + (sa2 * (f32x2){B1.z, B1.w} + vv2 * (f32x2){K1.z, K1.w});
                    const f32x2 yv = (S[0] * (f32x2){R0.x, R0.y} + S[1] * (f32x2){R0.z, R0.w}) + (S[2] * (f32x2){R1.x, R1.y} + S[3] * (f32x2){R1.z, R1.w});
                    pp[s8] = yv.x + yv.y;
                    W0 = nW0; W1 = nW1; N0 = nN0; N1 = nN1; B0 = nB0; B1 = nB1; K0 = nK0; K1 = nK1; R0 = nR0; R1 = nR1; vv = nvv;
                }
                float q4[4], r2[2];
#pragma unroll
                for (int i = 0; i < 4; ++i) q4[i] = (b0 ? pp[2 * i + 1] : pp[2 * i]) + dppf<0xB1>(b0 ? pp[2 * i] : pp[2 * i + 1]);
#pragma unroll
                for (int i = 0; i < 2; ++i) r2[i] = (b1 ? q4[2 * i + 1] : q4[2 * i]) + dppf<0x4E>(b1 ? q4[2 * i] : q4[2 * i + 1]);
                { const float keep = b2 ? r2[1] : r2[0], send = b2 ? r2[0] : r2[1];
                  int xr = __builtin_amdgcn_update_dpp(0, __float_as_int(send), 0x104, 0xF, 0x5, false);
                  xr = __builtin_amdgcn_update_dpp(xr, __float_as_int(send), 0x114, 0xF, 0xA, false);
                  yk[hh] = keep + __int_as_float(xr); }
            }
            { float* yo = YR + ((size_t)b * SEQ + t0 + l8) * 768 + h * 64 + row;
#pragma unroll
              for (int hh = 0; hh < 4; ++hh) yo[(size_t)hh * 8 * 768] = yk[hh]; }
            __syncthreads();
        }
        __builtin_amdgcn_s_setprio(0);
    }
}

template <int PART>
DI void phase_mixpost(const int ctx_tid, const int ctx_bid, const int ctx_g, const PView& p, int l, int gw, int nw, const bool xm = false) {
#ifdef NO_POST
    return;
#endif
    unsigned char* ws = p.ws; const bf16_t* Z = (const bf16_t*)(ws + OFF_Z); const bf16_t* AP = (const bf16_t*)(ws + OFF_AP); const float* LSE = (const float*)(ws + OFF_LSE);
    const bf16_t* RWG = (const bf16_t*)(ws + OFF_RWG); const float* YR = (const float*)(ws + OFF_YR); const float* BON = (const float*)(ws + OFF_BON); bf16_t* MIX = (bf16_t*)(ws + OFF_MIX);
    const float* aog = p.in[7] + (size_t)l * 768; const float* muv = p.in[12] + (size_t)l * 2688 + 1536; const float* lg = p.in[21] + (size_t)l * 768; const float* lb = p.in[22] + (size_t)l * 768;
    const int lane = ctx_tid & 63;
    const int hq = lane >> 4, dq = (lane & 15) * 4;
    f32x4 g_a[3], g_mu[3], g_lg[3], g_lb[3];
#pragma unroll
    for (int i = 0; i < 3; ++i) { const int c = (hq + 4 * i) * 64 + dq; g_a[i] = *(const f32x4*)(aog + c); g_mu[i] = *(const f32x4*)(muv + c); g_lg[i] = *(const f32x4*)(lg + c); g_lb[i] = *(const f32x4*)(lb + c); }
    for (int ti = 0; ; ++ti) { const int t = xm ? xcd_row(ctx_bid, __builtin_amdgcn_readfirstlane(ctx_tid >> 6), ctx_g, ti) : gw + ti * nw; if (t >= T) break;
        const bool hasp = (t % SEQ) != 0;
        if (PART == 1) {
            u32x2 ap[3][3]; float lse[3][3];
#pragma unroll
            for (int i = 0; i < 3; ++i) { const int j = hq + 4 * i, c = j * 64 + dq;
#pragma unroll
                for (int q = 0; q < 3; ++q) { lse[q][i] = LSE[((size_t)q * T + t) * 12 + j]; ap[q][i] = __builtin_nontemporal_load((const u32x2*)(AP + ((size_t)q * T + t) * 768 + c)); } }
            f32x4 oa[3]; float ss = 0.f;
#pragma unroll
            for (int i = 0; i < 3; ++i) {
                const float l0 = lse[0][i], l1 = lse[1][i], l2 = lse[2][i];
                const float mx = fmaxf(l0, fmaxf(l1, l2)); const float e0 = __expf(l0 - mx), e1 = __expf(l1 - mx), e2 = __expf(l2 - mx); const float inv = 1.0f / (e0 + e1 + e2);
                const f32x4 a0 = {bflo(ap[0][i].x), bfhi(ap[0][i].x), bflo(ap[0][i].y), bfhi(ap[0][i].y)}, a1 = {bflo(ap[1][i].x), bfhi(ap[1][i].x), bflo(ap[1][i].y), bfhi(ap[1][i].y)}, a2 = {bflo(ap[2][i].x), bfhi(ap[2][i].x), bflo(ap[2][i].y), bfhi(ap[2][i].y)};
                oa[i] = (a0 * e0 + a1 * e1 + a2 * e2) * inv; ss += oa[i][0] * oa[i][0] + oa[i][1] * oa[i][1] + oa[i][2] * oa[i][2] + oa[i][3] * oa[i][3]; }
            const float rs = rsqrtf(wsum(ss) * (1.0f / 768.0f) + 1e-6f);
#pragma unroll
            for (int i = 0; i < 3; ++i) { const int c = (hq + 4 * i) * 64 + dq; const f32x4 o1 = oa[i] * rs * g_a[i];
                u32x2 w1; w1.x = pack2(o1[0], o1[1]); w1.y = pack2(o1[2], o1[3]); *(u32x2*)(MIX + (size_t)t * DM + c) = w1; }
        } else {
            u32x2 rg[3], zc[3], zp[3]; float bon[3]; f32x4 yr[3];
#pragma unroll
            for (int i = 0; i < 3; ++i) { const int j = hq + 4 * i, c = j * 64 + dq;
                bon[i] = BON[(size_t)t * 12 + j]; yr[i] = __builtin_nontemporal_load((const f32x4*)(YR + (size_t)t * 768 + c)); rg[i] = __builtin_nontemporal_load((const u32x2*)(RWG + (size_t)t * 768 + c));
                zc[i] = *(const u32x2*)(Z + (size_t)t * NINP + 4864 + c); zp[i] = hasp ? *(const u32x2*)(Z + (size_t)(t - 1) * NINP + 4864 + c) : (u32x2){0u, 0u}; }
#pragma unroll
            for (int i = 0; i < 3; ++i) {
                const f32x4 y = yr[i]; const float mean = rsum16((y[0] + y[1]) + (y[2] + y[3])) * (1.0f / 64.0f); const f32x4 yc = y - mean;
                const float var = rsum16((yc[0] * yc[0] + yc[1] * yc[1]) + (yc[2] * yc[2] + yc[3] * yc[3])) * (1.0f / 64.0f);
                f32x4 yn = yc * rsqrtf(var + 64e-5f) * g_lg[i] + g_lb[i];
                const f32x4 vc = {bflo(zc[i].x), bfhi(zc[i].x), bflo(zc[i].y), bfhi(zc[i].y)}, vp = {bflo(zp[i].x), bfhi(zp[i].x), bflo(zp[i].y), bfhi(zp[i].y)};
                const f32x4 vs = vc + (vp - vc) * g_mu[i];
                yn += vs * bon[i];
                const f32x4 gg = {bflo(rg[i].x), bfhi(rg[i].x), bflo(rg[i].y), bfhi(rg[i].y)};
                const f32x4 o2 = yn * gg; const int c = (hq + 4 * i) * 64 + dq;
                u32x2 w2; w2.x = pack2(o2[0], o2[1]); w2.y = pack2(o2[2], o2[3]); *(u32x2*)(MIX + (size_t)t * DM + 1280 + c) = w2; }
        }
    }
}

DI void phase_convfix(const int ctx_tid, const int ctx_bid, const int ctx_g, const PView& p, int l) {
#ifdef NO_CONV
    return;
#endif
    unsigned char* ws = p.ws; bf16_t* ACT = (bf16_t*)(ws + OFF_ACT); const float* HALO = (const float*)(ws + OFF_HALO); const float* PART = (const float*)(ws + OFF_PART);
    const float* cw = p.in[27] + (size_t)l * 3 * NUP;
    const int gt = ctx_bid * 512 + ctx_tid, ng = ctx_g * 512;
    for (int it = gt; it < (T / 128) * 2 * (DFF / 4); it += ng) {
        const int c = (it % (DFF / 4)) * 4, gr = it / (DFF / 4), r = gr & 1, g = gr >> 1;
        const int colp = (c >> 7) * 256 + (c & 127);
        f32x4 pg = *(const f32x4*)(PART + ((size_t)g * 2 + r) * NUP + colp), pv = *(const f32x4*)(PART + ((size_t)g * 2 + r) * NUP + colp + 128);
        if ((g * 128) % SEQ != 0) {
            const f32x4 g1 = *(const f32x4*)(HALO + ((size_t)(g - 1) * 2 + 1) * NUP + colp), v1 = *(const f32x4*)(HALO + ((size_t)(g - 1) * 2 + 1) * NUP + colp + 128);
            const f32x4 g2 = *(const f32x4*)(HALO + ((size_t)(g - 1) * 2) * NUP + colp), v2 = *(const f32x4*)(HALO + ((size_t)(g - 1) * 2) * NUP + colp + 128);
            const f32x4 wg0 = *(const f32x4*)(cw + c), wg1 = *(const f32x4*)(cw + NUP + c), wv0 = *(const f32x4*)(cw + DFF + c), wv1 = *(const f32x4*)(cw + NUP + DFF + c);
            if (r == 0) { pg += wg1 * g1 + wg0 * g2; pv += wv1 * v1 + wv0 * v2; } else { pg += wg0 * g1; pv += wv0 * v1; }
        }
        uint2 w; w.x = pack2(gelu_t(pg[0]) * pv[0], gelu_t(pg[1]) * pv[1]); w.y = pack2(gelu_t(pg[2]) * pv[2], gelu_t(pg[3]) * pv[3]);
        *(uint2*)(ACT + (size_t)(g * 128 + r) * DFF + c) = w;
    }
}

DI void run_gemm_bf16(const int ctx_tid, const int ctx_bid, const int ctx_g, LAS unsigned char* lds, const bf16_t* A, const bf16_t* Bt, int M, int N, int K, bf16_t* O, int ldc, int G, int c) {
#ifdef NO_GEMM
    return;
#endif
    pg8::Gemm g{A, Bt, M, N, K}; pg8::StaticOrder S; S.init(M, N, G, c); pg8::EpiBf16 E{O, ldc};
    pg8::gemm_phase<pg8::EpiBf16, pg8::StaticOrder, false>(ctx_tid, lds, g, S, E, nullptr);
}
DI void run_gemm_f32(const int ctx_tid, const int ctx_bid, const int ctx_g, LAS unsigned char* lds, const bf16_t* A, const bf16_t* Bt, int M, int N, int K, float* C, int ldc, int G, int c) {
#ifdef NO_GEMM
    return;
#endif
    pg8::Gemm g{A, Bt, M, N, K}; pg8::StaticOrder S; S.init(M, N, G, c); pg8::EpiF32 E{C, ldc, nullptr};
    pg8::gemm_phase<pg8::EpiF32, pg8::StaticOrder, false>(ctx_tid, lds, g, S, E, nullptr);
}

DI void run_gemm_conv(const int ctx_tid, const int ctx_bid, const int ctx_g, LAS unsigned char* lds, const bf16_t* A, const bf16_t* Bt, int M, int N, int K, bf16_t* ACT, const float* cw, const float* cb, float* HALO, float* PARTB, int G, int c) {
#ifdef NO_GEMM
    return;
#endif
    pg8::Gemm g{A, Bt, M, N, K}; pg8::StaticOrder S; S.init(M, N, G, c); pg8::EpiConv E{ACT, cw, cb, HALO, PARTB, DFF, NUP};
    pg8::gemm_phase<pg8::EpiConv, pg8::StaticOrder, false>(ctx_tid, lds, g, S, E, nullptr);
}
#define XB_TMO      128
#define XB_XCNT(j)  (256  + 64 * (j))
#define XB_XSUB(j)  (1280 + 64 * (j))
#define XB_XGEN(j)  (2304 + 64 * (j))
#define XB_TOP      3328
#define XB_TOPGEN   3392
#define XCD_BAR_WORDS 3456
#define XB_SPIN_CAP (1u << 18)

__device__ __forceinline__ unsigned xb_ld(unsigned* p)              { return __hip_atomic_load(p, __ATOMIC_RELAXED, __HIP_MEMORY_SCOPE_AGENT); }
__device__ __forceinline__ unsigned xb_add(unsigned* p, unsigned v) { return __hip_atomic_fetch_add(p, v, __ATOMIC_RELAXED, __HIP_MEMORY_SCOPE_AGENT); }
__device__ __forceinline__ unsigned xb_xcc_id() { return (unsigned)__builtin_amdgcn_s_getreg((3 << 11) | 20) & 0xFu; }
#define XB_SPIN(cond, bar) do { unsigned _sp = 0; while (cond) { __builtin_amdgcn_s_sleep(1); \
    if ((++_sp & 255u) == 0u) { if (xb_ld(&(bar)[XB_TMO])) break; if (_sp > XB_SPIN_CAP) { atomicAdd(&(bar)[XB_TMO], 1u); break; } } } } while (0)
struct XcdBarrier {
    unsigned* bar; unsigned x;
    volatile LAS unsigned* st;
};

__device__ __forceinline__ XcdBarrier xcd_barrier_post(unsigned* bar, volatile LAS unsigned* st, const bool tid0) {
    XcdBarrier b; b.bar = bar; b.x = xb_xcc_id(); b.st = st;
    if (tid0) (void)xb_add(&bar[XB_XCNT(b.x)], 1u);
    return b;
}
__device__ __forceinline__ void xcd_barrier_complete(unsigned* bar, unsigned x, unsigned& nloc, unsigned& nx) {
    const unsigned G = gridDim.x * gridDim.y * gridDim.z;
    unsigned sum, cnt, mine, sp = 0u;
    for (;;) {
        sum = 0u; cnt = 0u; mine = 0u;
#pragma unroll
        for (unsigned j = 0; j < 16; ++j) { const unsigned c = xb_ld(&bar[XB_XCNT(j)]); sum += c; cnt += (c > 0u) ? 1u : 0u; mine = (j == x) ? c : mine; }
        if (sum == G) break;
        __builtin_amdgcn_s_sleep(1);
        if ((++sp & 255u) == 0u) { if (xb_ld(&bar[XB_TMO])) break; if (sp > XB_SPIN_CAP) { atomicAdd(&bar[XB_TMO], 1u); break; } }
    }
    nloc = mine > 0u ? mine : 1u; nx = cnt > 0u ? cnt : 1u;
}

__device__ __forceinline__ void xcd_barrier(const XcdBarrier& b, const bool tid0) {
    asm volatile("s_waitcnt vmcnt(0)" ::: "memory");
    __syncthreads();
    if (tid0) {
        unsigned* bar = b.bar;
        __builtin_amdgcn_s_waitcnt(0);
        unsigned nloc = b.st[0], nx = b.st[1];
        if (nloc == 0u) { xcd_barrier_complete(bar, b.x, nloc, nx); b.st[0] = nloc; b.st[1] = nx; }
        const unsigned old = xb_add(&bar[XB_XSUB(b.x)], 1u);
        const unsigned gen = old / nloc;
        if (old + 1u == (gen + 1u) * nloc) {
            __builtin_amdgcn_fence(__ATOMIC_RELEASE, "agent");
            asm volatile("s_waitcnt vmcnt(0)" ::: "memory");
            const unsigned og = xb_add(&bar[XB_TOP], 1u);
            const unsigned tg = og / nx;
            if (og + 1u == (tg + 1u) * nx) xb_add(&bar[XB_TOPGEN], 1u);
            else XB_SPIN(xb_ld(&bar[XB_TOPGEN]) == tg, bar);
            __builtin_amdgcn_fence(__ATOMIC_ACQUIRE, "agent");
            xb_add(&bar[XB_XGEN(b.x)], 1u);
            asm volatile("s_waitcnt vmcnt(0)" ::: "memory");
        } else {
            XB_SPIN(xb_ld(&bar[XB_XGEN(b.x)]) == gen, bar);
            __builtin_amdgcn_fence(__ATOMIC_ACQUIRE, "agent");
            asm volatile("s_waitcnt vmcnt(0)" ::: "memory");
        }
    }
    __syncthreads();
}

DI void sub_barrier(unsigned* cnt, unsigned target, const bool tid0) {
    asm volatile("s_waitcnt vmcnt(0)" ::: "memory");
    __syncthreads();
    if (tid0) {
        __builtin_amdgcn_fence(__ATOMIC_RELEASE, "agent"); asm volatile("s_waitcnt vmcnt(0)" ::: "memory");
        (void)__hip_atomic_fetch_add(cnt, 1u, __ATOMIC_RELAXED, __HIP_MEMORY_SCOPE_AGENT);
        unsigned sp = 0;
        while (__hip_atomic_load(cnt, __ATOMIC_RELAXED, __HIP_MEMORY_SCOPE_AGENT) < target) { __builtin_amdgcn_s_sleep(2); if (++sp > (1u << 22)) break; }
        __builtin_amdgcn_fence(__ATOMIC_ACQUIRE, "agent"); asm volatile("s_waitcnt vmcnt(0)" ::: "memory");
    }
    __syncthreads();
}
__global__ __launch_bounds__(512, 2) void mega(Params pin, int ph_lo, int ph_hi) {
    extern __shared__ __attribute__((aligned(16))) unsigned char shm[];
    LAS unsigned char* lds = (LAS unsigned char*)shm;
    const int gridDim_x0 = (int)gridDim.x;
    const int wave_sgpr = __builtin_amdgcn_readfirstlane((int)(threadIdx.x >> 6));
    volatile LAS unsigned* xb_st = (volatile LAS unsigned*)(lds + LDS_BYTES - 16);
    if (threadIdx.x == 0) { xb_st[0] = 0u; xb_st[1] = 0u; xb_st[2] = 0u; xb_st[3] = 0u; }
    __syncthreads();
    XcdBarrier xb; xb.bar = (unsigned*)(pin.ws + OFF_CTL); xb.x = 0; xb.st = xb_st;
    if (ph_hi - ph_lo > 1) xb = xcd_barrier_post((unsigned*)(pin.ws + OFF_CTL), xb_st, threadIdx.x == 0);
    if (ph_lo < 0) cg::this_grid().sync();
    for (int ph = ph_lo; ph < ph_hi; ++ph) {
        if (ph == NPL && ph > ph_lo) continue;
        if (ph > ph_lo) {
            xcd_barrier(xb, wave_sgpr == 0 && (int)__builtin_amdgcn_mbcnt_hi(~0u, __builtin_amdgcn_mbcnt_lo(~0u, 0u)) == 0);
#ifdef EXTRA_SYNCS
            for (int es = 0; es < EXTRA_SYNCS; ++es) xcd_barrier(xb, wave_sgpr == 0 && (int)__builtin_amdgcn_mbcnt_hi(~0u, __builtin_amdgcn_mbcnt_lo(~0u, 0u)) == 0);
#endif
        }
        const int l = ph / NPL, lp = ph % NPL;
        const int nrep = ((REP_MASK >> lp) & 1) ? 2 : 1;
        for (int rep = 0; rep < nrep; ++rep) {
        if (rep) xcd_barrier(xb, wave_sgpr == 0 && (int)__builtin_amdgcn_mbcnt_hi(~0u, __builtin_amdgcn_mbcnt_lo(~0u, 0u)) == 0);
        size_t zero = 0; asm volatile("" : "+s"(zero));
        int wv_ = wave_sgpr; asm volatile("" : "+s"(wv_));
        int ctx_tid = wv_ * 64 + (int)__builtin_amdgcn_mbcnt_hi(~0u, __builtin_amdgcn_mbcnt_lo(~0u, 0u)); asm volatile("" : "+v"(ctx_tid));
        int ctx_bid = blockIdx.x; asm volatile("" : "+s"(ctx_bid));
        int ctx_g = (int)gridDim_x0; asm volatile("" : "+s"(ctx_g));
        const int bid = ctx_bid, G = ctx_g;
        PView p; p.in.pp = &pin; p.in.zero = zero; p.out = pin.out + zero; p.ws = pin.ws + zero;
        unsigned char* ws = p.ws; bf16_t* HB = (bf16_t*)(ws + OFF_HB);
        const float* gains = p.in[3] + (size_t)l * 6 * DM;
        int gk = 0; const bf16_t* gA = nullptr; const bf16_t* gB = nullptr; int gM = 0, gN = 0, gK = 0, gld = 0, gG = G, gc = bid; void* gO = nullptr;
        switch (lp) {
        case 0: phase_cvt(ctx_tid, ctx_bid, ctx_g, p, l, lds); break;
        case 1: gk = 1; gA = HB; gB = (const bf16_t*)(ws + OFF_WIN) + (size_t)3072 * DM; gM = T; gN = NINP - 3072; gK = DM; gO = (bf16_t*)(ws + OFF_Z) + 3072; gld = NINP; break;
        case 2: phase_rwkv_prep(ctx_tid, ctx_bid, ctx_g, p, l, lds); break;
        case 3:
            if (bid < SCAN_BLOCKS) { if (!(rep && P3_MODE == 2)) phase_scan(ctx_tid, ctx_bid, ctx_g, p, l, bid, lds); }
            else if (!(rep && P3_MODE == 1)) { gk = 1; gA = HB; gB = (const bf16_t*)(ws + OFF_WIN); gM = T; gN = 3072; gK = DM; gO = ws + OFF_Z; gld = NINP; gG = G - SCAN_BLOCKS; gc = bid - SCAN_BLOCKS; }
            break;
        case 4: phase_mixpost<2>(ctx_tid, ctx_bid, ctx_g, p, l, ctx_bid * 8 + __builtin_amdgcn_readfirstlane(ctx_tid >> 6), ctx_g * 8, true); break;
        case 5: gk = 1; gA = (const bf16_t*)(ws + OFF_MIX); gB = (const bf16_t*)(ws + OFF_WOUT); gM = T; gN = DM; gK = DM; gO = ws + OFF_Y; gld = DM; break;
        case 6: if (l == 0) phase_resid<true, false>(ctx_tid, ctx_bid, ctx_g, (const bf16_t*)(ws + OFF_Y), p.in[0], ws + OFF_XB, gains + DM, gains + 2 * DM, HB);
                else phase_resid<false, false>(ctx_tid, ctx_bid, ctx_g, (const bf16_t*)(ws + OFF_Y), ws + OFF_XB, ws + OFF_XB, gains + DM, gains + 2 * DM, HB);
                break;
        case 7: { const int nh = G / 2;
            if (bid < nh) { gk = 1; gA = HB; gB = (const bf16_t*)(ws + OFF_WQ); gM = T; gN = 512; gK = DM; gO = ws + OFF_Q; gld = 512; gG = nh; gc = bid; }
            else { gk = 1; gA = (const bf16_t*)(ws + OFF_MEMN); gB = (const bf16_t*)(ws + OFF_WKV); gM = 1024; gN = 1024; gK = DM; gO = ws + OFF_KV; gld = 1024; gG = G - nh; gc = bid - nh; } } break;
        case 8: { int last_kv = -1; for (int it = bid; it < 512; it += G) { cross_item(ctx_tid, ctx_bid, ctx_g, p, it, (it & 15) != last_kv, lds); last_kv = it & 15; } } break;
        case 9: gk = 1; gA = (const bf16_t*)(ws + OFF_O); gB = (const bf16_t*)(ws + OFF_WO); gM = T; gN = DM; gK = 512; gO = ws + OFF_Y; gld = DM; break;
        case 10: phase_resid<false, false>(ctx_tid, ctx_bid, ctx_g, (const bf16_t*)(ws + OFF_Y), ws + OFF_XB, ws + OFF_XB, gains + 3 * DM, gains + 4 * DM, HB); break;
        case 11: gk = 3; gA = HB; gB = (const bf16_t*)(ws + OFF_WUP); gM = T; gN = NUP; gK = DM; gO = ws + OFF_ACT; break;
        case 12: phase_convfix(ctx_tid, ctx_bid, ctx_g, p, l); break;
        case 13: gk = 1; gA = (const bf16_t*)(ws + OFF_ACT); gB = (const bf16_t*)(ws + OFF_WDN); gM = T; gN = DM; gK = DFF; gO = ws + OFF_Y; gld = DM; break;
        case 14: if (l + 1 < 2) phase_resid<false, false>(ctx_tid, ctx_bid, ctx_g, (const bf16_t*)(ws + OFF_Y), ws + OFF_XB, ws + OFF_XB, gains + 5 * DM, gains + 6 * DM, HB);
                 else phase_resid<false, true>(ctx_tid, ctx_bid, ctx_g, (const bf16_t*)(ws + OFF_Y), ws + OFF_XB, p.out, gains + 5 * DM, nullptr, HB);
                 if (l == 0 && ph_hi - ph_lo > 1) phase_cvt(ctx_tid, ctx_bid, ctx_g, p, 1, lds);
                 break;
        }
        if (gk == 1) run_gemm_bf16(ctx_tid, ctx_bid, ctx_g, lds, gA, gB, gM, gN, gK, (bf16_t*)gO, gld, gG, gc);
        else if (gk == 3) run_gemm_conv(ctx_tid, ctx_bid, ctx_g, lds, gA, gB, gM, gN, gK, (bf16_t*)gO, p.in[27] + (size_t)l * 3 * NUP, p.in[28] + (size_t)l * NUP, (float*)(ws + OFF_HALO), (float*)(ws + OFF_PART), gG, gc);
        if (lp == 3 && bid >= SCAN_BLOCKS && !(rep && P3_MODE == 1)) {
            const int nb = G - SCAN_BLOCKS; int it = bid - SCAN_BLOCKS;
            sub_barrier((unsigned*)(ws + OFF_CTL) + 3584 + 64 * (l * 2 + rep), (unsigned)nb, ctx_tid == 0);
#ifndef NO_SGU
            for (; it < 128; it += nb) sgu_item(ctx_tid, ctx_bid, ctx_g, p, l, it, lds);
#endif
#ifndef NO_DIL
            u32x4 kq[4]; u32x2 vq[8]; bf16x8 qc[2], qn[2]; float btv; int item = it - 128;
            dil_load(ctx_tid, p, item < 4608 ? item : 4607, kq, vq, qc, btv);
            for (; item < 4608; item += nb) {
                dil_stage(ctx_tid, p, item, kq, vq, btv, lds); __syncthreads();
                dil_load(ctx_tid, p, item + nb < 4608 ? item + nb : 4607, kq, vq, qn, btv);
                dil_compute(ctx_tid, ctx_bid, ctx_g, p, item, qc, lds); __syncthreads();
                qc[0] = qn[0]; qc[1] = qn[1]; }
#endif
            sub_barrier((unsigned*)(ws + OFF_CTL) + 3840 + 64 * (l * 2 + rep), (unsigned)nb, ctx_tid == 0);
            phase_mixpost<1>(ctx_tid, ctx_bid, ctx_g, p, l, (bid - SCAN_BLOCKS) * 8 + __builtin_amdgcn_readfirstlane(ctx_tid >> 6), nb * 8);
        }
        }
    }
}

#ifndef MK_SINGLE
#define MK_SINGLE 1
#endif
extern "C" void kernel_launch(void* const* d_in, const int* in_sizes, int n_in, void* d_out, int out_size, void* d_ws, size_t ws_size, hipStream_t stream) {
    (void)in_sizes; (void)out_size;
    if (n_in < 30 || ws_size < WS_NEED) { fprintf(stderr, "kernel_launch: bad arguments (n_in %d, ws %zu < %zu)\n", n_in, ws_size, (size_t)WS_NEED); return; }
    Params p{};
    for (int i = 0; i < 30; ++i) p.in[i] = (const float*)d_in[i];
    p.out = (float*)d_out; p.ws = (unsigned char*)d_ws;
    hipFuncSetAttribute((const void*)mega, hipFuncAttributeMaxDynamicSharedMemorySize, LDS_BYTES);
    int dev = 0, cus = 0, per_cu = 0;
    hipGetDevice(&dev); hipDeviceGetAttribute(&cus, hipDeviceAttributeMultiprocessorCount, dev);
    hipOccupancyMaxActiveBlocksPerMultiprocessor(&per_cu, mega, 512, LDS_BYTES);
    if (per_cu < 1) per_cu = 1;
    int grid = cus * per_cu; if (grid > 256) grid = 256; if (grid < 128) grid = 128;
    if (hipMemsetAsync((unsigned char*)d_ws + OFF_CTL, 0, CTL_BYTES, stream) != hipSuccess) { fprintf(stderr, "kernel_launch: memset of the barrier words failed\n"); return; }
#if MK_SINGLE
    int lo = 0, hi = 2 * NPL; void* args[] = {&p, &lo, &hi};
    hipError_t e = hipLaunchCooperativeKernel((void*)mega, dim3(grid), dim3(512), args, LDS_BYTES, stream);
    if (e != hipSuccess) fprintf(stderr, "cooperative launch failed: %s (grid %d)\n", hipGetErrorString(e), grid);
#else
    for (int ph = 0; ph < 2 * NPL; ++ph) hipLaunchKernelGGL(mega, dim3(grid), dim3(512), LDS_BYTES, stream, p, ph, ph + 1);
#endif
}
```

```cpp
#include <hip/hip_runtime.h>
#include <hip/hip_cooperative_groups.h>
#include <cstdio>
#include <cstdint>
namespace cg = cooperative_groups;
namespace pg8 {
#define PG8_LAS __attribute__((address_space(3)))
typedef unsigned short bf16_t;
typedef short bf16x8 __attribute__((ext_vector_type(8)));
typedef float f32x4 __attribute__((ext_vector_type(4)));
typedef unsigned u32x4 __attribute__((ext_vector_type(4)));
constexpr int BM = 256, BK = 64, HALF = 128, HTB = HALF * BK * 2  , STAGE_BYTES = 8 * HTB, NXCD = 8, WGM = 4;

__host__ __device__ __forceinline__ int lds_byte(int r, int c) { const int st = (r >> 4) * 2 + (c >> 5), rr = r & 15, cc = c & 31, ob = rr * 64 + cc * 2; return st * 1024 + (ob ^ (((ob >> 9) & 1) << 5)); }
__host__ __device__ __forceinline__ void stage_rc(int b, int& R, int& C) { const int st = b / 1024, sb = b % 1024, swz = sb ^ (((sb >> 9) & 1) << 5); R = (st >> 1) * 16 + swz / 64; C = (st & 1) * 32 + (swz % 64) / 2; }
__host__ __device__ __forceinline__ int perm32(int rho) { const int n = rho >> 4, i = rho & 15; return 8 * (i >> 2) + 4 * n + (i & 3); }

struct Unit { int pm, pn; };
struct Gemm { const bf16_t* A; const bf16_t* Bt; int M, N, K; };

struct StaticOrder {
    int nM, nN, nwg, G, c;
    __host__ __device__ void init(int M, int N, int G_, int c_) { nM = M / BM; nN = N / BM; nwg = nM * nN; G = G_; c = c_; }
    __host__ __device__ bool next(int i, Unit& u) const {
        const long L = (long)i * G + c; if (L >= nwg) return false;
        int wgid = (int)L; { const int q = nwg / NXCD, r = nwg % NXCD, xcd = wgid % NXCD, off = wgid / NXCD; wgid = (xcd < r ? xcd * (q + 1) : r * (q + 1) + (xcd - r) * q) + off; }
        const int nig = WGM * nN, gid = wgid / nig, fm = gid * WGM, gsz = (nM - fm) < WGM ? (nM - fm) : WGM;
        u.pm = fm + ((wgid % nig) % gsz); u.pn = (wgid % nig) / gsz; return true;
    }
    __device__ __forceinline__ void a_ready(const Unit&) const {}
    __device__ __forceinline__ void done(const Unit&) const {}
};
__device__ __forceinline__ unsigned cvt_pk_bf16(float lo, float hi) { unsigned r; asm volatile("v_cvt_pk_bf16_f32 %0, %1, %2" : "=v"(r) : "v"(lo), "v"(hi)); return r; }
struct EpiF32 {
    static constexpr bool PERM = false, AFTER_DRAIN = false, TOKPERM = false;
    float* C; int ldc; const float* bias;
    __device__ __forceinline__ void operator()(const f32x4 (&acc)[2][2][4][2], const Unit& u, int wr, int wc, int fr, int fq) const {
        const int row0 = u.pm * BM + wr * 64 + fr, col0 = u.pn * BM + wc * 32 + 4 * fq;
        f32x4 bv[2][2];
#pragma unroll
        for (int bj = 0; bj < 2; ++bj)
#pragma unroll
            for (int n = 0; n < 2; ++n) bv[bj][n] = bias ? *(const f32x4*)(bias + col0 + bj * HALF + n * 16) : (f32x4){0.f, 0.f, 0.f, 0.f};
#pragma unroll
        for (int ai = 0; ai < 2; ++ai)
#pragma unroll
            for (int m = 0; m < 4; ++m) { float* rowp = C + (size_t)(row0 + ai * HALF + m * 16) * ldc + col0;
#pragma unroll
                for (int bj = 0; bj < 2; ++bj)
#pragma unroll
                    for (int n = 0; n < 2; ++n) *(f32x4*)(rowp + bj * HALF + n * 16) = acc[ai][bj][m][n] + bv[bj][n]; }
    }
};
struct EpiBf16 {
    static constexpr bool PERM = true, AFTER_DRAIN = false, TOKPERM = false;
    bf16_t* O; int ldc;
    __device__ __forceinline__ void operator()(const f32x4 (&acc)[2][2][4][2], const Unit& u, int wr, int wc, int fr, int fq) const {
        const int row0 = u.pm * BM + wr * 64 + fr; const int col0 = u.pn * BM + wc * 32 + 8 * fq;
#pragma unroll
        for (int ai = 0; ai < 2; ++ai)
#pragma unroll
            for (int m = 0; m < 4; ++m) { bf16_t* rowp = O + (size_t)(row0 + ai * HALF + m * 16) * ldc + col0;
#pragma unroll
                for (int bj = 0; bj < 2; ++bj) { const f32x4 v0 = acc[ai][bj][m][0], v1 = acc[ai][bj][m][1];
                    u32x4 w; w.x = cvt_pk_bf16(v0[0], v0[1]); w.y = cvt_pk_bf16(v0[2], v0[3]); w.z = cvt_pk_bf16(v1[0], v1[1]); w.w = cvt_pk_bf16(v1[2], v1[3]);
                    *(u32x4*)(rowp + bj * HALF) = w; } }
    }
};

typedef unsigned u32x2 __attribute__((ext_vector_type(2)));
template <int CTRL> __device__ __forceinline__ float epi_dpp(float x) { return __int_as_float(__builtin_amdgcn_update_dpp(0, __float_as_int(x), CTRL, 0xF, 0xF, true)); }
__device__ __forceinline__ float epi_gelu_t(float x) { const float u = 0.7978845608028654f * (x + 0.044715f * x * x * x); return x * __builtin_amdgcn_rcpf(1.0f + __expf(-2.0f * u)); }
struct EpiConv {
    static constexpr bool PERM = true, AFTER_DRAIN = false, TOKPERM = true;
    bf16_t* ACT; const float* cw; const float* cb; float* HALO; float* PARTB; int dff, nup;
    __device__ __forceinline__ void operator()(const f32x4 (&acc)[2][2][4][2], const Unit& u, int wr, int wc, int fr, int fq) const {
        const int tok0 = u.pm * BM + (wr * 16 + fr) * 8;
        const int grp = u.pm * 2 + wr;
        const int cl = wc * 32 + fq * 8;
#pragma unroll
        for (int n = 0; n < 2; ++n) {
            const int ch = u.pn * 128 + cl + 4 * n;
            const int colp = u.pn * 256 + cl + 4 * n;
            const f32x4 bg = *(const f32x4*)(cb + ch), bv = *(const f32x4*)(cb + dff + ch);
            f32x4 wg[3], wv[3];
#pragma unroll
            for (int j = 0; j < 3; ++j) { wg[j] = *(const f32x4*)(cw + (size_t)j * nup + ch); wv[j] = *(const f32x4*)(cw + (size_t)j * nup + dff + ch); }
            f32x4 hg6, hg7, hv6, hv7;
#pragma unroll
            for (int e = 0; e < 4; ++e) { hg6[e] = epi_dpp<0x111>(acc[1][0][2][n][e]); hg7[e] = epi_dpp<0x111>(acc[1][0][3][n][e]); hv6[e] = epi_dpp<0x111>(acc[1][1][2][n][e]); hv7[e] = epi_dpp<0x111>(acc[1][1][3][n][e]); }
            if (fr == 15) {
                float* h = HALO + ((size_t)grp * 2) * nup + colp;
                *(f32x4*)(h) = acc[1][0][2][n]; *(f32x4*)(h + 128) = acc[1][1][2][n]; *(f32x4*)(h + nup) = acc[1][0][3][n]; *(f32x4*)(h + nup + 128) = acc[1][1][3][n]; }
            if (fr == 0) {
                float* q = PARTB + ((size_t)grp * 2) * nup + colp;
                *(f32x4*)(q) = bg + wg[2] * acc[0][0][0][n]; *(f32x4*)(q + 128) = bv + wv[2] * acc[0][1][0][n];
                *(f32x4*)(q + nup) = bg + wg[2] * acc[0][0][1][n] + wg[1] * acc[0][0][0][n]; *(f32x4*)(q + nup + 128) = bv + wv[2] * acc[0][1][1][n] + wv[1] * acc[0][1][0][n]; }
#pragma unroll
            for (int j = 0; j < 8; ++j) {
                const f32x4 g0 = acc[j >> 2][0][j & 3][n], v0 = acc[j >> 2][1][j & 3][n];
                const f32x4 g1 = j >= 1 ? acc[(j - 1 < 0 ? 0 : j - 1) >> 2][0][(j - 1 < 0 ? 0 : j - 1) & 3][n] : hg7, v1 = j >= 1 ? acc[(j - 1 < 0 ? 0 : j - 1) >> 2][1][(j - 1 < 0 ? 0 : j - 1) & 3][n] : hv7;
                const f32x4 g2 = j >= 2 ? acc[(j - 2 < 0 ? 0 : j - 2) >> 2][0][(j - 2 < 0 ? 0 : j - 2) & 3][n] : (j == 1 ? hg7 : hg6), v2 = j >= 2 ? acc[(j - 2 < 0 ? 0 : j - 2) >> 2][1][(j - 2 < 0 ? 0 : j - 2) & 3][n] : (j == 1 ? hv7 : hv6);
                const f32x4 gc = bg + wg[0] * g2 + wg[1] * g1 + wg[2] * g0, vc = bv + wv[0] * v2 + wv[1] * v1 + wv[2] * v0;
                if (j >= 2 || fr != 0) { u32x2 w; w.x = cvt_pk_bf16(epi_gelu_t(gc[0]) * vc[0], epi_gelu_t(gc[1]) * vc[1]); w.y = cvt_pk_bf16(epi_gelu_t(gc[2]) * vc[2], epi_gelu_t(gc[3]) * vc[3]);
                    *(u32x2*)(ACT + (size_t)(tok0 + j) * dff + ch) = w; }
            }
        }
    }
};
template <class Epi, class Sched, bool STAMP = false>
__device__ __forceinline__ void gemm_phase(const int tid_in, PG8_LAS unsigned char* lds, const Gemm g, const Sched& S, const Epi& E, unsigned long long* stamps) {
    const int tid = tid_in, wid = __builtin_amdgcn_readfirstlane(tid >> 6), lane = tid & 63, wr = wid >> 2, wc = wid & 3, fr = lane & 15, fq = lane >> 4;
    const int K = g.K, nt = K / BK;
    int ts_lo = 0, ts_hi = 0, nts = 0; const unsigned long long rt_entry = STAMP ? (unsigned long long)wall_clock64() : 0ull;
#define PG8_STAMP() do { if (STAMP && wid == 0 && nts < 64) { const unsigned long long _c = (unsigned long long)clock64(); \
        ts_lo = (lane == nts) ? (int)(unsigned)_c : ts_lo; ts_hi = (lane == nts) ? (int)(unsigned)(_c >> 32) : ts_hi; ++nts; } } while (0)
    PG8_STAMP();
    unsigned voffA[2], voffB[2];
#pragma unroll
    for (int i = 0; i < 2; ++i) { int R, C; stage_rc(tid * 16 + i * 8192, R, C); const int Rb = Epi::PERM ? ((R & ~31) + perm32(R & 31)) : R;
        const int Ra = Epi::TOKPERM ? ((((R >> 6) * 16 + (R & 15)) * 8) + ((R >> 4) & 3)) : R;
        voffA[i] = (unsigned)(Ra * K + C) * 2u; voffB[i] = (unsigned)(Rb * K + C) * 2u; }
    const size_t kstep = (size_t)(BK * 2);
    const size_t hstep = (size_t)HALF * K * 2;
    const size_t hstepA = Epi::TOKPERM ? (size_t)4 * K * 2 : hstep;
    const size_t tstep = 2 * hstep;
    const unsigned ldsw = (unsigned)wid * 1024u;
    const int aoff = lds_byte(wr * 64 + fr, fq * 8), boff = lds_byte(wc * 32 + fr, fq * 8);
#define PG8_SA(b, h) (((b) * 2 + (h)) * HTB)
#define PG8_SB(b, h) ((4 + (b) * 2 + (h)) * HTB)
#define PG8_STAGE(bufoff, gbase, voff) do { _Pragma("unroll") for (int _i = 0; _i < 2; ++_i) \
        __builtin_amdgcn_global_load_lds((const unsigned*)((const char*)(gbase) + (voff)[_i]), (PG8_LAS unsigned*)(lds + (bufoff) + ldsw + _i * 8192), 16, 0, 0); } while (0)
#define PG8_LDA(dst, b, h) do { _Pragma("unroll") for (int m = 0; m < 4; ++m) _Pragma("unroll") for (int k = 0; k < 2; ++k) dst[m][k] = *(const PG8_LAS bf16x8*)(lds + PG8_SA(b, h) + aoff + m * 2048 + k * 1024); } while (0)
#define PG8_LDB(dst, b, h) do { _Pragma("unroll") for (int n = 0; n < 2; ++n) _Pragma("unroll") for (int k = 0; k < 2; ++k) dst[n][k] = *(const PG8_LAS bf16x8*)(lds + PG8_SB(b, h) + boff + n * 2048 + k * 1024); } while (0)
#define PG8_MMA(ai, bj, At, Bt) do { __builtin_amdgcn_s_setprio(1); _Pragma("unroll") for (int m = 0; m < 4; ++m) _Pragma("unroll") for (int n = 0; n < 2; ++n) _Pragma("unroll") for (int k = 0; k < 2; ++k) \
        acc[ai][bj][m][n] = __builtin_amdgcn_mfma_f32_16x16x32_bf16(Bt[n][k], At[m][k], acc[ai][bj][m][n], 0, 0, 0); __builtin_amdgcn_s_setprio(0); } while (0)
#define PG8_WAIT_V(n) asm volatile("s_waitcnt vmcnt(" #n ")" ::: "memory")
#define PG8_WAIT_L(n) asm volatile("s_waitcnt lgkmcnt(" #n ")" ::: "memory")
#define PG8_BAR __builtin_amdgcn_s_barrier()
#define PG8_SCHED __builtin_amdgcn_sched_barrier(0)
    Unit cur, nxt; int ui = 0;
    if (!S.next(0, cur)) return;
    f32x4 acc[2][2][4][2];
#pragma unroll
    for (int a = 0; a < 2; ++a)
#pragma unroll
        for (int b = 0; b < 2; ++b)
#pragma unroll
            for (int m = 0; m < 4; ++m)
#pragma unroll
                for (int n = 0; n < 2; ++n) acc[a][b][m][n] = (f32x4){0.f, 0.f, 0.f, 0.f};
    bf16x8 At[4][2], B0[2][2], B1[2][2];
    const char* cA = (const char*)g.A + (size_t)cur.pm * tstep; const char* cB = (const char*)g.Bt + (size_t)cur.pn * tstep;
    S.a_ready(cur);
    PG8_STAGE(PG8_SB(0, 0), cB, voffB); PG8_STAGE(PG8_SA(0, 0), cA, voffA); PG8_STAGE(PG8_SB(0, 1), cB + hstep, voffB); PG8_STAGE(PG8_SA(0, 1), cA + hstepA, voffA);
    if (wr == 1) PG8_BAR;
    PG8_WAIT_V(4); PG8_BAR;
    PG8_STAGE(PG8_SB(1, 0), cB + kstep, voffB); PG8_STAGE(PG8_SA(1, 0), cA + kstep, voffA); PG8_STAGE(PG8_SB(1, 1), cB + hstep + kstep, voffB);
    PG8_WAIT_V(6); PG8_BAR;
    PG8_STAMP();
    for (;;) {
        const bool has_next = S.next(ui + 1, nxt);
        const char* nA = has_next ? (const char*)g.A + (size_t)nxt.pm * tstep : cA; const char* nB = has_next ? (const char*)g.Bt + (size_t)nxt.pn * tstep : cB;
        for (int t = 0; t < nt; t += 2) {
            const bool last = (t == nt - 2);
            const char* a1 = cA + (size_t)(t + 1) * kstep;
            const char* a2 = last ? nA : cA + (size_t)(t + 2) * kstep; const char* b2 = last ? nB : cB + (size_t)(t + 2) * kstep;
            const char* a3 = a2 + kstep; const char* b3 = b2 + kstep;
            if (last && has_next) S.a_ready(nxt);
            PG8_LDB(B0, 0, 0); PG8_SCHED; PG8_LDA(At, 0, 0); PG8_STAGE(PG8_SA(1, 1), a1 + hstepA, voffA);
            PG8_WAIT_L(8); PG8_BAR; PG8_WAIT_L(0); PG8_MMA(0, 0, At, B0); PG8_BAR; PG8_SCHED;
            PG8_LDB(B1, 0, 1); PG8_STAGE(PG8_SB(0, 0), b2, voffB);
            PG8_BAR; PG8_WAIT_L(0); PG8_MMA(0, 1, At, B1); PG8_BAR;
            PG8_LDA(At, 0, 1); PG8_STAGE(PG8_SA(0, 0), a2, voffA);
            PG8_BAR; PG8_WAIT_L(0); PG8_MMA(1, 0, At, B0); PG8_BAR; PG8_SCHED;
            PG8_STAGE(PG8_SB(0, 1), b2 + hstep, voffB);
            PG8_WAIT_V(6); PG8_BAR; PG8_MMA(1, 1, At, B1); PG8_BAR;
            PG8_LDB(B0, 1, 0); PG8_SCHED; PG8_LDA(At, 1, 0); PG8_STAGE(PG8_SA(0, 1), a2 + hstepA, voffA);
            PG8_WAIT_L(8); PG8_BAR; PG8_WAIT_L(0); PG8_MMA(0, 0, At, B0); PG8_BAR; PG8_SCHED;
            PG8_LDB(B1, 1, 1); PG8_STAGE(PG8_SB(1, 0), b3, voffB);
            PG8_BAR; PG8_WAIT_L(0); PG8_MMA(0, 1, At, B1); PG8_BAR;
            PG8_LDA(At, 1, 1); PG8_STAGE(PG8_SA(1, 0), a3, voffA);
            PG8_BAR; PG8_WAIT_L(0); PG8_MMA(1, 0, At, B0); PG8_BAR; PG8_SCHED;
            PG8_STAGE(PG8_SB(1, 1), b3 + hstep, voffB);
            PG8_WAIT_V(6); PG8_BAR; PG8_MMA(1, 1, At, B1); PG8_BAR;
        }
        PG8_STAMP();
        if constexpr (!Epi::AFTER_DRAIN) { E(acc, cur, wr, wc, fr, fq); S.done(cur); }
        PG8_STAMP();
        if (!has_next) break;
#pragma unroll
        for (int a = 0; a < 2; ++a)
#pragma unroll
            for (int b = 0; b < 2; ++b)
#pragma unroll
                for (int m = 0; m < 4; ++m)
#pragma unroll
                    for (int n = 0; n < 2; ++n) acc[a][b][m][n] = (f32x4){0.f, 0.f, 0.f, 0.f};
        cur = nxt; cA = nA; cB = nB; ++ui;
    }
    PG8_WAIT_V(0);
    if (wr == 0) PG8_BAR;
    PG8_BAR;
    if constexpr (Epi::AFTER_DRAIN) { E.fused(acc, cur, wr, wc, fr, fq, lds, wid, lane); S.done(cur); }
    PG8_STAMP();
    if (STAMP && wid == 0) { stamps[lane] = lane < nts ? (((unsigned long long)(unsigned)ts_hi << 32) | (unsigned)ts_lo) : 0ull;
        if (lane == 62) stamps[62] = rt_entry; if (lane == 63) stamps[63] = (unsigned long long)wall_clock64(); }
#undef PG8_STAMP
#undef PG8_SA
#undef PG8_SB
#undef PG8_STAGE
#undef PG8_LDA
#undef PG8_LDB
#undef PG8_MMA
#undef PG8_WAIT_V
#undef PG8_WAIT_L
#undef PG8_BAR
#undef PG8_SCHED
}
}
#ifndef REP_MASK
#define REP_MASK 0
#endif
#ifndef P3_MODE
#define P3_MODE 0
#endif
typedef unsigned short bf16_t;
typedef pg8::bf16x8 bf16x8;
typedef pg8::f32x4 f32x4;
typedef pg8::u32x2 u32x2;
typedef unsigned u32x4 __attribute__((ext_vector_type(4)));
typedef float f32x2 __attribute__((ext_vector_type(2)));
#define DI __device__ __forceinline__
#define LAS __attribute__((address_space(3)))

constexpr int T = 16384, DM = 2048, SEQ = 4096, NIN = 6016, NINP = 6144, DFF = 5632, NUP = 11264;
constexpr int NPL = 15;
constexpr int LDS_BYTES = 147456;
constexpr int SCAN_BLOCKS = 96;
constexpr size_t al256(size_t x) { return (x + 255) & ~(size_t)255; }
constexpr size_t OFF_CTL = 0;
constexpr size_t CTL_BYTES = 16384;
constexpr size_t OFF_WIN = OFF_CTL + CTL_BYTES;
constexpr size_t OFF_WOUT = OFF_WIN + (size_t)NINP * DM * 2;
constexpr size_t OFF_WQ = OFF_WOUT + (size_t)DM * DM * 2;
constexpr size_t OFF_WKV = OFF_WQ + (size_t)512 * DM * 2;
constexpr size_t OFF_WO = OFF_WKV + (size_t)1024 * DM * 2;
constexpr size_t OFF_WUP = OFF_WO + (size_t)DM * 512 * 2;
constexpr size_t OFF_WDN = OFF_WUP + (size_t)NUP * DM * 2;
constexpr size_t OFF_LW = OFF_WDN + (size_t)DM * DFF * 2;
constexpr size_t OFF_LA = OFF_LW + (size_t)768 * 64 * 2;
constexpr size_t OFF_LG = OFF_LA + (size_t)768 * 64 * 2;
constexpr size_t OFF_WS = OFF_LG + (size_t)768 * 256 * 2;
constexpr size_t OFF_BT = OFF_WS + (size_t)8 * 128 * 128 * 2;
constexpr size_t OFF_MEMN = al256(OFF_BT + 3 * 12 * 132 * 4);
constexpr size_t OFF_HB = OFF_MEMN + (size_t)1024 * DM * 2;
constexpr size_t OFF_XB = OFF_HB + (size_t)T * DM * 2;
constexpr size_t OFF_R = OFF_XB + (size_t)T * DM * 2;
constexpr size_t OFF_Z = OFF_R;
constexpr size_t OFF_AP = OFF_Z + (size_t)T * NINP * 2;
constexpr size_t OFF_LSE = OFF_AP + (size_t)3 * T * 768 * 2;
constexpr size_t OFF_RWA = OFF_LSE + (size_t)3 * T * 12 * 4;
constexpr size_t OFF_RWD = OFF_RWA + (size_t)T * 768 * 2;
constexpr size_t OFF_RWG = OFF_RWD + (size_t)T * 768 * 2;
constexpr size_t OFF_YR = OFF_RWG + (size_t)T * 768 * 2;
constexpr size_t OFF_BON = OFF_YR + (size_t)T * 768 * 4;
constexpr size_t OFF_MIX = OFF_BON + (size_t)T * 12 * 4;
constexpr size_t OFF_END1 = OFF_MIX + (size_t)T * DM * 2;
constexpr size_t OFF_Y = OFF_R;
constexpr size_t OFF_Q = OFF_Y + (size_t)T * DM * 4;
constexpr size_t OFF_O = OFF_Q + (size_t)T * 512 * 2;
constexpr size_t OFF_KV = OFF_O + (size_t)T * 512 * 2;
constexpr size_t OFF_ACT = OFF_Y + (size_t)T * DM * 4;
constexpr size_t OFF_HALO = OFF_ACT + (size_t)T * DFF * 2;
constexpr size_t OFF_PART = OFF_HALO + (size_t)(T / 128) * 2 * NUP * 4;
constexpr size_t OFF_END2 = OFF_PART + (size_t)(T / 128) * 2 * NUP * 4;
constexpr size_t WS_NEED = OFF_END1 > OFF_END2 ? OFF_END1 : OFF_END2;
static_assert(OFF_Y + (size_t)T * DM * 4 <= OFF_MIX, "Y must not overlap MIX");

struct Params { const float* in[30]; float* out; unsigned char* ws; };
struct InArr { const Params* pp; size_t zero; DI const float* operator[](int i) const { return pp->in[i] + zero; } };
struct PView { InArr in; float* out; unsigned char* ws; };

DI float bf2f(unsigned b) { return __uint_as_float(b << 16); }
DI float bflo(unsigned w) { return __uint_as_float(w << 16); }
DI float bfhi(unsigned w) { return __uint_as_float(w & 0xffff0000u); }
typedef __bf16 bf16x2_t __attribute__((ext_vector_type(2)));
DI unsigned pack2(float lo, float hi) { const f32x2 v = {lo, hi}; const bf16x2_t r = __builtin_convertvector(v, bf16x2_t); return __builtin_bit_cast(unsigned, r); }
DI bf16_t f2bf(float f) { return (bf16_t)(pack2(f, 0.f) & 0xffffu); }

template <int C> DI float dppf(float x) { return __int_as_float(__builtin_amdgcn_update_dpp(0, __float_as_int(x), C, 0xF, 0xF, true)); }
DI float rsum16(float x) { x += dppf<0xB1>(x); x += dppf<0x4E>(x); x += dppf<0x141>(x); x += dppf<0x140>(x); return x; }
DI float swz16(float x) { return __int_as_float(__builtin_amdgcn_ds_swizzle(__float_as_int(x), 0x401F)); }
DI float wsum(float x) { x = rsum16(x); x += swz16(x); return __int_as_float(__builtin_amdgcn_readlane(__float_as_int(x), 0)) + __int_as_float(__builtin_amdgcn_readlane(__float_as_int(x), 32)); }
DI float xor32(float x, int tid) { return __int_as_float(__builtin_amdgcn_ds_bpermute(((tid ^ 32) & 63) << 2, __float_as_int(x))); }
DI float gelu_t(float x) { const float u = 0.7978845608028654f * (x + 0.044715f * x * x * x); return x * __builtin_amdgcn_rcpf(1.0f + __expf(-2.0f * u)); }
DI float sigm(float x) { return __builtin_amdgcn_rcpf(1.0f + __expf(-x)); }
DI void unpack8(const uint4 w, float (&f)[8]) { f[0] = bflo(w.x); f[1] = bfhi(w.x); f[2] = bflo(w.y); f[3] = bfhi(w.y); f[4] = bflo(w.z); f[5] = bfhi(w.z); f[6] = bflo(w.w); f[7] = bfhi(w.w); }
DI uint4 pack8(const float (&f)[8]) { uint4 w; w.x = pack2(f[0], f[1]); w.y = pack2(f[2], f[3]); w.z = pack2(f[4], f[5]); w.w = pack2(f[6], f[7]); return w; }

template <int KT>
DI void cvt_job(const int ctx_tid, const int ctx_bid, const int ctx_g, const float* W, bf16_t* Bt, int K, int N, int Npad, int mode, int& tile_base, LAS float* tile) {
    constexpr int NL = KT / 32;
    const int tk = K / KT, tn = Npad / 64, nt = tk * tn, G = ctx_g, tid = ctx_tid, w = tid >> 6, lane = tid & 63;
    const int first = (ctx_bid - (tile_base % G) + G) % G;
    const int r = tid >> 4, c4 = (tid & 15) * 4;
    auto tile_src = [&](int ti, int& n0, int& k0, int& src, bool& valid) { const int ik = ti % tk, in_ = ti / tk; n0 = in_ * 64; k0 = ik * KT; src = n0; valid = n0 < N;
        if (mode == 1) { const int pn = n0 / 256, bj = (n0 % 256) / 128, off = n0 % 128; src = bj * DFF + pn * 128 + off; valid = true; } };
    float4 cur[NL], nxt[NL], nx2[NL];
    auto tile_load = [&](int ti, float4 (&v)[NL]) { int n0, k0, src; bool valid; tile_src(ti < nt ? ti : first, n0, k0, src, valid);
#pragma unroll
        for (int i = 0; i < NL; ++i) { if (valid) { const f32x4 t = __builtin_nontemporal_load((const f32x4*)(W + (size_t)(k0 + r + 32 * i) * N + src + c4)); v[i] = make_float4(t.x, t.y, t.z, t.w); } else v[i] = make_float4(0.f, 0.f, 0.f, 0.f); } };
    if (first < nt) { tile_load(first, cur); tile_load(first + G, nxt); }
    for (int ti = first; ti < nt; ti += G) {
        int n0, k0, src; bool valid; tile_src(ti, n0, k0, src, valid);
        tile_load(ti + 2 * G, nx2);
#pragma unroll
        for (int i = 0; i < NL; ++i) { LAS float* d = tile + (r + 32 * i) * 65 + c4; d[0] = cur[i].x; d[1] = cur[i].y; d[2] = cur[i].z; d[3] = cur[i].w; }
        __syncthreads();
        { constexpr int KW = KT / 8;
          bf16_t* o = Bt + (size_t)(n0 + lane) * K + k0 + w * KW;
#pragma unroll
          for (int q = 0; q < KW / 8; ++q) { float f[8];
#pragma unroll
            for (int j = 0; j < 8; ++j) f[j] = tile[(w * KW + q * 8 + j) * 65 + lane];
            *(uint4*)(o + q * 8) = pack8(f); } }
        __syncthreads();
#pragma unroll
        for (int i = 0; i < NL; ++i) { cur[i] = nxt[i]; nxt[i] = nx2[i]; }
    }
    tile_base += nt;
}
DI int xcd_row(const int bid, const int wave, const int G, const int i) {
    if (G == 256) return i < 8 ? 2048 * (bid & 7) + ((bid >> 3) * 8 + wave) + 256 * i : T;
    return bid * 8 + wave + i * G * 8;
}
DI void rmsnorm_rows_bf16(const int ctx_tid, const int ctx_bid, const int ctx_g, const float* X, const float* gain, bf16_t* O, int rows) {
    const int lane = ctx_tid & 63, wv = ctx_tid >> 6; const bool xm = (rows == T) && (ctx_g == 256);
    for (int ri = 0; ; ++ri) { const int r = xm ? xcd_row(ctx_bid, wv, 256, ri) : ctx_bid * 8 + wv + ri * ctx_g * 8; if (r >= rows) break;
        const float* x = X + (size_t)r * DM; float4 v[8]; float ss = 0.f;
#pragma unroll
        for (int i = 0; i < 8; ++i) { v[i] = *(const float4*)(x + (i * 64 + lane) * 4); ss += v[i].x * v[i].x + v[i].y * v[i].y + v[i].z * v[i].z + v[i].w * v[i].w; }
        const float rs = rsqrtf(wsum(ss) * (1.0f / DM) + 1e-6f);
#pragma unroll
        for (int i = 0; i < 8; ++i) { const float4 g = *(const float4*)(gain + (i * 64 + lane) * 4); uint2 w; w.x = pack2(v[i].x * rs * g.x, v[i].y * rs * g.y); w.y = pack2(v[i].z * rs * g.z, v[i].w * rs * g.w);
            *(uint2*)(O + (size_t)r * DM + (i * 64 + lane) * 4) = w; }
    }
}
DI int t5_bucket(int dist) {
    if (dist < 16) return dist;
    int bkt = 16;
    bkt += dist >= 22; bkt += dist >= 30; bkt += dist >= 40; bkt += dist >= 54; bkt += dist >= 73; bkt += dist >= 99; bkt += dist >= 134; bkt += dist >= 182;
    bkt += dist >= 246; bkt += dist >= 332; bkt += dist >= 450; bkt += dist >= 609; bkt += dist >= 825; bkt += dist >= 1117; bkt += dist >= 1513;
    return bkt;
}
DI void phase_cvt(const int ctx_tid, const int ctx_bid, const int ctx_g, const PView& p, int l, LAS unsigned char* lds) {
#ifdef NO_CVT
    return;
#endif
    unsigned char* ws = p.ws; LAS float* tile = (LAS float*)lds; int tb = 0;
    cvt_job<256>(ctx_tid, ctx_bid, ctx_g, p.in[5] + (size_t)l * DM * NIN, (bf16_t*)(ws + OFF_WIN), DM, NIN, NINP, 0, tb, tile);
    cvt_job<256>(ctx_tid, ctx_bid, ctx_g, p.in[26] + (size_t)l * DM * NUP, (bf16_t*)(ws + OFF_WUP), DM, NUP, NUP, 1, tb, tile);
    cvt_job<256>(ctx_tid, ctx_bid, ctx_g, p.in[29] + (size_t)l * DFF * DM, (bf16_t*)(ws + OFF_WDN), DFF, DM, DM, 0, tb, tile);
    cvt_job<256>(ctx_tid, ctx_bid, ctx_g, p.in[6] + (size_t)l * DM * DM, (bf16_t*)(ws + OFF_WOUT), DM, DM, DM, 0, tb, tile);
    cvt_job<256>(ctx_tid, ctx_bid, ctx_g, p.in[23] + (size_t)l * DM * 512, (bf16_t*)(ws + OFF_WQ), DM, 512, 512, 0, tb, tile);
    cvt_job<256>(ctx_tid, ctx_bid, ctx_g, p.in[24] + (size_t)l * DM * 1024, (bf16_t*)(ws + OFF_WKV), DM, 1024, 1024, 0, tb, tile);
    cvt_job<256>(ctx_tid, ctx_bid, ctx_g, p.in[25] + (size_t)l * 512 * DM, (bf16_t*)(ws + OFF_WO), 512, DM, DM, 0, tb, tile);
    cvt_job<64>(ctx_tid, ctx_bid, ctx_g, p.in[14] + (size_t)l * 64 * 768, (bf16_t*)(ws + OFF_LW), 64, 768, 768, 0, tb, tile);
    cvt_job<64>(ctx_tid, ctx_bid, ctx_g, p.in[16] + (size_t)l * 64 * 768, (bf16_t*)(ws + OFF_LA), 64, 768, 768, 0, tb, tile);
    cvt_job<256>(ctx_tid, ctx_bid, ctx_g, p.in[17] + (size_t)l * 256 * 768, (bf16_t*)(ws + OFF_LG), 256, 768, 768, 0, tb, tile);
    const int gt = ctx_bid * 512 + ctx_tid, ng = ctx_g * 512;
    { const float* sw = p.in[9] + (size_t)l * 8 * 128 * 128; bf16_t* o = (bf16_t*)(ws + OFF_WS);
      for (int i = gt; i < 8 * 128 * 128; i += ng) { const int jj = i & 127, ii = (i >> 7) & 127; o[i] = f2bf(jj <= ii ? sw[i] : 0.f); } }
    if (l == 0) { float* bt = (float*)(ws + OFF_BT);
      for (int i = gt; i < 3 * 12 * 129; i += ng) { const int delta = i % 129, h = (i / 129) % 12, pp = i / (129 * 12); const int d = pp == 0 ? 1 : (pp == 1 ? 4 : 16);
        bt[(pp * 12 + h) * 132 + delta] = p.in[2][t5_bucket(delta * d) * 12 + h]; } }
    rmsnorm_rows_bf16(ctx_tid, ctx_bid, ctx_g, p.in[1], p.in[4] + (size_t)l * DM, (bf16_t*)(ws + OFF_MEMN), 1024);
    if (l == 0) rmsnorm_rows_bf16(ctx_tid, ctx_bid, ctx_g, p.in[0], p.in[3], (bf16_t*)(ws + OFF_HB), T);
}

template <bool XIN_F32, bool XOUT_F32>
DI void phase_resid(const int ctx_tid, const int ctx_bid, const int ctx_g, const bf16_t* Y, const void* xi_, void* xo_, const float* ga, const float* gb, bf16_t* HB) {
#ifdef NO_RESID
    return;
#endif
    const int lane = ctx_tid & 63, wv = ctx_tid >> 6;
    for (int ri = 0, r = xcd_row(ctx_bid, wv, ctx_g, 0); r < T; r = xcd_row(ctx_bid, wv, ctx_g, ++ri)) {
        float4 xv[8], xin[8]; float ss = 0.f;
#pragma unroll
        for (int i = 0; i < 8; ++i) { const int c = (i * 64 + lane) * 4; const u32x2 yq = __builtin_nontemporal_load((const u32x2*)(Y + (size_t)r * DM + c)); float4 y; y.x = bflo(yq.x); y.y = bfhi(yq.x); y.z = bflo(yq.y); y.w = bfhi(yq.y); xv[i] = y; ss += y.x * y.x + y.y * y.y + y.z * y.z + y.w * y.w;
            if (XIN_F32) { const f32x4 t = __builtin_nontemporal_load((const f32x4*)((const float*)xi_ + (size_t)r * DM + c)); xin[i] = make_float4(t.x, t.y, t.z, t.w); }
            else { const u32x2 xq = __builtin_nontemporal_load((const u32x2*)((const bf16_t*)xi_ + (size_t)r * DM + c)); xin[i].x = bflo(xq.x); xin[i].y = bfhi(xq.x); xin[i].z = bflo(xq.y); xin[i].w = bfhi(xq.y); } }
        const float rs = rsqrtf(wsum(ss) * (1.0f / DM) + 1e-6f); float s2 = 0.f;
#pragma unroll
        for (int i = 0; i < 8; ++i) { const int c = (i * 64 + lane) * 4; const float4 g = *(const float4*)(ga + c); const float4 x = xin[i];
            float4 o; o.x = x.x + xv[i].x * rs * g.x; o.y = x.y + xv[i].y * rs * g.y; o.z = x.z + xv[i].z * rs * g.z; o.w = x.w + xv[i].w * rs * g.w;
            if (XOUT_F32) __builtin_nontemporal_store((f32x4){o.x, o.y, o.z, o.w}, (f32x4*)((float*)xo_ + (size_t)r * DM + c));
            else { uint2 w; w.x = pack2(o.x, o.y); w.y = pack2(o.z, o.w); *(uint2*)((bf16_t*)xo_ + (size_t)r * DM + c) = w; }
            xv[i] = o; s2 += o.x * o.x + o.y * o.y + o.z * o.z + o.w * o.w; }
        if (gb) { const float r2 = rsqrtf(wsum(s2) * (1.0f / DM) + 1e-6f);
#pragma unroll
            for (int i = 0; i < 8; ++i) { const int c = (i * 64 + lane) * 4; const float4 g = *(const float4*)(gb + c); uint2 w; w.x = pack2(xv[i].x * r2 * g.x, xv[i].y * r2 * g.y); w.y = pack2(xv[i].z * r2 * g.z, xv[i].w * r2 * g.w);
                *(uint2*)(HB + (size_t)r * DM + c) = w; } }
    }
}

DI void phase_rwkv_prep(const int ctx_tid, const int ctx_bid, const int ctx_g, const PView& p, int l, LAS unsigned char* lds) {
#ifdef NO_PREP
    return;
#endif
    unsigned char* ws = p.ws; const bf16_t* Z = (const bf16_t*)(ws + OFF_Z);
    const float* mu = p.in[12] + (size_t)l * 2688 + 2304; const float* w0 = p.in[13] + (size_t)l * 768; const float* a0 = p.in[15] + (size_t)l * 768;
    const bf16_t* LW = (const bf16_t*)(ws + OFF_LW); const bf16_t* LA = (const bf16_t*)(ws + OFF_LA); const bf16_t* LG = (const bf16_t*)(ws + OFF_LG);
    bf16_t* RWA = (bf16_t*)(ws + OFF_RWA); bf16_t* RWD = (bf16_t*)(ws + OFF_RWD); bf16_t* RWG = (bf16_t*)(ws + OFF_RWG);
    const int tid = ctx_tid, lane = tid & 63, w = tid >> 6, fr = lane & 15, fq = lane >> 4;
    constexpr int AST = 392;
    LAS bf16_t* A = (LAS bf16_t*)lds;
    for (int item = ctx_bid; item < T / 64; item += ctx_g) {
        { uint2 cur[4][3], prv[4][3];
#pragma unroll
          for (int r = 0; r < 4; ++r) { const int idx = tid + 512 * r, row = idx >> 5, cs = (idx & 31) * 12; const int t = item * 64 + row; const bool hasp = (t % SEQ) != 0;
            const bf16_t* zr = Z + (size_t)t * NINP + 5632 + cs;
#pragma unroll
            for (int q = 0; q < 3; ++q) { cur[r][q] = *(const uint2*)(zr + q * 4); prv[r][q] = make_uint2(0u, 0u); if (hasp) prv[r][q] = *(const uint2*)(zr - NINP + q * 4); } }
#pragma unroll
          for (int r = 0; r < 4; ++r) { const int idx = tid + 512 * r, row = idx >> 5, cs = (idx & 31) * 12;
#pragma unroll
            for (int q = 0; q < 3; ++q) { const float c4[4] = {bflo(cur[r][q].x), bfhi(cur[r][q].x), bflo(cur[r][q].y), bfhi(cur[r][q].y)}, p4[4] = {bflo(prv[r][q].x), bfhi(prv[r][q].x), bflo(prv[r][q].y), bfhi(prv[r][q].y)};
#pragma unroll
              for (int e = 0; e < 4; ++e) { const int c = cs + q * 4 + e; float v = c4[e] + (p4[e] - c4[e]) * mu[c];
                  if (c < 64) v = 1.0f - 2.0f * __builtin_amdgcn_rcpf(__expf(2.0f * v) + 1.0f); else if (c >= 128) v = sigm(v);
                  A[row * AST + c] = f2bf(v); } } } }
        __syncthreads();
        const int t0 = item * 64;
        bf16x8 bc[12]; float wz, az;
#pragma unroll 1
        for (int nt = 0; nt < 6; ++nt) {
            const int n0 = w * 96 + nt * 16, c = n0 + fr;
#pragma unroll
            for (int ks = 0; ks < 2; ++ks) { bc[ks] = *(const bf16x8*)(LW + (size_t)(n0 + fr) * 64 + ks * 32 + fq * 8); bc[2 + ks] = *(const bf16x8*)(LA + (size_t)(n0 + fr) * 64 + ks * 32 + fq * 8); }
#pragma unroll
            for (int ks = 0; ks < 8; ++ks) bc[4 + ks] = *(const bf16x8*)(LG + (size_t)(n0 + fr) * 256 + ks * 32 + fq * 8);
            wz = w0[c]; az = a0[c];
#pragma unroll 1
            for (int mt = 0; mt < 4; ++mt) {
                const LAS bf16_t* Ar = A + (mt * 16 + fr) * AST + fq * 8; const int tb = t0 + mt * 16 + fq * 4;
                f32x4 accw = {0.f, 0.f, 0.f, 0.f}, acca = {0.f, 0.f, 0.f, 0.f}, accg = {0.f, 0.f, 0.f, 0.f};
#pragma unroll
                for (int ks = 0; ks < 2; ++ks) { accw = __builtin_amdgcn_mfma_f32_16x16x32_bf16(*(const LAS bf16x8*)(Ar + ks * 32), bc[ks], accw, 0, 0, 0);
                                                 acca = __builtin_amdgcn_mfma_f32_16x16x32_bf16(*(const LAS bf16x8*)(Ar + 64 + ks * 32), bc[2 + ks], acca, 0, 0, 0); }
#pragma unroll
                for (int ks = 0; ks < 8; ++ks) accg = __builtin_amdgcn_mfma_f32_16x16x32_bf16(*(const LAS bf16x8*)(Ar + 128 + ks * 32), bc[4 + ks], accg, 0, 0, 0);
#pragma unroll
                for (int j = 0; j < 4; ++j) { const float u = wz + accw[j];
                    RWD[(size_t)(tb + j) * 768 + c] = f2bf(0.6065306597126334f * sigm(u)); RWA[(size_t)(tb + j) * 768 + c] = f2bf(sigm(az + acca[j])); RWG[(size_t)(tb + j) * 768 + c] = f2bf(accg[j]); }
            }
        }
        __syncthreads();
    }
}

template <int DH, int NSTEP, bool MASK>
DI void attn_wave(const int ctx_tid, const int ctx_bid, const int ctx_g, const LAS unsigned char* Kl, int KS, const LAS unsigned char* Vl, int VS, const bf16x8 (&qf)[DH / 32], int step0, float scale,
                  int qi, bool first_block, const LAS float* btab, bf16_t* orow, float* lse_out) {
    const int lane = ctx_tid & 63, fr = lane & 15, fq = lane >> 4;
    f32x4 s[NSTEP][2];
#pragma unroll
    for (int st = 0; st < NSTEP; ++st)
#pragma unroll
        for (int hf = 0; hf < 2; ++hf) {
            const int key0 = (step0 + st) * 32 + hf * 16; f32x4 acc = {0.f, 0.f, 0.f, 0.f};
#pragma unroll
            for (int ks = 0; ks < DH / 32; ++ks) { const bf16x8 kf = *(const LAS bf16x8*)(Kl + (key0 + fr) * KS + (ks * 32 + fq * 8) * 2);
                acc = __builtin_amdgcn_mfma_f32_16x16x32_bf16(kf, qf[ks], acc, 0, 0, 0); }
            s[st][hf] = acc;
        }
    float m = -3.0e38f;
    const int kjb = step0 * 32 + fq * 4, tb0 = kjb - qi + 31;
#pragma unroll
    for (int st = 0; st < NSTEP; ++st)
#pragma unroll
        for (int hf = 0; hf < 2; ++hf)
#pragma unroll
            for (int j = 0; j < 4; ++j) {
                float v = s[st][hf][j] * scale;
                if (MASK) v += btab[tb0 + st * 32 + hf * 16 + j];
                s[st][hf][j] = v;
            }
    if (MASK && first_block) {
#pragma unroll
        for (int st = 0; st < NSTEP; ++st)
#pragma unroll
            for (int hf = 0; hf < 2; ++hf)
#pragma unroll
                for (int j = 0; j < 4; ++j) s[st][hf][j] = (kjb + (st * 32 + hf * 16 + j) >= 128) ? s[st][hf][j] : -1e30f; }
#pragma unroll
    for (int st = 0; st < NSTEP; ++st)
#pragma unroll
        for (int hf = 0; hf < 2; ++hf)
#pragma unroll
            for (int j = 0; j < 4; ++j) m = fmaxf(m, s[st][hf][j]);
    m = fmaxf(m, swz16(m)); m = fmaxf(m, xor32(m, ctx_tid));
    float den = 0.f;
#pragma unroll
    for (int st = 0; st < NSTEP; ++st)
#pragma unroll
        for (int hf = 0; hf < 2; ++hf)
#pragma unroll
            for (int j = 0; j < 4; ++j) { const float e = __expf(s[st][hf][j] - m); s[st][hf][j] = e; den += e; }
    den += swz16(den); den += xor32(den, ctx_tid);
    f32x4 o[DH / 16];
#pragma unroll
    for (int dt = 0; dt < DH / 16; ++dt) o[dt] = (f32x4){0.f, 0.f, 0.f, 0.f};
#pragma unroll
    for (int st = 0; st < NSTEP; ++st) {
        uint4 pw; pw.x = pack2(s[st][0][0], s[st][0][1]); pw.y = pack2(s[st][0][2], s[st][0][3]); pw.z = pack2(s[st][1][0], s[st][1][1]); pw.w = pack2(s[st][1][2], s[st][1][3]);
        const bf16x8 pf = __builtin_bit_cast(bf16x8, pw);
        const int kb = (step0 + st) * 32;
#pragma unroll
        for (int dt = 0; dt < DH / 16; ++dt) {
            const LAS unsigned char* vr = Vl + (dt * 16 + fr) * VS + (kb + fq * 4) * 2;
            const u32x2 v0 = *(const LAS u32x2*)vr; const u32x2 v1 = *(const LAS u32x2*)(vr + 32);
            u32x4 vw; vw.x = v0.x; vw.y = v0.y; vw.z = v1.x; vw.w = v1.y;
            o[dt] = __builtin_amdgcn_mfma_f32_16x16x32_bf16(__builtin_bit_cast(bf16x8, vw), pf, o[dt], 0, 0, 0);
        }
    }
    const float inv = 1.0f / den;
#pragma unroll
    for (int dt = 0; dt < DH / 16; ++dt) { uint2 w; w.x = pack2(o[dt][0] * inv, o[dt][1] * inv); w.y = pack2(o[dt][2] * inv, o[dt][3] * inv); *(uint2*)(orow + dt * 16 + fq * 4) = w; }
    if (lse_out && fq == 0) *lse_out = m + __logf(den);
}

struct DilItem { int b, h, pp, d, r, nb; };
DI DilItem dil_decode(int item) { DilItem I; const int sub = item & 31; I.pp = (item >> 5) % 3; const int bh = item / 96; I.b = bh / 12; I.h = bh % 12;
    if (I.pp == 0) { I.d = 1; I.r = 0; I.nb = sub; } else if (I.pp == 1) { I.d = 4; I.r = sub >> 3; I.nb = sub & 7; } else { I.d = 16; I.r = sub >> 1; I.nb = sub & 1; } return I; }
DI void dil_load(const int ctx_tid, const PView& p, int item, u32x4 (&kq)[4], u32x2 (&vq)[8], bf16x8 (&qf)[2], float& btv) {
    const char* Zb = (const char*)(p.ws + OFF_Z); const DilItem I = dil_decode(item);
    const unsigned strideB = (unsigned)I.d * (unsigned)(NINP * 2);
    const unsigned base0 = ((unsigned)(I.b * SEQ + I.r) * (unsigned)NINP + (unsigned)(I.h * 64)) * 2u;
    const int m0 = 128 * (I.nb - 1);
    { const int w = ctx_tid >> 6, lane = ctx_tid & 63; const int qi = 16 * w + (lane & 15);
      const char* qrow = Zb + (base0 + (unsigned)(m0 + 128 + qi) * strideB + (unsigned)((lane >> 4) * 16)); qf[0] = *(const bf16x8*)(qrow); qf[1] = *(const bf16x8*)(qrow + 64); }
    { const int u = ctx_tid - 31; const int uc = u < 0 ? 0 : (u > 128 ? 128 : u); const float bv = ((const float*)(p.ws + OFF_BT))[(I.pp * 12 + I.h) * 132 + (128 - uc)]; btv = (u >= 0 && u <= 128) ? bv : -1e30f; }
    { const int key = ctx_tid >> 1, hf = ctx_tid & 1; const int mk = m0 + key; const unsigned msk = mk < 0 ? 0u : 0xffffffffu;
      const char* zr = Zb + (base0 + (unsigned)(mk < 0 ? 0 : mk) * strideB + (unsigned)((768 + hf * 32) * 2));
#pragma unroll
      for (int i = 0; i < 4; ++i) kq[i] = *(const u32x4*)(zr + i * 16) & msk; }
    { const int kg = ctx_tid >> 4, dg = ctx_tid & 15; const int mk0 = m0 + kg * 8; const unsigned msk = mk0 < 0 ? 0u : 0xffffffffu;
      const char* zv = Zb + (base0 + (unsigned)(mk0 < 0 ? 0 : mk0) * strideB + (unsigned)((1536 + dg * 4) * 2));
#pragma unroll
      for (int k = 0; k < 8; ++k) vq[k] = *(const u32x2*)(zv + (unsigned)k * strideB) & msk; }
}
DI void dil_stage(const int ctx_tid, const PView& p, int item, const u32x4 (&kq)[4], const u32x2 (&vq)[8], const float btv, LAS unsigned char* lds) {
    constexpr int KS = 144, VS = 528; const DilItem I = dil_decode(item);
    LAS unsigned char* Kl = lds; LAS unsigned char* Vl = lds + 256 * KS; LAS float* btl = (LAS float*)(lds + 256 * KS + 64 * VS);
    const int tid = ctx_tid, key = tid >> 1, hf = tid & 1;
    if (tid < 192) btl[tid] = btv;
#pragma unroll
    for (int i = 0; i < 4; ++i) *(LAS u32x4*)(Kl + key * KS + hf * 64 + i * 16) = kq[i];
    { const int kg = tid >> 4, dg = tid & 15; u32x4 o[4];
#pragma unroll
      for (int i = 0; i < 4; ++i) {
          o[0][i] = __builtin_amdgcn_perm(vq[2 * i + 1].x, vq[2 * i].x, 0x05040100u); o[1][i] = __builtin_amdgcn_perm(vq[2 * i + 1].x, vq[2 * i].x, 0x07060302u);
          o[2][i] = __builtin_amdgcn_perm(vq[2 * i + 1].y, vq[2 * i].y, 0x05040100u); o[3][i] = __builtin_amdgcn_perm(vq[2 * i + 1].y, vq[2 * i].y, 0x07060302u); }
#pragma unroll
      for (int d = 0; d < 4; ++d) *(LAS u32x4*)(Vl + (dg * 4 + d) * VS + kg * 16) = o[d]; }
}
DI void dil_compute(const int ctx_tid, const int ctx_bid, const int ctx_g, const PView& p, int item, const bf16x8 (&qf)[2], LAS unsigned char* lds) {
    constexpr int KS = 144, VS = 528; const DilItem I = dil_decode(item);
    unsigned char* ws = p.ws; const bf16_t* Z = (const bf16_t*)(ws + OFF_Z);
    LAS unsigned char* Kl = lds; LAS unsigned char* Vl = lds + 256 * KS; LAS float* btl = (LAS float*)(lds + 256 * KS + 64 * VS);
    const int w = ctx_tid >> 6, lane = ctx_tid & 63;
    const int qi = 16 * w + (lane & 15); const int tq = I.b * SEQ + (128 * I.nb + qi) * I.d + I.r;
    bf16_t* AP = (bf16_t*)(ws + OFF_AP); float* LSE = (float*)(ws + OFF_LSE);
    attn_wave<64, 5, true>(ctx_tid, ctx_bid, ctx_g, Kl, KS, Vl, VS, qf, w >> 1, 0.125f, qi, I.nb == 0, btl,
                           AP + ((size_t)I.pp * T + tq) * 768 + I.h * 64, LSE + ((size_t)I.pp * T + tq) * 12 + I.h);
}
DI void cross_item(const int ctx_tid, const int ctx_bid, const int ctx_g, const PView& p, int item, const bool restage, LAS unsigned char* lds) {
#ifdef NO_CROSS
    return;
#endif
    unsigned char* ws = p.ws; const bf16_t* KV = (const bf16_t*)(ws + OFF_KV); const bf16_t* Q = (const bf16_t*)(ws + OFF_Q); bf16_t* O = (bf16_t*)(ws + OFF_O);
    const int tid = ctx_tid, w = tid >> 6, lane = tid & 63;
    const int kv = item & 15, qb = item >> 4, b = kv >> 2, mh = kv & 3;
    constexpr int KS = 272, VS = 528;
    LAS unsigned char* Kl = lds; LAS unsigned char* Vl = lds + 256 * KS;
    const int tq = b * SEQ + qb * 128 + 16 * w + (lane & 15);
    bf16x8 qf[4];
#pragma unroll
    for (int ks = 0; ks < 4; ++ks) qf[ks] = *(const bf16x8*)(Q + (size_t)tq * 512 + mh * 128 + ks * 32 + (lane >> 4) * 8);
    if (restage) {
        { const int key = tid >> 1, hf = tid & 1; const bf16_t* kr = KV + (size_t)(b * 256 + key) * 1024 + mh * 128 + hf * 64;
          u32x4 kq[8];
#pragma unroll
          for (int i = 0; i < 8; ++i) kq[i] = *(const u32x4*)(kr + i * 8);
          const int kg = tid >> 4, dg = tid & 15; u32x4 vq[8];
#pragma unroll
          for (int k = 0; k < 8; ++k) vq[k] = *(const u32x4*)(KV + (size_t)(b * 256 + kg * 8 + k) * 1024 + 512 + mh * 128 + dg * 8);
#pragma unroll
          for (int i = 0; i < 8; ++i) *(LAS u32x4*)(Kl + key * KS + hf * 128 + i * 16) = kq[i];
#pragma unroll
          for (int c = 0; c < 4; ++c) {
              u32x4 lo, hi;
#pragma unroll
              for (int i = 0; i < 4; ++i) { lo[i] = __builtin_amdgcn_perm(vq[2 * i + 1][c], vq[2 * i][c], 0x05040100u); hi[i] = __builtin_amdgcn_perm(vq[2 * i + 1][c], vq[2 * i][c], 0x07060302u); }
              *(LAS u32x4*)(Vl + (dg * 8 + 2 * c) * VS + kg * 16) = lo; *(LAS u32x4*)(Vl + (dg * 8 + 2 * c + 1) * VS + kg * 16) = hi; } }
        __syncthreads();
    }
    attn_wave<128, 8, false>(ctx_tid, ctx_bid, ctx_g, Kl, KS, Vl, VS, qf, 0, 0.08838834764831845f, 0, false, nullptr, O + (size_t)tq * 512 + mh * 128, nullptr);
    __syncthreads();
}

DI void sgu_item(const int ctx_tid, const int ctx_bid, const int ctx_g, const PView& p, int l, int chunk, LAS unsigned char* lds) {
#ifdef NO_SGU
    return;
#endif
    unsigned char* ws = p.ws; const bf16_t* Z = (const bf16_t*)(ws + OFF_Z); bf16_t* MIX = (bf16_t*)(ws + OFF_MIX); const bf16_t* WS = (const bf16_t*)(ws + OFF_WS);
    const float* ng = p.in[8] + (size_t)l * 512; const float* sb = p.in[10] + (size_t)l * 1024; const float* og = p.in[11] + (size_t)l * 512;
    const int tid = ctx_tid, w = tid >> 6, lane = tid & 63, fr = lane & 15, fq = lane >> 4;
    constexpr int GS = 520;
    constexpr int GT = 136;
    LAS bf16_t* G = (LAS bf16_t*)lds;
    float gain8[8];
#pragma unroll
    for (int e = 0; e < 8; ++e) gain8[e] = ng[lane + 64 * e];
#pragma unroll 1
    for (int i0 = 0; i0 < 16; i0 += 4) {
        unsigned short raw[4][8];
#pragma unroll
        for (int ii = 0; ii < 4; ++ii) { const size_t tok = (size_t)chunk * 128 + 16 * w + i0 + ii;
#pragma unroll
            for (int e = 0; e < 8; ++e) raw[ii][e] = __builtin_nontemporal_load(Z + tok * NINP + 2816 + lane + 64 * e); }
#pragma unroll
        for (int ii = 0; ii < 4; ++ii) { const int j = 16 * w + i0 + ii;
            float f[8]; float s = 0.f;
#pragma unroll
            for (int e = 0; e < 8; ++e) { f[e] = gelu_t(bf2f(raw[ii][e])); s += f[e]; }
            const float mean = wsum(s) * (1.0f / 512.0f); float q = 0.f;
#pragma unroll
            for (int e = 0; e < 8; ++e) { f[e] -= mean; q += f[e] * f[e]; }
            const float rs = rsqrtf(wsum(q) * (1.0f / 512.0f) + 1e-6f);
#pragma unroll
            for (int e = 0; e < 8; ++e) G[(lane + 64 * e) * GT + j] = f2bf(f[e] * rs * gain8[e]); } }
    __syncthreads();
    bf16x8 bfr[4][4];
#pragma unroll
    for (int nt = 0; nt < 4; ++nt)
#pragma unroll
        for (int ks = 0; ks < 4; ++ks) bfr[nt][ks] = *(const LAS bf16x8*)(G + (w * 64 + nt * 16 + fr) * GT + ks * 32 + fq * 8);
    __syncthreads();
    unsigned short uc[4][4], un[4][4]; float bc4[4], bn4[4];
#pragma unroll
    for (int j = 0; j < 4; ++j) { const int i = fq * 4 + j; const size_t tok = (size_t)chunk * 128 + i; bc4[j] = sb[w * 128 + i];
#pragma unroll
        for (int nt = 0; nt < 4; ++nt) uc[j][nt] = __builtin_nontemporal_load(Z + tok * NINP + 2304 + w * 64 + nt * 16 + fr); }
#pragma unroll 1
    for (int it = 0; it < 8; ++it) {
        { const int itn = it < 7 ? it + 1 : 7;
#pragma unroll
          for (int j = 0; j < 4; ++j) { const int i = itn * 16 + fq * 4 + j; const size_t tok = (size_t)chunk * 128 + i; bn4[j] = sb[w * 128 + i];
#pragma unroll
            for (int nt = 0; nt < 4; ++nt) un[j][nt] = __builtin_nontemporal_load(Z + tok * NINP + 2304 + w * 64 + nt * 16 + fr); } }
        f32x4 acc[4];
#pragma unroll
        for (int nt = 0; nt < 4; ++nt) acc[nt] = (f32x4){0.f, 0.f, 0.f, 0.f};
#pragma unroll
        for (int ks = 0; ks < 4; ++ks) if (ks * 32 <= it * 16 + 15) {
            const bf16x8 a = *(const bf16x8*)(WS + (size_t)(w * 128 + it * 16 + fr) * 128 + ks * 32 + fq * 8);
#pragma unroll
            for (int nt = 0; nt < 4; ++nt) acc[nt] = __builtin_amdgcn_mfma_f32_16x16x32_bf16(a, bfr[nt][ks], acc[nt], 0, 0, 0); }
#pragma unroll
        for (int j = 0; j < 4; ++j) { const int i = it * 16 + fq * 4 + j;
#pragma unroll
            for (int nt = 0; nt < 4; ++nt) { const int c = w * 64 + nt * 16 + fr; const float u = gelu_t(bf2f(uc[j][nt]));
                G[i * GS + c] = f2bf(u * (acc[nt][j] + bc4[j])); } }
#pragma unroll
        for (int j = 0; j < 4; ++j) { bc4[j] = bn4[j];
#pragma unroll
            for (int nt = 0; nt < 4; ++nt) uc[j][nt] = un[j][nt]; }
    }
    __syncthreads();
    float og8[8];
#pragma unroll
    for (int e = 0; e < 8; ++e) og8[e] = og[lane * 8 + e];
    for (int i = 0; i < 16; ++i) { const int j = 16 * w + i; const size_t tok = (size_t)chunk * 128 + j;
        float f[8]; { const u32x4 lv = *(const LAS u32x4*)(G + j * GS + lane * 8); unpack8(make_uint4(lv.x, lv.y, lv.z, lv.w), f); } float q = 0.f;
#pragma unroll
        for (int e = 0; e < 8; ++e) q += f[e] * f[e];
        const float rs = rsqrtf(wsum(q) * (1.0f / 512.0f) + 1e-6f);
#pragma unroll
        for (int e = 0; e < 8; ++e) f[e] = f[e] * rs * og8[e];
        *(uint4*)(MIX + tok * DM + 768 + lane * 8) = pack8(f); }
    __syncthreads();
}

struct ScanRegs { u32x4 zr, zrp, zk, zkp, zv, zvp, aq, eq; };
constexpr int SSTEP = 392;
DI float rsum8(float x) { x += dppf<0xB1>(x); x += dppf<0x4E>(x); x += dppf<0x141>(x); return x; }
DI void scan_load(ScanRegs& R, const bf16_t* Z, const bf16_t* RWA, const bf16_t* RWD, int b, int h, int t, int l8) {
    const size_t tok = (size_t)b * SEQ + t; const bf16_t* zr = Z + tok * NINP + 3328 + h * 64 + l8 * 8;
    const bf16_t* zq = t > 0 ? zr - NINP : zr;
    R.zr = *(const u32x4*)(zr); R.zk = *(const u32x4*)(zr + 768); R.zv = *(const u32x4*)(zr + 1536);
    const unsigned msk = t > 0 ? 0xffffffffu : 0u;
    R.zrp = *(const u32x4*)(zq) & msk; R.zkp = *(const u32x4*)(zq + 768) & msk; R.zvp = *(const u32x4*)(zq + 1536) & msk;
    R.aq = *(const u32x4*)(RWA + tok * 768 + h * 64 + l8 * 8); R.eq = *(const u32x4*)(RWD + tok * 768 + h * 64 + l8 * 8);
}
DI void unpack8v(const u32x4 w, float (&f)[8]) { f[0] = bflo(w.x); f[1] = bfhi(w.x); f[2] = bflo(w.y); f[3] = bfhi(w.y); f[4] = bflo(w.z); f[5] = bfhi(w.z); f[6] = bflo(w.w); f[7] = bfhi(w.w); }
DI void lerp8(const u32x4 c, const u32x4 pv, const float* mu, float (&o)[8]) {
    float cc[8], pp[8]; unpack8v(c, cc); unpack8v(pv, pp);
#pragma unroll
    for (int e = 0; e < 8; ++e) o[e] = cc[e] + (pp[e] - cc[e]) * mu[e];
}
DI void phase_scan(const int ctx_tid, const int ctx_bid, const int ctx_g, const PView& p, int l, int sb, LAS unsigned char* lds) {
#ifdef NO_SCAN
    return;
#endif
    unsigned char* ws = p.ws; const bf16_t* Z = (const bf16_t*)(ws + OFF_Z); const bf16_t* RWA = (const bf16_t*)(ws + OFF_RWA); const bf16_t* RWD = (const bf16_t*)(ws + OFF_RWD);
    float* YR = (float*)(ws + OFF_YR); float* BON = (float*)(ws + OFF_BON);
    const int tid = ctx_tid, w = tid >> 6, lane = tid & 63, l8 = lane & 7;
    const int part = sb & 1, bh = sb >> 1, b = bh / 12, h = bh % 12;
    const int row0 = part * 32, nscan = 4;
    const bool scanner = w < nscan;
    const int half = part;
    const int ts = (tid & 255) >> 3;
    const int row = row0 + (w & 3) * 8 + (lane >> 3);
    LAS float* buf = (LAS float*)lds;
    if (w >= 4) {
        const float* mub = p.in[12] + (size_t)l * 2688 + h * 64 + l8 * 8;
        float mur[8], muk[8], muv[8], kk8[8], ka8[8], rk8[8];
#pragma unroll
        for (int e = 0; e < 8; ++e) { mur[e] = mub[e]; muk[e] = mub[768 + e]; muv[e] = mub[1536 + e];
            kk8[e] = p.in[18][(size_t)l * 768 + h * 64 + l8 * 8 + e]; ka8[e] = p.in[19][(size_t)l * 768 + h * 64 + l8 * 8 + e]; rk8[e] = p.in[20][(size_t)l * 768 + h * 64 + l8 * 8 + e]; }
        ScanRegs R;
        auto process = [&](int stage, int t) {
            float r8[8], k8[8], v8[8]; lerp8(R.zr, R.zrp, mur, r8); lerp8(R.zk, R.zkp, muk, k8); lerp8(R.zv, R.zvp, muv, v8);
            float a8[8], w8[8]; unpack8v(R.aq, a8); unpack8v(R.eq, w8);
#pragma unroll
            for (int e = 0; e < 8; ++e) w8[e] = __expf(-w8[e]);
            float kkv[8], n2 = 0.f;
#pragma unroll
            for (int e = 0; e < 8; ++e) { kkv[e] = k8[e] * kk8[e]; n2 += kkv[e] * kkv[e]; }
            n2 = rsum8(n2); const float inv = 1.0f / fmaxf(sqrtf(n2), 1e-12f);
            float kp[8], bb[8], nk[8], bon = 0.f;
#pragma unroll
            for (int e = 0; e < 8; ++e) { const float kh = kkv[e] * inv; nk[e] = -kh; bb[e] = kh * a8[e]; kp[e] = k8[e] * (1.0f + (a8[e] - 1.0f) * ka8[e]);
                bon += r8[e] * kp[e] * rk8[e]; }
            bon = rsum8(bon);
            LAS float* d = buf + (stage * 32 + ts) * SSTEP + l8 * 8;
#pragma unroll
            for (int q = 0; q < 2; ++q) {
                *(LAS f32x4*)(d + q * 4) = (f32x4){w8[q * 4], w8[q * 4 + 1], w8[q * 4 + 2], w8[q * 4 + 3]}; *(LAS f32x4*)(d + 64 + q * 4) = (f32x4){nk[q * 4], nk[q * 4 + 1], nk[q * 4 + 2], nk[q * 4 + 3]};
                *(LAS f32x4*)(d + 128 + q * 4) = (f32x4){bb[q * 4], bb[q * 4 + 1], bb[q * 4 + 2], bb[q * 4 + 3]}; *(LAS f32x4*)(d + 192 + q * 4) = (f32x4){kp[q * 4], kp[q * 4 + 1], kp[q * 4 + 2], kp[q * 4 + 3]};
                *(LAS f32x4*)(d + 256 + q * 4) = (f32x4){r8[q * 4], r8[q * 4 + 1], r8[q * 4 + 2], r8[q * 4 + 3]}; *(LAS f32x4*)(d + 320 + q * 4) = (f32x4){v8[q * 4], v8[q * 4 + 1], v8[q * 4 + 2], v8[q * 4 + 3]}; }
            if (l8 == 0 && half == 0) BON[((size_t)b * SEQ + t) * 12 + h] = bon;
        };
        scan_load(R, Z, RWA, RWD, b, h, ts, l8);
        process(0, ts);
        scan_load(R, Z, RWA, RWD, b, h, 32 + ts, l8);
        __syncthreads();
        for (int ci = 0; ci < SEQ / 32; ++ci) {
            if (ci + 1 < SEQ / 32) { process((ci + 1) & 1, (ci + 1) * 32 + ts); if (ci + 2 < SEQ / 32) scan_load(R, Z, RWA, RWD, b, h, (ci + 2) * 32 + ts, l8); }
            __syncthreads();
        }
    } else if (!scanner) {
        __syncthreads();
        for (int ci = 0; ci < SEQ / 32; ++ci) __syncthreads();
    } else {
        __builtin_amdgcn_s_setprio(3);
        f32x2 S[4];
#pragma unroll
        for (int i = 0; i < 4; ++i) S[i] = (f32x2){0.f, 0.f};
        __syncthreads();
        for (int ci = 0; ci < SEQ / 32; ++ci) {
            const int t0 = ci * 32;
            const LAS float* sbuf = buf + (ci & 1) * 32 * SSTEP;
            float yk[4];
            const LAS float* d0 = sbuf + l8 * 8;
            f32x4 W0 = *(const LAS f32x4*)(d0), W1 = *(const LAS f32x4*)(d0 + 4), N0 = *(const LAS f32x4*)(d0 + 64), N1 = *(const LAS f32x4*)(d0 + 68), B0 = *(const LAS f32x4*)(d0 + 128), B1 = *(const LAS f32x4*)(d0 + 132),
                  K0 = *(const LAS f32x4*)(d0 + 192), K1 = *(const LAS f32x4*)(d0 + 196), R0 = *(const LAS f32x4*)(d0 + 256), R1 = *(const LAS f32x4*)(d0 + 260);
            float vv = sbuf[320 + row];
            const bool b0 = (l8 & 1) != 0, b1 = (l8 & 2) != 0, b2 = (l8 & 4) != 0;
#pragma unroll
            for (int hh = 0; hh < 4; ++hh) {
                float pp[8];
#pragma unroll
                for (int s8 = 0; s8 < 8; ++s8) {
                    const int s = hh * 8 + s8; const int sn = s < 31 ? s + 1 : 31;
                    const LAS float* dn = sbuf + sn * SSTEP + l8 * 8;
                    const f32x4 nW0 = *(const LAS f32x4*)(dn), nW1 = *(const LAS f32x4*)(dn + 4), nN0 = *(const LAS f32x4*)(dn + 64), nN1 = *(const LAS f32x4*)(dn + 68), nB0 = *(const LAS f32x4*)(dn + 128), nB1 = *(const LAS f32x4*)(dn + 132),
                                nK0 = *(const LAS f32x4*)(dn + 192), nK1 = *(const LAS f32x4*)(dn + 196), nR0 = *(const LAS f32x4*)(dn + 256), nR1 = *(const LAS f32x4*)(dn + 260);
                    const float nvv = sbuf[sn * SSTEP + 320 + row];
                    const f32x2 d1v = (S[0] * (f32x2){N0.x, N0.y} + S[1] * (f32x2){N0.z, N0.w}) + (S[2] * (f32x2){N1.x, N1.y} + S[3] * (f32x2){N1.z, N1.w});
                    const float sa = rsum8(d1v.x + d1v.y);
                    const f32x2 sa2 = {sa, sa}, vv2 = {vv, vv};
                    S[0] = S[0] * (f32x2){W0.x, W0.y} + (sa2 * (f32x2){B0.x, B0.y} + vv2 * (f32x2){K0.x, K0.y});
                    S[1] = S[1] * (f32x2){W0.z, W0.w} + (sa2 * (f32x2){B0.z, B0.w} + vv2 * (f32x2){K0.z, K0.w});
                    S[2] = S[2] * (f32x2){W1.x, W1.y} + (sa2 * (f32x2){B1.x, B1.y} + vv2 * (f32x2){K1.x, K1.y});
                    S[3] = S[3] * (f32x2){W1.z, W1.w} + (sa2 * (f32x2){B1.z, B1.w} + vv2 * (f32x2){K1.z, K1.w});
                    const f32x2 yv = (S[0] * (f32x2){R0.x, R0.y} + S[1] * (f32x2){R0.z, R0.w}) + (S[2] * (f32x2){R1.x, R1.y} + S[3] * (f32x2){R1.z, R1.w});
                    pp[s8] = yv.x + yv.y;
                    W0 = nW0; W1 = nW1; N0 = nN0; N1 = nN1; B0 = nB0; B1 = nB1; K0 = nK0; K1 = nK1; R0 = nR0; R1 = nR1; vv = nvv;
                }
                float q4[4], r2[2];
#pragma unroll
                for (int i = 0; i < 4; ++i) q4[i] = (b0 ? pp[2 * i + 1] : pp[2 * i]) + dppf<0xB1>(b0 ? pp[2 * i] : pp[2 * i + 1]);
#pragma unroll
                for (int i = 0; i < 2; ++i) r2[i] = (b1 ? q4[2 * i + 1] : q4[2 * i]) + dppf<0x4E>(b1 ? q4[2 * i] : q4[2 * i + 1]);
                { const float keep = b2 ? r2[1] : r2[0], send = b2 ? r2[0] : r2[1];
                  int xr = __builtin_amdgcn_update_dpp(0, __float_as_int(send), 0x104, 0xF, 0x5, false);
                  xr = __builtin_amdgcn_update_dpp(xr, __float_as_int(send), 0x114, 0xF, 0xA, false);
                  yk[hh] = keep + __int_as_float(xr); }
            }
            { float* yo = YR + ((size_t)b * SEQ + t0 + l8) * 768 + h * 64 + row;
#pragma unroll
              for (int hh = 0; hh < 4; ++hh) yo[(size_t)hh * 8 * 768] = yk[hh]; }
            __syncthreads();
        }
        __builtin_amdgcn_s_setprio(0);
    }
}

template <int PART>
DI void phase_mixpost(const int ctx_tid, const int ctx_bid, const int ctx_g, const PView& p, int l, int gw, int nw, const bool xm = false) {
#ifdef NO_POST
    return;
#endif
    unsigned char* ws = p.ws; const bf16_t* Z = (const bf16_t*)(ws + OFF_Z); const bf16_t* AP = (const bf16_t*)(ws + OFF_AP); const float* LSE = (const float*)(ws + OFF_LSE);
    const bf16_t* RWG = (const bf16_t*)(ws + OFF_RWG); const float* YR = (const float*)(ws + OFF_YR); const float* BON = (const float*)(ws + OFF_BON); bf16_t* MIX = (bf16_t*)(ws + OFF_MIX);
    const float* aog = p.in[7] + (size_t)l * 768; const float* muv = p.in[12] + (size_t)l * 2688 + 1536; const float* lg = p.in[21] + (size_t)l * 768; const float* lb = p.in[22] + (size_t)l * 768;
    const int lane = ctx_tid & 63;
    const int hq = lane >> 4, dq = (lane & 15) * 4;
    f32x4 g_a[3], g_mu[3], g_lg[3], g_lb[3];
#pragma unroll
    for (int i = 0; i < 3; ++i) { const int c = (hq + 4 * i) * 64 + dq; g_a[i] = *(const f32x4*)(aog + c); g_mu[i] = *(const f32x4*)(muv + c); g_lg[i] = *(const f32x4*)(lg + c); g_lb[i] = *(const f32x4*)(lb + c); }
    for (int ti = 0; ; ++ti) { const int t = xm ? xcd_row(ctx_bid, __builtin_amdgcn_readfirstlane(ctx_tid >> 6), ctx_g, ti) : gw + ti * nw; if (t >= T) break;
        const bool hasp = (t % SEQ) != 0;
        if (PART == 1) {
            u32x2 ap[3][3]; float lse[3][3];
#pragma unroll
            for (int i = 0; i < 3; ++i) { const int j = hq + 4 * i, c = j * 64 + dq;
#pragma unroll
                for (int q = 0; q < 3; ++q) { lse[q][i] = LSE[((size_t)q * T + t) * 12 + j]; ap[q][i] = __builtin_nontemporal_load((const u32x2*)(AP + ((size_t)q * T + t) * 768 + c)); } }
            f32x4 oa[3]; float ss = 0.f;
#pragma unroll
            for (int i = 0; i < 3; ++i) {
                const float l0 = lse[0][i], l1 = lse[1][i], l2 = lse[2][i];
                const float mx = fmaxf(l0, fmaxf(l1, l2)); const float e0 = __expf(l0 - mx), e1 = __expf(l1 - mx), e2 = __expf(l2 - mx); const float inv = 1.0f / (e0 + e1 + e2);
                const f32x4 a0 = {bflo(ap[0][i].x), bfhi(ap[0][i].x), bflo(ap[0][i].y), bfhi(ap[0][i].y)}, a1 = {bflo(ap[1][i].x), bfhi(ap[1][i].x), bflo(ap[1][i].y), bfhi(ap[1][i].y)}, a2 = {bflo(ap[2][i].x), bfhi(ap[2][i].x), bflo(ap[2][i].y), bfhi(ap[2][i].y)};
                oa[i] = (a0 * e0 + a1 * e1 + a2 * e2) * inv; ss += oa[i][0] * oa[i][0] + oa[i][1] * oa[i][1] + oa[i][2] * oa[i][2] + oa[i][3] * oa[i][3]; }
            const float rs = rsqrtf(wsum(ss) * (1.0f / 768.0f) + 1e-6f);
#pragma unroll
            for (int i = 0; i < 3; ++i) { const int c = (hq + 4 * i) * 64 + dq; const f32x4 o1 = oa[i] * rs * g_a[i];
                u32x2 w1; w1.x = pack2(o1[0], o1[1]); w1.y = pack2(o1[2], o1[3]); *(u32x2*)(MIX + (size_t)t * DM + c) = w1; }
        } else {
            u32x2 rg[3], zc[3], zp[3]; float bon[3]; f32x4 yr[3];
#pragma unroll
            for (int i = 0; i < 3; ++i) { const int j = hq + 4 * i, c = j * 64 + dq;
                bon[i] = BON[(size_t)t * 12 + j]; yr[i] = __builtin_nontemporal_load((const f32x4*)(YR + (size_t)t * 768 + c)); rg[i] = __builtin_nontemporal_load((const u32x2*)(RWG + (size_t)t * 768 + c));
                zc[i] = *(const u32x2*)(Z + (size_t)t * NINP + 4864 + c); zp[i] = hasp ? *(const u32x2*)(Z + (size_t)(t - 1) * NINP + 4864 + c) : (u32x2){0u, 0u}; }
#pragma unroll
            for (int i = 0; i < 3; ++i) {
                const f32x4 y = yr[i]; const float mean = rsum16((y[0] + y[1]) + (y[2] + y[3])) * (1.0f / 64.0f); const f32x4 yc = y - mean;
                const float var = rsum16((yc[0] * yc[0] + yc[1] * yc[1]) + (yc[2] * yc[2] + yc[3] * yc[3])) * (1.0f / 64.0f);
                f32x4 yn = yc * rsqrtf(var + 64e-5f) * g_lg[i] + g_lb[i];
                const f32x4 vc = {bflo(zc[i].x), bfhi(zc[i].x), bflo(zc[i].y), bfhi(zc[i].y)}, vp = {bflo(zp[i].x), bfhi(zp[i].x), bflo(zp[i].y), bfhi(zp[i].y)};
                const f32x4 vs = vc + (vp - vc) * g_mu[i];
                yn += vs * bon[i];
                const f32x4 gg = {bflo(rg[i].x), bfhi(rg[i].x), bflo(rg[i].y), bfhi(rg[i].y)};
                const f32x4 o2 = yn * gg; const int c = (hq + 4 * i) * 64 + dq;
                u32x2 w2; w2.x = pack2(o2[0], o2[1]); w2.y = pack2(o2[2], o2[3]); *(u32x2*)(MIX + (size_t)t * DM + 1280 + c) = w2; }
        }
    }
}

DI void phase_convfix(const int ctx_tid, const int ctx_bid, const int ctx_g, const PView& p, int l) {
#ifdef NO_CONV
    return;
#endif
    unsigned char* ws = p.ws; bf16_t* ACT = (bf16_t*)(ws + OFF_ACT); const float* HALO = (const float*)(ws + OFF_HALO); const float* PART = (const float*)(ws + OFF_PART);
    const float* cw = p.in[27] + (size_t)l * 3 * NUP;
    const int gt = ctx_bid * 512 + ctx_tid, ng = ctx_g * 512;
    for (int it = gt; it < (T / 128) * 2 * (DFF / 4); it += ng) {
        const int c = (it % (DFF / 4)) * 4, gr = it / (DFF / 4), r = gr & 1, g = gr >> 1;
        const int colp = (c >> 7) * 256 + (c & 127);
        f32x4 pg = *(const f32x4*)(PART + ((size_t)g * 2 + r) * NUP + colp), pv = *(const f32x4*)(PART + ((size_t)g * 2 + r) * NUP + colp + 128);
        if ((g * 128) % SEQ != 0) {
            const f32x4 g1 = *(const f32x4*)(HALO + ((size_t)(g - 1) * 2 + 1) * NUP + colp), v1 = *(const f32x4*)(HALO + ((size_t)(g - 1) * 2 + 1) * NUP + colp + 128);
            const f32x4 g2 = *(const f32x4*)(HALO + ((size_t)(g - 1) * 2) * NUP + colp), v2 = *(const f32x4*)(HALO + ((size_t)(g - 1) * 2) * NUP + colp + 128);
            const f32x4 wg0 = *(const f32x4*)(cw + c), wg1 = *(const f32x4*)(cw + NUP + c), wv0 = *(const f32x4*)(cw + DFF + c), wv1 = *(const f32x4*)(cw + NUP + DFF + c);
            if (r == 0) { pg += wg1 * g1 + wg0 * g2; pv += wv1 * v1 + wv0 * v2; } else { pg += wg0 * g1; pv += wv0 * v1; }
        }
        uint2 w; w.x = pack2(gelu_t(pg[0]) * pv[0], gelu_t(pg[1]) * pv[1]); w.y = pack2(gelu_t(pg[2]) * pv[2], gelu_t(pg[3]) * pv[3]);
        *(uint2*)(ACT + (size_t)(g * 128 + r) * DFF + c) = w;
    }
}

DI void run_gemm_bf16(const int ctx_tid, const int ctx_bid, const int ctx_g, LAS unsigned char* lds, const bf16_t* A, const bf16_t* Bt, int M, int N, int K, bf16_t* O, int ldc, int G, int c) {
#ifdef NO_GEMM
    return;
#endif
    pg8::Gemm g{A, Bt, M, N, K}; pg8::StaticOrder S; S.init(M, N, G, c); pg8::EpiBf16 E{O, ldc};
    pg8::gemm_phase<pg8::EpiBf16, pg8::StaticOrder, false>(ctx_tid, lds, g, S, E, nullptr);
}
DI void run_gemm_f32(const int ctx_tid, const int ctx_bid, const int ctx_g, LAS unsigned char* lds, const bf16_t* A, const bf16_t* Bt, int M, int N, int K, float* C, int ldc, int G, int c) {
#ifdef NO_GEMM
    return;
#endif
    pg8::Gemm g{A, Bt, M, N, K}; pg8::StaticOrder S; S.init(M, N, G, c); pg8::EpiF32 E{C, ldc, nullptr};
    pg8::gemm_phase<pg8::EpiF32, pg8::StaticOrder, false>(ctx_tid, lds, g, S, E, nullptr);
}

DI void run_gemm_conv(const int ctx_tid, const int ctx_bid, const int ctx_g, LAS unsigned char* lds, const bf16_t* A, const bf16_t* Bt, int M, int N, int K, bf16_t* ACT, const float* cw, const float* cb, float* HALO, float* PARTB, int G, int c) {
#ifdef NO_GEMM
    return;
#endif
    pg8::Gemm g{A, Bt, M, N, K}; pg8::StaticOrder S; S.init(M, N, G, c); pg8::EpiConv E{ACT, cw, cb, HALO, PARTB, DFF, NUP};
    pg8::gemm_phase<pg8::EpiConv, pg8::StaticOrder, false>(ctx_tid, lds, g, S, E, nullptr);
}
#define XB_TMO      128
#define XB_XCNT(j)  (256  + 64 * (j))
#define XB_XSUB(j)  (1280 + 64 * (j))
#define XB_XGEN(j)  (2304 + 64 * (j))
#define XB_TOP      3328
#define XB_TOPGEN   3392
#define XCD_BAR_WORDS 3456
#define XB_SPIN_CAP (1u << 18)

__device__ __forceinline__ unsigned xb_ld(unsigned* p)              { return __hip_atomic_load(p, __ATOMIC_RELAXED, __HIP_MEMORY_SCOPE_AGENT); }
__device__ __forceinline__ unsigned xb_add(unsigned* p, unsigned v) { return __hip_atomic_fetch_add(p, v, __ATOMIC_RELAXED, __HIP_MEMORY_SCOPE_AGENT); }
__device__ __forceinline__ unsigned xb_xcc_id() { return (unsigned)__builtin_amdgcn_s_getreg((3 << 11) | 20) & 0xFu; }
#define XB_SPIN(cond, bar) do { unsigned _sp = 0; while (cond) { __builtin_amdgcn_s_sleep(1); \
    if ((++_sp & 255u) == 0u) { if (xb_ld(&(bar)[XB_TMO])) break; if (_sp > XB_SPIN_CAP) { atomicAdd(&(bar)[XB_TMO], 1u); break; } } } } while (0)
struct XcdBarrier {
    unsigned* bar; unsigned x;
    volatile LAS unsigned* st;
};

__device__ __forceinline__ XcdBarrier xcd_barrier_post(unsigned* bar, volatile LAS unsigned* st, const bool tid0) {
    XcdBarrier b; b.bar = bar; b.x = xb_xcc_id(); b.st = st;
    if (tid0) (void)xb_add(&bar[XB_XCNT(b.x)], 1u);
    return b;
}
__device__ __forceinline__ void xcd_barrier_complete(unsigned* bar, unsigned x, unsigned& nloc, unsigned& nx) {
    const unsigned G = gridDim.x * gridDim.y * gridDim.z;
    unsigned sum, cnt, mine, sp = 0u;
    for (;;) {
        sum = 0u; cnt = 0u; mine = 0u;
#pragma unroll
        for (unsigned j = 0; j < 16; ++j) { const unsigned c = xb_ld(&bar[XB_XCNT(j)]); sum += c; cnt += (c > 0u) ? 1u : 0u; mine = (j == x) ? c : mine; }
        if (sum == G) break;
        __builtin_amdgcn_s_sleep(1);
        if ((++sp & 255u) == 0u) { if (xb_ld(&bar[XB_TMO])) break; if (sp > XB_SPIN_CAP) { atomicAdd(&bar[XB_TMO], 1u); break; } }
    }
    nloc = mine > 0u ? mine : 1u; nx = cnt > 0u ? cnt : 1u;
}

__device__ __forceinline__ void xcd_barrier(const XcdBarrier& b, const bool tid0) {
    asm volatile("s_waitcnt vmcnt(0)" ::: "memory");
    __syncthreads();
    if (tid0) {
        unsigned* bar = b.bar;
        __builtin_amdgcn_s_waitcnt(0);
        unsigned nloc = b.st[0], nx = b.st[1];
        if (nloc == 0u) { xcd_barrier_complete(bar, b.x, nloc, nx); b.st[0] = nloc; b.st[1] = nx; }
        const unsigned old = xb_add(&bar[XB_XSUB(b.x)], 1u);
        const unsigned gen = old / nloc;
        if (old + 1u == (gen + 1u) * nloc) {
            __builtin_amdgcn_fence(__ATOMIC_RELEASE, "agent");
            asm volatile("s_waitcnt vmcnt(0)" ::: "memory");
            const unsigned og = xb_add(&bar[XB_TOP], 1u);
            const unsigned tg = og / nx;
            if (og + 1u == (tg + 1u) * nx) xb_add(&bar[XB_TOPGEN], 1u);
            else XB_SPIN(xb_ld(&bar[XB_TOPGEN]) == tg, bar);
            __builtin_amdgcn_fence(__ATOMIC_ACQUIRE, "agent");
            xb_add(&bar[XB_XGEN(b.x)], 1u);
            asm volatile("s_waitcnt vmcnt(0)" ::: "memory");
        } else {
            XB_SPIN(xb_ld(&bar[XB_XGEN(b.x)]) == gen, bar);
            __builtin_amdgcn_fence(__ATOMIC_ACQUIRE, "agent");
            asm volatile("s_waitcnt vmcnt(0)" ::: "memory");
        }
    }
    __syncthreads();
}

DI void sub_barrier(unsigned* cnt, unsigned target, const bool tid0) {
    asm volatile("s_waitcnt vmcnt(0)" ::: "memory");
    __syncthreads();
    if (tid0) {
        __builtin_amdgcn_fence(__ATOMIC_RELEASE, "agent"); asm volatile("s_waitcnt vmcnt(0)" ::: "memory");
        (void)__hip_atomic_fetch_add(cnt, 1u, __ATOMIC_RELAXED, __HIP_MEMORY_SCOPE_AGENT);
        unsigned sp = 0;
        while (__hip_atomic_load(cnt, __ATOMIC_RELAXED, __HIP_MEMORY_SCOPE_AGENT) < target) { __builtin_amdgcn_s_sleep(2); if (++sp > (1u << 22)) break; }
        __builtin_amdgcn_fence(__ATOMIC_ACQUIRE, "agent"); asm volatile("s_waitcnt vmcnt(0)" ::: "memory");
    }
    __syncthreads();
}
__global__ __launch_bounds__(512, 2) void mega(Params pin, int ph_lo, int ph_hi) {
    extern __shared__ __attribute__((aligned(16))) unsigned char shm[];
    LAS unsigned char* lds = (LAS unsigned char*)shm;
    const int gridDim_x0 = (int)gridDim.x;
    const int wave_sgpr = __builtin_amdgcn_readfirstlane((int)(threadIdx.x >> 6));
    volatile LAS unsigned* xb_st = (volatile LAS unsigned*)(lds + LDS_BYTES - 16);
    if (threadIdx.x == 0) { xb_st[0] = 0u; xb_st[1] = 0u; xb_st[2] = 0u; xb_st[3] = 0u; }
    __syncthreads();
    XcdBarrier xb; xb.bar = (unsigned*)(pin.ws + OFF_CTL); xb.x = 0; xb.st = xb_st;
    if (ph_hi - ph_lo > 1) xb = xcd_barrier_post((unsigned*)(pin.ws + OFF_CTL), xb_st, threadIdx.x == 0);
    if (ph_lo < 0) cg::this_grid().sync();
    for (int ph = ph_lo; ph < ph_hi; ++ph) {
        if (ph == NPL && ph > ph_lo) continue;
        if (ph > ph_lo) {
            xcd_barrier(xb, wave_sgpr == 0 && (int)__builtin_amdgcn_mbcnt_hi(~0u, __builtin_amdgcn_mbcnt_lo(~0u, 0u)) == 0);
#ifdef EXTRA_SYNCS
            for (int es = 0; es < EXTRA_SYNCS; ++es) xcd_barrier(xb, wave_sgpr == 0 && (int)__builtin_amdgcn_mbcnt_hi(~0u, __builtin_amdgcn_mbcnt_lo(~0u, 0u)) == 0);
#endif
        }
        const int l = ph / NPL, lp = ph % NPL;
        const int nrep = ((REP_MASK >> lp) & 1) ? 2 : 1;
        for (int rep = 0; rep < nrep; ++rep) {
        if (rep) xcd_barrier(xb, wave_sgpr == 0 && (int)__builtin_amdgcn_mbcnt_hi(~0u, __builtin_amdgcn_mbcnt_lo(~0u, 0u)) == 0);
        size_t zero = 0; asm volatile("" : "+s"(zero));
        int wv_ = wave_sgpr; asm volatile("" : "+s"(wv_));
        int ctx_tid = wv_ * 64 + (int)__builtin_amdgcn_mbcnt_hi(~0u, __builtin_amdgcn_mbcnt_lo(~0u, 0u)); asm volatile("" : "+v"(ctx_tid));
        int ctx_bid = blockIdx.x; asm volatile("" : "+s"(ctx_bid));
        int ctx_g = (int)gridDim_x0; asm volatile("" : "+s"(ctx_g));
        const int bid = ctx_bid, G = ctx_g;
        PView p; p.in.pp = &pin; p.in.zero = zero; p.out = pin.out + zero; p.ws = pin.ws + zero;
        unsigned char* ws = p.ws; bf16_t* HB = (bf16_t*)(ws + OFF_HB);
        const float* gains = p.in[3] + (size_t)l * 6 * DM;
        int gk = 0; const bf16_t* gA = nullptr; const bf16_t* gB = nullptr; int gM = 0, gN = 0, gK = 0, gld = 0, gG = G, gc = bid; void* gO = nullptr;
        switch (lp) {
        case 0: phase_cvt(ctx_tid, ctx_bid, ctx_g, p, l, lds); break;
        case 1: gk = 1; gA = HB; gB = (const bf16_t*)(ws + OFF_WIN) + (size_t)3072 * DM; gM = T; gN = NINP - 3072; gK = DM; gO = (bf16_t*)(ws + OFF_Z) + 3072; gld = NINP; break;
        case 2: phase_rwkv_prep(ctx_tid, ctx_bid, ctx_g, p, l, lds); break;
        case 3:
            if (bid < SCAN_BLOCKS) { if (!(rep && P3_MODE == 2)) phase_scan(ctx_tid, ctx_bid, ctx_g, p, l, bid, lds); }
            else if (!(rep && P3_MODE == 1)) { gk = 1; gA = HB; gB = (const bf16_t*)(ws + OFF_WIN); gM = T; gN = 3072; gK = DM; gO = ws + OFF_Z; gld = NINP; gG = G - SCAN_BLOCKS; gc = bid - SCAN_BLOCKS; }
            break;
        case 4: phase_mixpost<2>(ctx_tid, ctx_bid, ctx_g, p, l, ctx_bid * 8 + __builtin_amdgcn_readfirstlane(ctx_tid >> 6), ctx_g * 8, true); break;
        case 5: gk = 1; gA = (const bf16_t*)(ws + OFF_MIX); gB = (const bf16_t*)(ws + OFF_WOUT); gM = T; gN = DM; gK = DM; gO = ws + OFF_Y; gld = DM; break;
        case 6: if (l == 0) phase_resid<true, false>(ctx_tid, ctx_bid, ctx_g, (const bf16_t*)(ws + OFF_Y), p.in[0], ws + OFF_XB, gains + DM, gains + 2 * DM, HB);
                else phase_resid<false, false>(ctx_tid, ctx_bid, ctx_g, (const bf16_t*)(ws + OFF_Y), ws + OFF_XB, ws + OFF_XB, gains + DM, gains + 2 * DM, HB);
                break;
        case 7: { const int nh = G / 2;
            if (bid < nh) { gk = 1; gA = HB; gB = (const bf16_t*)(ws + OFF_WQ); gM = T; gN = 512; gK = DM; gO = ws + OFF_Q; gld = 512; gG = nh; gc = bid; }
            else { gk = 1; gA = (const bf16_t*)(ws + OFF_MEMN); gB = (const bf16_t*)(ws + OFF_WKV); gM = 1024; gN = 1024; gK = DM; gO = ws + OFF_KV; gld = 1024; gG = G - nh; gc = bid - nh; } } break;
        case 8: { int last_kv = -1; for (int it = bid; it < 512; it += G) { cross_item(ctx_tid, ctx_bid, ctx_g, p, it, (it & 15) != last_kv, lds); last_kv = it & 15; } } break;
        case 9: gk = 1; gA = (const bf16_t*)(ws + OFF_O); gB = (const bf16_t*)(ws + OFF_WO); gM = T; gN = DM; gK = 512; gO = ws + OFF_Y; gld = DM; break;
        case 10: phase_resid<false, false>(ctx_tid, ctx_bid, ctx_g, (const bf16_t*)(ws + OFF_Y), ws + OFF_XB, ws + OFF_XB, gains + 3 * DM, gains + 4 * DM, HB); break;
        case 11: gk = 3; gA = HB; gB = (const bf16_t*)(ws + OFF_WUP); gM = T; gN = NUP; gK = DM; gO = ws + OFF_ACT; break;
        case 12: phase_convfix(ctx_tid, ctx_bid, ctx_g, p, l); break;
        case 13: gk = 1; gA = (const bf16_t*)(ws + OFF_ACT); gB = (const bf16_t*)(ws + OFF_WDN); gM = T; gN = DM; gK = DFF; gO = ws + OFF_Y; gld = DM; break;
        case 14: if (l + 1 < 2) phase_resid<false, false>(ctx_tid, ctx_bid, ctx_g, (const bf16_t*)(ws + OFF_Y), ws + OFF_XB, ws + OFF_XB, gains + 5 * DM, gains + 6 * DM, HB);
                 else phase_resid<false, true>(ctx_tid, ctx_bid, ctx_g, (const bf16_t*)(ws + OFF_Y), ws + OFF_XB, p.out, gains + 5 * DM, nullptr, HB);
                 if (l == 0 && ph_hi - ph_lo > 1) phase_cvt(ctx_tid, ctx_bid, ctx_g, p, 1, lds);
                 break;
        }
        if (gk == 1) run_gemm_bf16(ctx_tid, ctx_bid, ctx_g, lds, gA, gB, gM, gN, gK, (bf16_t*)gO, gld, gG, gc);
        else if (gk == 3) run_gemm_conv(ctx_tid, ctx_bid, ctx_g, lds, gA, gB, gM, gN, gK, (bf16_t*)gO, p.in[27] + (size_t)l * 3 * NUP, p.in[28] + (size_t)l * NUP, (float*)(ws + OFF_HALO), (float*)(ws + OFF_PART), gG, gc);
        if (lp == 3 && bid >= SCAN_BLOCKS && !(rep && P3_MODE == 1)) {
            const int nb = G - SCAN_BLOCKS; int it = bid - SCAN_BLOCKS;
            sub_barrier((unsigned*)(ws + OFF_CTL) + 3584 + 64 * (l * 2 + rep), (unsigned)nb, ctx_tid == 0);
#ifndef NO_SGU
            for (; it < 128; it += nb) sgu_item(ctx_tid, ctx_bid, ctx_g, p, l, it, lds);
#endif
#ifndef NO_DIL
            u32x4 kq[4]; u32x2 vq[8]; bf16x8 qc[2], qn[2]; float btv; int item = it - 128;
            dil_load(ctx_tid, p, item < 4608 ? item : 4607, kq, vq, qc, btv);
            for (; item < 4608; item += nb) {
                dil_stage(ctx_tid, p, item, kq, vq, btv, lds); __syncthreads();
                dil_load(ctx_tid, p, item + nb < 4608 ? item + nb : 4607, kq, vq, qn, btv);
                dil_compute(ctx_tid, ctx_bid, ctx_g, p, item, qc, lds); __syncthreads();
                qc[0] = qn[0]; qc[1] = qn[1]; }
#endif
            sub_barrier((unsigned*)(ws + OFF_CTL) + 3840 + 64 * (l * 2 + rep), (unsigned)nb, ctx_tid == 0);
            phase_mixpost<1>(ctx_tid, ctx_bid, ctx_g, p, l, (bid - SCAN_BLOCKS) * 8 + __builtin_amdgcn_readfirstlane(ctx_tid >> 6), nb * 8);
        }
        }
    }
}

#ifndef MK_SINGLE
#define MK_SINGLE 1
#endif
extern "C" void kernel_launch(void* const* d_in, const int* in_sizes, int n_in, void* d_out, int out_size, void* d_ws, size_t ws_size, hipStream_t stream) {
    (void)in_sizes; (void)out_size;
    if (n_in < 30 || ws_size < WS_NEED) { fprintf(stderr, "kernel_launch: bad arguments (n_in %d, ws %zu < %zu)\n", n_in, ws_size, (size_t)WS_NEED); return; }
    Params p{};
    for (int i = 0; i < 30; ++i) p.in[i] = (const float*)d_in[i];
    p.out = (float*)d_out; p.ws = (unsigned char*)d_ws;
    hipFuncSetAttribute((const void*)mega, hipFuncAttributeMaxDynamicSharedMemorySize, LDS_BYTES);
    int dev = 0, cus = 0, per_cu = 0;
    hipGetDevice(&dev); hipDeviceGetAttribute(&cus, hipDeviceAttributeMultiprocessorCount, dev);
    hipOccupancyMaxActiveBlocksPerMultiprocessor(&per_cu, mega, 512, LDS_BYTES);
    if (per_cu < 1) per_cu = 1;
    int grid = cus * per_cu; if (grid > 256) grid = 256; if (grid < 128) grid = 128;
    if (hipMemsetAsync((unsigned char*)d_ws + OFF_CTL, 0, CTL_BYTES, stream) != hipSuccess) { fprintf(stderr, "kernel_launch: memset of the barrier words failed\n"); return; }
#if MK_SINGLE
    int lo = 0, hi = 2 * NPL; void* args[] = {&p, &lo, &hi};
    hipError_t e = hipLaunchCooperativeKernel((void*)mega, dim3(grid), dim3(512), args, LDS_BYTES, stream);
    if (e != hipSuccess) fprintf(stderr, "cooperative launch failed: %s (grid %d)\n", hipGetErrorString(e), grid);
#else
    for (int ph = 0; ph < 2 * NPL; ++ph) hipLaunchKernelGGL(mega, dim3(grid), dim3(512), LDS_BYTES, stream, p, ph, ph + 1);
#endif
}
```

```cpp
#include <hip/hip_runtime.h>
#include <hip/hip_cooperative_groups.h>
#include <cstdio>
#include <cstdint>
namespace cg = cooperative_groups;
namespace pg8 {
#define PG8_LAS __attribute__((address_space(3)))
typedef unsigned short bf16_t;
typedef short bf16x8 __attribute__((ext_vector_type(8)));
typedef float f32x4 __attribute__((ext_vector_type(4)));
typedef unsigned u32x4 __attribute__((ext_vector_type(4)));
constexpr int BM = 256, BK = 64, HALF = 128, HTB = HALF * BK * 2  , STAGE_BYTES = 8 * HTB, NXCD = 8, WGM = 4;

__host__ __device__ __forceinline__ int lds_byte(int r, int c) { const int st = (r >> 4) * 2 + (c >> 5), rr = r & 15, cc = c & 31, ob = rr * 64 + cc * 2; return st * 1024 + (ob ^ (((ob >> 9) & 1) << 5)); }
__host__ __device__ __forceinline__ void stage_rc(int b, int& R, int& C) { const int st = b / 1024, sb = b % 1024, swz = sb ^ (((sb >> 9) & 1) << 5); R = (st >> 1) * 16 + swz / 64; C = (st & 1) * 32 + (swz % 64) / 2; }
__host__ __device__ __forceinline__ int perm32(int rho) { const int n = rho >> 4, i = rho & 15; return 8 * (i >> 2) + 4 * n + (i & 3); }

struct Unit { int pm, pn; };
struct Gemm { const bf16_t* A; const bf16_t* Bt; int M, N, K; };

struct StaticOrder {
    int nM, nN, nwg, G, c;
    __host__ __device__ void init(int M, int N, int G_, int c_) { nM = M / BM; nN = N / BM; nwg = nM * nN; G = G_; c = c_; }
    __host__ __device__ bool next(int i, Unit& u) const {
        const long L = (long)i * G + c; if (L >= nwg) return false;
        int wgid = (int)L; { const int q = nwg / NXCD, r = nwg % NXCD, xcd = wgid % NXCD, off = wgid / NXCD; wgid = (xcd < r ? xcd * (q + 1) : r * (q + 1) + (xcd - r) * q) + off; }
        const int nig = WGM * nN, gid = wgid / nig, fm = gid * WGM, gsz = (nM - fm) < WGM ? (nM - fm) : WGM;
        u.pm = fm + ((wgid % nig) % gsz); u.pn = (wgid % nig) / gsz; return true;
    }
    __device__ __forceinline__ void a_ready(const Unit&) const {}
    __device__ __forceinline__ void done(const Unit&) const {}
};
__device__ __forceinline__ unsigned cvt_pk_bf16(float lo, float hi) { unsigned r; asm volatile("v_cvt_pk_bf16_f32 %0, %1, %2" : "=v"(r) : "v"(lo), "v"(hi)); return r; }
struct EpiF32 {
    static constexpr bool PERM = false, AFTER_DRAIN = false, TOKPERM = false;
    float* C; int ldc; const float* bias;
    __device__ __forceinline__ void operator()(const f32x4 (&acc)[2][2][4][2], const Unit& u, int wr, int wc, int fr, int fq) const {
        const int row0 = u.pm * BM + wr * 64 + fr, col0 = u.pn * BM + wc * 32 + 4 * fq;
        f32x4 bv[2][2];
#pragma unroll
        for (int bj = 0; bj < 2; ++bj)
#pragma unroll
            for (int n = 0; n < 2; ++n) bv[bj][n] = bias ? *(const f32x4*)(bias + col0 + bj * HALF + n * 16) : (f32x4){0.f, 0.f, 0.f, 0.f};
#pragma unroll
        for (int ai = 0; ai < 2; ++ai)
#pragma unroll
            for (int m = 0; m < 4; ++m) { float* rowp = C + (size_t)(row0 + ai * HALF + m * 16) * ldc + col0;
#pragma unroll
                for (int bj = 0; bj < 2; ++bj)
#pragma unroll
                    for (int n = 0; n < 2; ++n) *(f32x4*)(rowp + bj * HALF + n * 16) = acc[ai][bj][m][n] + bv[bj][n]; }
    }
};
struct EpiBf16 {
    static constexpr bool PERM = true, AFTER_DRAIN = false, TOKPERM = false;
    bf16_t* O; int ldc;
    __device__ __forceinline__ void operator()(const f32x4 (&acc)[2][2][4][2], const Unit& u, int wr, int wc, int fr, int fq) const {
        const int row0 = u.pm * BM + wr * 64 + fr; const int col0 = u.pn * BM + wc * 32 + 8 * fq;
#pragma unroll
        for (int ai = 0; ai < 2; ++ai)
#pragma unroll
            for (int m = 0; m < 4; ++m) { bf16_t* rowp = O + (size_t)(row0 + ai * HALF + m * 16) * ldc + col0;
#pragma unroll
                for (int bj = 0; bj < 2; ++bj) { const f32x4 v0 = acc[ai][bj][m][0], v1 = acc[ai][bj][m][1];
                    u32x4 w; w.x = cvt_pk_bf16(v0[0], v0[1]); w.y = cvt_pk_bf16(v0[2], v0[3]); w.z = cvt_pk_bf16(v1[0], v1[1]); w.w = cvt_pk_bf16(v1[2], v1[3]);
                    *(u32x4*)(rowp + bj * HALF) = w; } }
    }
};

typedef unsigned u32x2 __attribute__((ext_vector_type(2)));
template <int CTRL> __device__ __forceinline__ float epi_dpp(float x) { return __int_as_float(__builtin_amdgcn_update_dpp(0, __float_as_int(x), CTRL, 0xF, 0xF, true)); }
__device__ __forceinline__ float epi_gelu_t(float x) { const float u = 0.7978845608028654f * (x + 0.044715f * x * x * x); return x * __builtin_amdgcn_rcpf(1.0f + __expf(-2.0f * u)); }
struct EpiConv {
    static constexpr bool PERM = true, AFTER_DRAIN = false, TOKPERM = true;
    bf16_t* ACT; const float* cw; const float* cb; float* HALO; float* PARTB; int dff, nup;
    __device__ __forceinline__ void operator()(const f32x4 (&acc)[2][2][4][2], const Unit& u, int wr, int wc, int fr, int fq) const {
        const int tok0 = u.pm * BM + (wr * 16 + fr) * 8;
        const int grp = u.pm * 2 + wr;
        const int cl = wc * 32 + fq * 8;
#pragma unroll
        for (int n = 0; n < 2; ++n) {
            const int ch = u.pn * 128 + cl + 4 * n;
            const int colp = u.pn * 256 + cl + 4 * n;
            const f32x4 bg = *(const f32x4*)(cb + ch), bv = *(const f32x4*)(cb + dff + ch);
            f32x4 wg[3], wv[3];
#pragma unroll
            for (int j = 0; j < 3; ++j) { wg[j] = *(const f32x4*)(cw + (size_t)j * nup + ch); wv[j] = *(const f32x4*)(cw + (size_t)j * nup + dff + ch); }
            f32x4 hg6, hg7, hv6, hv7;
#pragma unroll
            for (int e = 0; e < 4; ++e) { hg6[e] = epi_dpp<0x111>(acc[1][0][2][n][e]); hg7[e] = epi_dpp<0x111>(acc[1][0][3][n][e]); hv6[e] = epi_dpp<0x111>(acc[1][1][2][n][e]); hv7[e] = epi_dpp<0x111>(acc[1][1][3][n][e]); }
            if (fr == 15) {
                float* h = HALO + ((size_t)grp * 2) * nup + colp;
                *(f32x4*)(h) = acc[1][0][2][n]; *(f32x4*)(h + 128) = acc[1][1][2][n]; *(f32x4*)(h + nup) = acc[1][0][3][n]; *(f32x4*)(h + nup + 128) = acc[1][1][3][n]; }
            if (fr == 0) {
                float* q = PARTB + ((size_t)grp * 2) * nup + colp;
                *(f32x4*)(q) = bg + wg[2] * acc[0][0][0][n]; *(f32x4*)(q + 128) = bv + wv[2] * acc[0][1][0][n];
                *(f32x4*)(q + nup) = bg + wg[2] * acc[0][0][1][n] + wg[1] * acc[0][0][0][n]; *(f32x4*)(q + nup + 128) = bv + wv[2] * acc[0][1][1][n] + wv[1] * acc[0][1][0][n]; }
#pragma unroll
            for (int j = 0; j < 8; ++j) {
                const f32x4 g0 = acc[j >> 2][0][j & 3][n], v0 = acc[j >> 2][1][j & 3][n];
                const f32x4 g1 = j >= 1 ? acc[(j - 1 < 0 ? 0 : j - 1) >> 2][0][(j - 1 < 0 ? 0 : j - 1) & 3][n] : hg7, v1 = j >= 1 ? acc[(j - 1 < 0 ? 0 : j - 1) >> 2][1][(j - 1 < 0 ? 0 : j - 1) & 3][n] : hv7;
                const f32x4 g2 = j >= 2 ? acc[(j - 2 < 0 ? 0 : j - 2) >> 2][0][(j - 2 < 0 ? 0 : j - 2) & 3][n] : (j == 1 ? hg7 : hg6), v2 = j >= 2 ? acc[(j - 2 < 0 ? 0 : j - 2) >> 2][1][(j - 2 < 0 ? 0 : j - 2) & 3][n] : (j == 1 ? hv7 : hv6);
                const f32x4 gc = bg + wg[0] * g2 + wg[1] * g1 + wg[2] * g0, vc = bv + wv[0] * v2 + wv[1] * v1 + wv[2] * v0;
                if (j >= 2 || fr != 0) { u32x2 w; w.x = cvt_pk_bf16(epi_gelu_t(gc[0]) * vc[0], epi_gelu_t(gc[1]) * vc[1]); w.y = cvt_pk_bf16(epi_gelu_t(gc[2]) * vc[2], epi_gelu_t(gc[3]) * vc[3]);
                    *(u32x2*)(ACT + (size_t)(tok0 + j) * dff + ch) = w; }
            }
        }
    }
};
template <class Epi, class Sched, bool STAMP = false>
__device__ __forceinline__ void gemm_phase(const int tid_in, PG8_LAS unsigned char* lds, const Gemm g, const Sched& S, const Epi& E, unsigned long long* stamps) {
    const int tid = tid_in, wid = __builtin_amdgcn_readfirstlane(tid >> 6), lane = tid & 63, wr = wid >> 2, wc = wid & 3, fr = lane & 15, fq = lane >> 4;
    const int K = g.K, nt = K / BK;
    int ts_lo = 0, ts_hi = 0, nts = 0; const unsigned long long rt_entry = STAMP ? (unsigned long long)wall_clock64() : 0ull;
#define PG8_STAMP() do { if (STAMP && wid == 0 && nts < 64) { const unsigned long long _c = (unsigned long long)clock64(); \
        ts_lo = (lane == nts) ? (int)(unsigned)_c : ts_lo; ts_hi = (lane == nts) ? (int)(unsigned)(_c >> 32) : ts_hi; ++nts; } } while (0)
    PG8_STAMP();
    unsigned voffA[2], voffB[2];
#pragma unroll
    for (int i = 0; i < 2; ++i) { int R, C; stage_rc(tid * 16 + i * 8192, R, C); const int Rb = Epi::PERM ? ((R & ~31) + perm32(R & 31)) : R;
        const int Ra = Epi::TOKPERM ? ((((R >> 6) * 16 + (R & 15)) * 8) + ((R >> 4) & 3)) : R;
        voffA[i] = (unsigned)(Ra * K + C) * 2u; voffB[i] = (unsigned)(Rb * K + C) * 2u; }
    const size_t kstep = (size_t)(BK * 2);
    const size_t hstep = (size_t)HALF * K * 2;
    const size_t hstepA = Epi::TOKPERM ? (size_t)4 * K * 2 : hstep;
    const size_t tstep = 2 * hstep;
    const unsigned ldsw = (unsigned)wid * 1024u;
    const int aoff = lds_byte(wr * 64 + fr, fq * 8), boff = lds_byte(wc * 32 + fr, fq * 8);
#define PG8_SA(b, h) (((b) * 2 + (h)) * HTB)
#define PG8_SB(b, h) ((4 + (b) * 2 + (h)) * HTB)
#define PG8_STAGE(bufoff, gbase, voff) do { _Pragma("unroll") for (int _i = 0; _i < 2; ++_i) \
        __builtin_amdgcn_global_load_lds((const unsigned*)((const char*)(gbase) + (voff)[_i]), (PG8_LAS unsigned*)(lds + (bufoff) + ldsw + _i * 8192), 16, 0, 0); } while (0)
#define PG8_LDA(dst, b, h) do { _Pragma("unroll") for (int m = 0; m < 4; ++m) _Pragma("unroll") for (int k = 0; k < 2; ++k) dst[m][k] = *(const PG8_LAS bf16x8*)(lds + PG8_SA(b, h) + aoff + m * 2048 + k * 1024); } while (0)
#define PG8_LDB(dst, b, h) do { _Pragma("unroll") for (int n = 0; n < 2; ++n) _Pragma("unroll") for (int k = 0; k < 2; ++k) dst[n][k] = *(const PG8_LAS bf16x8*)(lds + PG8_SB(b, h) + boff + n * 2048 + k * 1024); } while (0)
#define PG8_MMA(ai, bj, At, Bt) do { __builtin_amdgcn_s_setprio(1); _Pragma("unroll") for (int m = 0; m < 4; ++m) _Pragma("unroll") for (int n = 0; n < 2; ++n) _Pragma("unroll") for (int k = 0; k < 2; ++k) \
        acc[ai][bj][m][n] = __builtin_amdgcn_mfma_f32_16x16x32_bf16(Bt[n][k], At[m][k], acc[ai][bj][m][n], 0, 0, 0); __builtin_amdgcn_s_setprio(0); } while (0)
#define PG8_WAIT_V(n) asm volatile("s_waitcnt vmcnt(" #n ")" ::: "memory")
#define PG8_WAIT_L(n) asm volatile("s_waitcnt lgkmcnt(" #n ")" ::: "memory")
#define PG8_BAR __builtin_amdgcn_s_barrier()
#define PG8_SCHED __builtin_amdgcn_sched_barrier(0)
    Unit cur, nxt; int ui = 0;
    if (!S.next(0, cur)) return;
    f32x4 acc[2][2][4][2];
#pragma unroll
    for (int a = 0; a < 2; ++a)
#pragma unroll
        for (int b = 0; b < 2; ++b)
#pragma unroll
            for (int m = 0; m < 4; ++m)
#pragma unroll
                for (int n = 0; n < 2; ++n) acc[a][b][m][n] = (f32x4){0.f, 0.f, 0.f, 0.f};
    bf16x8 At[4][2], B0[2][2], B1[2][2];
    const char* cA = (const char*)g.A + (size_t)cur.pm * tstep; const char* cB = (const char*)g.Bt + (size_t)cur.pn * tstep;
    S.a_ready(cur);
    PG8_STAGE(PG8_SB(0, 0), cB, voffB); PG8_STAGE(PG8_SA(0, 0), cA, voffA); PG8_STAGE(PG8_SB(0, 1), cB + hstep, voffB); PG8_STAGE(PG8_SA(0, 1), cA + hstepA, voffA);
    if (wr == 1) PG8_BAR;
    PG8_WAIT_V(4); PG8_BAR;
    PG8_STAGE(PG8_SB(1, 0), cB + kstep, voffB); PG8_STAGE(PG8_SA(1, 0), cA + kstep, voffA); PG8_STAGE(PG8_SB(1, 1), cB + hstep + kstep, voffB);
    PG8_WAIT_V(6); PG8_BAR;
    PG8_STAMP();
    for (;;) {
        const bool has_next = S.next(ui + 1, nxt);
        const char* nA = has_next ? (const char*)g.A + (size_t)nxt.pm * tstep : cA; const char* nB = has_next ? (const char*)g.Bt + (size_t)nxt.pn * tstep : cB;
        for (int t = 0; t < nt; t += 2) {
            const bool last = (t == nt - 2);
            const char* a1 = cA + (size_t)(t + 1) * kstep;
            const char* a2 = last ? nA : cA + (size_t)(t + 2) * kstep; const char* b2 = last ? nB : cB + (size_t)(t + 2) * kstep;
            const char* a3 = a2 + kstep; const char* b3 = b2 + kstep;
            if (last && has_next) S.a_ready(nxt);
            PG8_LDB(B0, 0, 0); PG8_SCHED; PG8_LDA(At, 0, 0); PG8_STAGE(PG8_SA(1, 1), a1 + hstepA, voffA);
            PG8_WAIT_L(8); PG8_BAR; PG8_WAIT_L(0); PG8_MMA(0, 0, At, B0); PG8_BAR; PG8_SCHED;
            PG8_LDB(B1, 0, 1); PG8_STAGE(PG8_SB(0, 0), b2, voffB);
            PG8_BAR; PG8_WAIT_L(0); PG8_MMA(0, 1, At, B1); PG8_BAR;
            PG8_LDA(At, 0, 1); PG8_STAGE(PG8_SA(0, 0), a2, voffA);
            PG8_BAR; PG8_WAIT_L(0); PG8_MMA(1, 0, At, B0); PG8_BAR; PG8_SCHED;
            PG8_STAGE(PG8_SB(0, 1), b2 + hstep, voffB);
            PG8_WAIT_V(6); PG8_BAR; PG8_MMA(1, 1, At, B1); PG8_BAR;
            PG8_LDB(B0, 1, 0); PG8_SCHED; PG8_LDA(At, 1, 0); PG8_STAGE(PG8_SA(0, 1), a2 + hstepA, voffA);
            PG8_WAIT_L(8); PG8_BAR; PG8_WAIT_L(0); PG8_MMA(0, 0, At, B0); PG8_BAR; PG8_SCHED;
            PG8_LDB(B1, 1, 1); PG8_STAGE(PG8_SB(1, 0), b3, voffB);
            PG8_BAR; PG8_WAIT_L(0); PG8_MMA(0, 1, At, B1); PG8_BAR;
            PG8_LDA(At, 1, 1); PG8_STAGE(PG8_SA(1, 0), a3, voffA);
            PG8_BAR; PG8_WAIT_L(0); PG8_MMA(1, 0, At, B0); PG8_BAR; PG8_SCHED;
            PG8_STAGE(PG8_SB(1, 1), b3 + hstep, voffB);
            PG8_WAIT_V(6); PG8_BAR; PG8_MMA(1, 1, At, B1); PG8_BAR;
        }
        PG8_STAMP();
        if constexpr (!Epi::AFTER_DRAIN) { E(acc, cur, wr, wc, fr, fq); S.done(cur); }
        PG8_STAMP();
        if (!has_next) break;
#pragma unroll
        for (int a = 0; a < 2; ++a)
#pragma unroll
            for (int b = 0; b < 2; ++b)
#pragma unroll
                for (int m = 0; m < 4; ++m)
#pragma unroll
                    for (int n = 0; n < 2; ++n) acc[a][b][m][n] = (f32x4){0.f, 0.f, 0.f, 0.f};
        cur = nxt; cA = nA; cB = nB; ++ui;
    }
    PG8_WAIT_V(0);
    if (wr == 0) PG8_BAR;
    PG8_BAR;
    if constexpr (Epi::AFTER_DRAIN) { E.fused(acc, cur, wr, wc, fr, fq, lds, wid, lane); S.done(cur); }
    PG8_STAMP();
    if (STAMP && wid == 0) { stamps[lane] = lane < nts ? (((unsigned long long)(unsigned)ts_hi << 32) | (unsigned)ts_lo) : 0ull;
        if (lane == 62) stamps[62] = rt_entry; if (lane == 63) stamps[63] = (unsigned long long)wall_clock64(); }
#undef PG8_STAMP
#undef PG8_SA
#undef PG8_SB
#undef PG8_STAGE
#undef PG8_LDA
#undef PG8_LDB
#undef PG8_MMA
#undef PG8_WAIT_V
#undef PG8_WAIT_L
#undef PG8_BAR
#undef PG8_SCHED
}
}
#ifndef REP_MASK
#define REP_MASK 0
#endif
#ifndef P3_MODE
#define P3_MODE 0
#endif
typedef unsigned short bf16_t;
typedef pg8::bf16x8 bf16x8;
typedef pg8::f32x4 f32x4;
typedef pg8::u32x2 u32x2;
typedef unsigned u32x4 __attribute__((ext_vector_type(4)));
typedef float f32x2 __attribute__((ext_vector_type(2)));
#define DI __device__ __forceinline__
#define LAS __attribute__((address_space(3)))

constexpr int T = 16384, DM = 2048, SEQ = 4096, NIN = 6016, NINP = 6144, DFF = 5632, NUP = 11264;
constexpr int NPL = 15;
constexpr int LDS_BYTES = 147456;
constexpr int SCAN_BLOCKS = 96;
constexpr size_t al256(size_t x) { return (x + 255) & ~(size_t)255; }
constexpr size_t OFF_CTL = 0;
constexpr size_t CTL_BYTES = 16384;
constexpr size_t OFF_WIN = OFF_CTL + CTL_BYTES;
constexpr size_t OFF_WOUT = OFF_WIN + (size_t)NINP * DM * 2;
constexpr size_t OFF_WQ = OFF_WOUT + (size_t)DM * DM * 2;
constexpr size_t OFF_WKV = OFF_WQ + (size_t)512 * DM * 2;
constexpr size_t OFF_WO = OFF_WKV + (size_t)1024 * DM * 2;
constexpr size_t OFF_WUP = OFF_WO + (size_t)DM * 512 * 2;
constexpr size_t OFF_WDN = OFF_WUP + (size_t)NUP * DM * 2;
constexpr size_t OFF_LW = OFF_WDN + (size_t)DM * DFF * 2;
constexpr size_t OFF_LA = OFF_LW + (size_t)768 * 64 * 2;
constexpr size_t OFF_LG = OFF_LA + (size_t)768 * 64 * 2;
constexpr size_t OFF_WS = OFF_LG + (size_t)768 * 256 * 2;
constexpr size_t OFF_BT = OFF_WS + (size_t)8 * 128 * 128 * 2;
constexpr size_t OFF_MEMN = al256(OFF_BT + 3 * 12 * 132 * 4);
constexpr size_t OFF_HB = OFF_MEMN + (size_t)1024 * DM * 2;
constexpr size_t OFF_XB = OFF_HB + (size_t)T * DM * 2;
constexpr size_t OFF_R = OFF_XB + (size_t)T * DM * 2;
constexpr size_t OFF_Z = OFF_R;
constexpr size_t OFF_AP = OFF_Z + (size_t)T * NINP * 2;
constexpr size_t OFF_LSE = OFF_AP + (size_t)3 * T * 768 * 2;
constexpr size_t OFF_RWA = OFF_LSE + (size_t)3 * T * 12 * 4;
constexpr size_t OFF_RWD = OFF_RWA + (size_t)T * 768 * 2;
constexpr size_t OFF_RWG = OFF_RWD + (size_t)T * 768 * 2;
constexpr size_t OFF_YR = OFF_RWG + (size_t)T * 768 * 2;
constexpr size_t OFF_BON = OFF_YR + (size_t)T * 768 * 4;
constexpr size_t OFF_MIX = OFF_BON + (size_t)T * 12 * 4;
constexpr size_t OFF_END1 = OFF_MIX + (size_t)T * DM * 2;
constexpr size_t OFF_Y = OFF_R;
constexpr size_t OFF_Q = OFF_Y + (size_t)T * DM * 4;
constexpr size_t OFF_O = OFF_Q + (size_t)T * 512 * 2;
constexpr size_t OFF_KV = OFF_O + (size_t)T * 512 * 2;
constexpr size_t OFF_ACT = OFF_Y + (size_t)T * DM * 4;
constexpr size_t OFF_HALO = OFF_ACT + (size_t)T * DFF * 2;
constexpr size_t OFF_PART = OFF_HALO + (size_t)(T / 128) * 2 * NUP * 4;
constexpr size_t OFF_END2 = OFF_PART + (size_t)(T / 128) * 2 * NUP * 4;
constexpr size_t WS_NEED = OFF_END1 > OFF_END2 ? OFF_END1 : OFF_END2;
static_assert(OFF_Y + (size_t)T * DM * 4 <= OFF_MIX, "Y must not overlap MIX");

struct Params { const float* in[30]; float* out; unsigned char* ws; };
struct InArr { const Params* pp; size_t zero; DI const float* operator[](int i) const { return pp->in[i] + zero; } };
struct PView { InArr in; float* out; unsigned char* ws; };

DI float bf2f(unsigned b) { return __uint_as_float(b << 16); }
DI float bflo(unsigned w) { return __uint_as_float(w << 16); }
DI float bfhi(unsigned w) { return __uint_as_float(w & 0xffff0000u); }
typedef __bf16 bf16x2_t __attribute__((ext_vector_type(2)));
DI unsigned pack2(float lo, float hi) { const f32x2 v = {lo, hi}; const bf16x2_t r = __builtin_convertvector(v, bf16x2_t); return __builtin_bit_cast(unsigned, r); }
DI bf16_t f2bf(float f) { return (bf16_t)(pack2(f, 0.f) & 0xffffu); }

template <int C> DI float dppf(float x) { return __int_as_float(__builtin_amdgcn_update_dpp(0, __float_as_int(x), C, 0xF, 0xF, true)); }
DI float rsum16(float x) { x += dppf<0xB1>(x); x += dppf<0x4E>(x); x += dppf<0x141>(x); x += dppf<0x140>(x); return x; }
DI float swz16(float x) { return __int_as_float(__builtin_amdgcn_ds_swizzle(__float_as_int(x), 0x401F)); }
DI float wsum(float x) { x = rsum16(x); x += swz16(x); return __int_as_float(__builtin_amdgcn_readlane(__float_as_int(x), 0)) + __int_as_float(__builtin_amdgcn_readlane(__float_as_int(x), 32)); }
DI float xor32(float x, int tid) { return __int_as_float(__builtin_amdgcn_ds_bpermute(((tid ^ 32) & 63) << 2, __float_as_int(x))); }
DI float gelu_t(float x) { const float u = 0.7978845608028654f * (x + 0.044715f * x * x * x); return x * __builtin_amdgcn_rcpf(1.0f + __expf(-2.0f * u)); }
DI float sigm(float x) { return __builtin_amdgcn_rcpf(1.0f + __expf(-x)); }
DI void unpack8(const uint4 w, float (&f)[8]) { f[0] = bflo(w.x); f[1] = bfhi(w.x); f[2] = bflo(w.y); f[3] = bfhi(w.y); f[4] = bflo(w.z); f[5] = bfhi(w.z); f[6] = bflo(w.w); f[7] = bfhi(w.w); }
DI uint4 pack8(const float (&f)[8]) { uint4 w; w.x = pack2(f[0], f[1]); w.y = pack2(f[2], f[3]); w.z = pack2(f[4], f[5]); w.w = pack2(f[6], f[7]); return w; }

template <int KT>
DI void cvt_job(const int ctx_tid, const int ctx_bid, const int ctx_g, const float* W, bf16_t* Bt, int K, int N, int Npad, int mode, int& tile_base, LAS float* tile) {
    constexpr int NL = KT / 32;
    const int tk = K / KT, tn = Npad / 64, nt = tk * tn, G = ctx_g, tid = ctx_tid, w = tid >> 6, lane = tid & 63;
    const int first = (ctx_bid - (tile_base % G) + G) % G;
    const int r = tid >> 4, c4 = (tid & 15) * 4;
    auto tile_src = [&](int ti, int& n0, int& k0, int& src, bool& valid) { const int ik = ti % tk, in_ = ti / tk; n0 = in_ * 64; k0 = ik * KT; src = n0; valid = n0 < N;
        if (mode == 1) { const int pn = n0 / 256, bj = (n0 % 256) / 128, off = n0 % 128; src = bj * DFF + pn * 128 + off; valid = true; } };
    float4 cur[NL], nxt[NL], nx2[NL];
    auto tile_load = [&](int ti, float4 (&v)[NL]) { int n0, k0, src; bool valid; tile_src(ti < nt ? ti : first, n0, k0, src, valid);
#pragma unroll
        for (int i = 0; i < NL; ++i) { if (valid) { const f32x4 t = __builtin_nontemporal_load((const f32x4*)(W + (size_t)(k0 + r + 32 * i) * N + src + c4)); v[i] = make_float4(t.x, t.y, t.z, t.w); } else v[i] = make_float4(0.f, 0.f, 0.f, 0.f); } };
    if (first < nt) { tile_load(first, cur); tile_load(first + G, nxt); }
    for (int ti = first; ti < nt; ti += G) {
        int n0, k0, src; bool valid; tile_src(ti, n0, k0, src, valid);
        tile_load(ti + 2 * G, nx2);
#pragma unroll
        for (int i = 0; i < NL; ++i) { LAS float* d = tile + (r + 32 * i) * 65 + c4; d[0] = cur[i].x; d[1] = cur[i].y; d[2] = cur[i].z; d[3] = cur[i].w; }
        __syncthreads();
        { constexpr int KW = KT / 8;
          bf16_t* o = Bt + (size_t)(n0 + lane) * K + k0 + w * KW;
#pragma unroll
          for (int q = 0; q < KW / 8; ++q) { float f[8];
#pragma unroll
            for (int j = 0; j < 8; ++j) f[j] = tile[(w * KW + q * 8 + j) * 65 + lane];
            *(uint4*)(o + q * 8) = pack8(f); } }
        __syncthreads();
#pragma unroll
        for (int i = 0; i < NL; ++i) { cur[i] = nxt[i]; nxt[i] = nx2[i]; }
    }
    tile_base += nt;
}
DI int xcd_row(const int bid, const int wave, const int G, const int i) {
    if (G == 256) return i < 8 ? 2048 * (bid & 7) + ((bid >> 3) * 8 + wave) + 256 * i : T;
    return bid * 8 + wave + i * G * 8;
}
DI void rmsnorm_rows_bf16(const int ctx_tid, const int ctx_bid, const int ctx_g, const float* X, const float* gain, bf16_t* O, int rows) {
    const int lane = ctx_tid & 63, wv = ctx_tid >> 6; const bool xm = (rows == T) && (ctx_g == 256);
    for (int ri = 0; ; ++ri) { const int r = xm ? xcd_row(ctx_bid, wv, 256, ri) : ctx_bid * 8 + wv + ri * ctx_g * 8; if (r >= rows) break;
        const float* x = X + (size_t)r * DM; float4 v[8]; float ss = 0.f;
#pragma unroll
        for (int i = 0; i < 8; ++i) { v[i] = *(const float4*)(x + (i * 64 + lane) * 4); ss += v[i].x * v[i].x + v[i].y * v[i].y + v[i].z * v[i].z + v[i].w * v[i].w; }
        const float rs = rsqrtf(wsum(ss) * (1.0f / DM) + 1e-6f);
#pragma unroll
        for (int i = 0; i < 8; ++i) { const float4 g = *(const float4*)(gain + (i * 64 + lane) * 4); uint2 w; w.x = pack2(v[i].x * rs * g.x, v[i].y * rs * g.y); w.y = pack2(v[i].z * rs * g.z, v[i].w * rs * g.w);
            *(uint2*)(O + (size_t)r * DM + (i * 64 + lane) * 4) = w; }
    }
}
DI int t5_bucket(int dist) {
    if (dist < 16) return dist;
    int bkt = 16;
    bkt += dist >= 22; bkt += dist >= 30; bkt += dist >= 40; bkt += dist >= 54; bkt += dist >= 73; bkt += dist >= 99; bkt += dist >= 134; bkt += dist >= 182;
    bkt += dist >= 246; bkt += dist >= 332; bkt += dist >= 450; bkt += dist >= 609; bkt += dist >= 825; bkt += dist >= 1117; bkt += dist >= 1513;
    return bkt;
}
DI void phase_cvt(const int ctx_tid, const int ctx_bid, const int ctx_g, const PView& p, int l, LAS unsigned char* lds) {
#ifdef NO_CVT
    return;
#endif
    unsigned char* ws = p.ws; LAS float* tile = (LAS float*)lds; int tb = 0;
    cvt_job<256>(ctx_tid, ctx_bid, ctx_g, p.in[5] + (size_t)l * DM * NIN, (bf16_t*)(ws + OFF_WIN), DM, NIN, NINP, 0, tb, tile);
    cvt_job<256>(ctx_tid, ctx_bid, ctx_g, p.in[26] + (size_t)l * DM * NUP, (bf16_t*)(ws + OFF_WUP), DM, NUP, NUP, 1, tb, tile);
    cvt_job<256>(ctx_tid, ctx_bid, ctx_g, p.in[29] + (size_t)l * DFF * DM, (bf16_t*)(ws + OFF_WDN), DFF, DM, DM, 0, tb, tile);
    cvt_job<256>(ctx_tid, ctx_bid, ctx_g, p.in[6] + (size_t)l * DM * DM, (bf16_t*)(ws + OFF_WOUT), DM, DM, DM, 0, tb, tile);
    cvt_job<256>(ctx_tid, ctx_bid, ctx_g, p.in[23] + (size_t)l * DM * 512, (bf16_t*)(ws + OFF_WQ), DM, 512, 512, 0, tb, tile);
    cvt_job<256>(ctx_tid, ctx_bid, ctx_g, p.in[24] + (size_t)l * DM * 1024, (bf16_t*)(ws + OFF_WKV), DM, 1024, 1024, 0, tb, tile);
    cvt_job<256>(ctx_tid, ctx_bid, ctx_g, p.in[25] + (size_t)l * 512 * DM, (bf16_t*)(ws + OFF_WO), 512, DM, DM, 0, tb, tile);
    cvt_job<64>(ctx_tid, ctx_bid, ctx_g, p.in[14] + (size_t)l * 64 * 768, (bf16_t*)(ws + OFF_LW), 64, 768, 768, 0, tb, tile);
    cvt_job<64>(ctx_tid, ctx_bid, ctx_g, p.in[16] + (size_t)l * 64 * 768, (bf16_t*)(ws + OFF_LA), 64, 768, 768, 0, tb, tile);
    cvt_job<256>(ctx_tid, ctx_bid, ctx_g, p.in[17] + (size_t)l * 256 * 768, (bf16_t*)(ws + OFF_LG), 256, 768, 768, 0, tb, tile);
    const int gt = ctx_bid * 512 + ctx_tid, ng = ctx_g * 512;
    { const float* sw = p.in[9] + (size_t)l * 8 * 128 * 128; bf16_t* o = (bf16_t*)(ws + OFF_WS);
      for (int i = gt; i < 8 * 128 * 128; i += ng) { const int jj = i & 127, ii = (i >> 7) & 127; o[i] = f2bf(jj <= ii ? sw[i] : 0.f); } }
    if (l == 0) { float* bt = (float*)(ws + OFF_BT);
      for (int i = gt; i < 3 * 12 * 129; i += ng) { const int delta = i % 129, h = (i / 129) % 12, pp = i / (129 * 12); const int d = pp == 0 ? 1 : (pp == 1 ? 4 : 16);
        bt[(pp * 12 + h) * 132 + delta] = p.in[2][t5_bucket(delta * d) * 12 + h]; } }
    rmsnorm_rows_bf16(ctx_tid, ctx_bid, ctx_g, p.in[1], p.in[4] + (size_t)l * DM, (bf16_t*)(ws + OFF_MEMN), 1024);
    if (l == 0) rmsnorm_rows_bf16(ctx_tid, ctx_bid, ctx_g, p.in[0], p.in[3], (bf16_t*)(ws + OFF_HB), T);
}

template <bool XIN_F32, bool XOUT_F32>
DI void phase_resid(const int ctx_tid, const int ctx_bid, const int ctx_g, const bf16_t* Y, const void* xi_, void* xo_, const float* ga, const float* gb, bf16_t* HB) {
#ifdef NO_RESID
    return;
#endif
    const int lane = ctx_tid & 63, wv = ctx_tid >> 6;
    for (int ri = 0, r = xcd_row(ctx_bid, wv, ctx_g, 0); r < T; r = xcd_row(ctx_bid, wv, ctx_g, ++ri)) {
        float4 xv[8], xin[8]; float ss = 0.f;
#pragma unroll
        for (int i = 0; i < 8; ++i) { const int c = (i * 64 + lane) * 4; const u32x2 yq = __builtin_nontemporal_load((const u32x2*)(Y + (size_t)r * DM + c)); float4 y; y.x = bflo(yq.x); y.y = bfhi(yq.x); y.z = bflo(yq.y); y.w = bfhi(yq.y); xv[i] = y; ss += y.x * y.x + y.y * y.y + y.z * y.z + y.w * y.w;
            if (XIN_F32) { const f32x4 t = __builtin_nontemporal_load((const f32x4*)((const float*)xi_ + (size_t)r * DM + c)); xin[i] = make_float4(t.x, t.y, t.z, t.w); }
            else { const u32x2 xq = __builtin_nontemporal_load((const u32x2*)((const bf16_t*)xi_ + (size_t)r * DM + c)); xin[i].x = bflo(xq.x); xin[i].y = bfhi(xq.x); xin[i].z = bflo(xq.y); xin[i].w = bfhi(xq.y); } }
        const float rs = rsqrtf(wsum(ss) * (1.0f / DM) + 1e-6f); float s2 = 0.f;
#pragma unroll
        for (int i = 0; i < 8; ++i) { const int c = (i * 64 + lane) * 4; const float4 g = *(const float4*)(ga + c); const float4 x = xin[i];
            float4 o; o.x = x.x + xv[i].x * rs * g.x; o.y = x.y + xv[i].y * rs * g.y; o.z = x.z + xv[i].z * rs * g.z; o.w = x.w + xv[i].w * rs * g.w;
            if (XOUT_F32) __builtin_nontemporal_store((f32x4){o.x, o.y, o.z, o.w}, (f32x4*)((float*)xo_ + (size_t)r * DM + c));
            else { uint2 w; w.x = pack2(o.x, o.y); w.y = pack2(o.z, o.w); *(uint2*)((bf16_t*)xo_ + (size_t)r * DM + c) = w; }
            xv[i] = o; s2 += o.x * o.x + o.y * o.y + o.z * o.z + o.w * o.w; }
        if (gb) { const float r2 = rsqrtf(wsum(s2) * (1.0f / DM) + 1e-6f);
#pragma unroll
            for (int i = 0; i < 8; ++i) { const int c = (i * 64 + lane) * 4; const float4 g = *(const float4*)(gb + c); uint2 w; w.x = pack2(xv[i].x * r2 * g.x, xv[i].y * r2 * g.y); w.y = pack2(xv[i].z * r2 * g.z, xv[i].w * r2 * g.w);
                *(uint2*)(HB + (size_t)r * DM + c) = w; } }
    }
}

DI void phase_rwkv_prep(const int ctx_tid, const int ctx_bid, const int ctx_g, const PView& p, int l, LAS unsigned char* lds) {
#ifdef NO_PREP
    return;
#endif
    unsigned char* ws = p.ws; const bf16_t* Z = (const bf16_t*)(ws + OFF_Z);
    const float* mu = p.in[12] + (size_t)l * 2688 + 2304; const float* w0 = p.in[13] + (size_t)l * 768; const float* a0 = p.in[15] + (size_t)l * 768;
    const bf16_t* LW = (const bf16_t*)(ws + OFF_LW); const bf16_t* LA = (const bf16_t*)(ws + OFF_LA); const bf16_t* LG = (const bf16_t*)(ws + OFF_LG);
    bf16_t* RWA = (bf16_t*)(ws + OFF_RWA); bf16_t* RWD = (bf16_t*)(ws + OFF_RWD); bf16_t* RWG = (bf16_t*)(ws + OFF_RWG);
    const int tid = ctx_tid, lane = tid & 63, w = tid >> 6, fr = lane & 15, fq = lane >> 4;
    constexpr int AST = 392;
    LAS bf16_t* A = (LAS bf16_t*)lds;
    for (int item = ctx_bid; item < T / 64; item += ctx_g) {
        { uint2 cur[4][3], prv[4][3];
#pragma unroll
          for (int r = 0; r < 4; ++r) { const int idx = tid + 512 * r, row = idx >> 5, cs = (idx & 31) * 12; const int t = item * 64 + row; const bool hasp = (t % SEQ) != 0;
            const bf16_t* zr = Z + (size_t)t * NINP + 5632 + cs;
#pragma unroll
            for (int q = 0; q < 3; ++q) { cur[r][q] = *(const uint2*)(zr + q * 4); prv[r][q] = make_uint2(0u, 0u); if (hasp) prv[r][q] = *(const uint2*)(zr - NINP + q * 4); } }
#pragma unroll
          for (int r = 0; r < 4; ++r) { const int idx = tid + 512 * r, row = idx >> 5, cs = (idx & 31) * 12;
#pragma unroll
            for (int q = 0; q < 3; ++q) { const float c4[4] = {bflo(cur[r][q].x), bfhi(cur[r][q].x), bflo(cur[r][q].y), bfhi(cur[r][q].y)}, p4[4] = {bflo(prv[r][q].x), bfhi(prv[r][q].x), bflo(prv[r][q].y), bfhi(prv[r][q].y)};
#pragma unroll
              for (int e = 0; e < 4; ++e) { const int c = cs + q * 4 + e; float v = c4[e] + (p4[e] - c4[e]) * mu[c];
                  if (c < 64) v = 1.0f - 2.0f * __builtin_amdgcn_rcpf(__expf(2.0f * v) + 1.0f); else if (c >= 128) v = sigm(v);
                  A[row * AST + c] = f2bf(v); } } } }
        __syncthreads();
        const int t0 = item * 64;
        bf16x8 bc[12]; float wz, az;
#pragma unroll 1
        for (int nt = 0; nt < 6; ++nt) {
            const int n0 = w * 96 + nt * 16, c = n0 + fr;
#pragma unroll
            for (int ks = 0; ks < 2; ++ks) { bc[ks] = *(const bf16x8*)(LW + (size_t)(n0 + fr) * 64 + ks * 32 + fq * 8); bc[2 + ks] = *(const bf16x8*)(LA + (size_t)(n0 + fr) * 64 + ks * 32 + fq * 8); }
#pragma unroll
            for (int ks = 0; ks < 8; ++ks) bc[4 + ks] = *(const bf16x8*)(LG + (size_t)(n0 + fr) * 256 + ks * 32 + fq * 8);
            wz = w0[c]; az = a0[c];
#pragma unroll 1
            for (int mt = 0; mt < 4; ++mt) {
                const LAS bf16_t* Ar = A + (mt * 16 + fr) * AST + fq * 8; const int tb = t0 + mt * 16 + fq * 4;
                f32x4 accw = {0.f, 0.f, 0.f, 0.f}, acca = {0.f, 0.f, 0.f, 0.f}, accg = {0.f, 0.f, 0.f, 0.f};
#pragma unroll
                for (int ks = 0; ks < 2; ++ks) { accw = __builtin_amdgcn_mfma_f32_16x16x32_bf16(*(const LAS bf16x8*)(Ar + ks * 32), bc[ks], accw, 0, 0, 0);
                                                 acca = __builtin_amdgcn_mfma_f32_16x16x32_bf16(*(const LAS bf16x8*)(Ar + 64 + ks * 32), bc[2 + ks], acca, 0, 0, 0); }
#pragma unroll
                for (int ks = 0; ks < 8; ++ks) accg = __builtin_amdgcn_mfma_f32_16x16x32_bf16(*(const LAS bf16x8*)(Ar + 128 + ks * 32), bc[4 + ks], accg, 0, 0, 0);
#pragma unroll
                for (int j = 0; j < 4; ++j) { const float u = wz + accw[j];
                    RWD[(size_t)(tb + j) * 768 + c] = f2bf(0.6065306597126334f * sigm(u)); RWA[(size_t)(tb + j) * 768 + c] = f2bf(sigm(az + acca[j])); RWG[(size_t)(tb + j) * 768 + c] = f2bf(accg[j]); }
            }
        }
        __syncthreads();
    }
}

template <int DH, int NSTEP, bool MASK>
DI void attn_wave(const int ctx_tid, const int ctx_bid, const int ctx_g, const LAS unsigned char* Kl, int KS, const LAS unsigned char* Vl, int VS, const bf16x8 (&qf)[DH / 32], int step0, float scale,
                  int qi, bool first_block, const LAS float* btab, bf16_t* orow, float* lse_out) {
    const int lane = ctx_tid & 63, fr = lane & 15, fq = lane >> 4;
    f32x4 s[NSTEP][2];
#pragma unroll
    for (int st = 0; st < NSTEP; ++st)
#pragma unroll
        for (int hf = 0; hf < 2; ++hf) {
            const int key0 = (step0 + st) * 32 + hf * 16; f32x4 acc = {0.f, 0.f, 0.f, 0.f};
#pragma unroll
            for (int ks = 0; ks < DH / 32; ++ks) { const bf16x8 kf = *(const LAS bf16x8*)(Kl + (key0 + fr) * KS + (ks * 32 + fq * 8) * 2);
                acc = __builtin_amdgcn_mfma_f32_16x16x32_bf16(kf, qf[ks], acc, 0, 0, 0); }
            s[st][hf] = acc;
        }
    float m = -3.0e38f;
    const int kjb = step0 * 32 + fq * 4, tb0 = kjb - qi + 31;
#pragma unroll
    for (int st = 0; st < NSTEP; ++st)
#pragma unroll
        for (int hf = 0; hf < 2; ++hf)
#pragma unroll
            for (int j = 0; j < 4; ++j) {
                float v = s[st][hf][j] * scale;
                if (MASK) v += btab[tb0 + st * 32 + hf * 16 + j];
                s[st][hf][j] = v;
            }
    if (MASK && first_block) {
#pragma unroll
        for (int st = 0; st < NSTEP; ++st)
#pragma unroll
            for (int hf = 0; hf < 2; ++hf)
#pragma unroll
                for (int j = 0; j < 4; ++j) s[st][hf][j] = (kjb + (st * 32 + hf * 16 + j) >= 128) ? s[st][hf][j] : -1e30f; }
#pragma unroll
    for (int st = 0; st < NSTEP; ++st)
#pragma unroll
        for (int hf = 0; hf < 2; ++hf)
#pragma unroll
            for (int j = 0; j < 4; ++j) m = fmaxf(m, s[st][hf][j]);
    m = fmaxf(m, swz16(m)); m = fmaxf(m, xor32(m, ctx_tid));
    float den = 0.f;
#pragma unroll
    for (int st = 0; st < NSTEP; ++st)
#pragma unroll
        for (int hf = 0; hf < 2; ++hf)
#pragma unroll
            for (int j = 0; j < 4; ++j) { const float e = __expf(s[st][hf][j] - m); s[st][hf][j] = e; den += e; }
    den += swz16(den); den += xor32(den, ctx_tid);
    f32x4 o[DH / 16];
#pragma unroll
    for (int dt = 0; dt < DH / 16; ++dt) o[dt] = (f32x4){0.f, 0.f, 0.f, 0.f};
#pragma unroll
    for (int st = 0; st < NSTEP; ++st) {
        uint4 pw; pw.x = pack2(s[st][0][0], s[st][0][1]); pw.y = pack2(s[st][0][2], s[st][0][3]); pw.z = pack2(s[st][1][0], s[st][1][1]); pw.w = pack2(s[st][1][2], s[st][1][3]);
        const bf16x8 pf = __builtin_bit_cast(bf16x8, pw);
        const int kb = (step0 + st) * 32;
#pragma unroll
        for (int dt = 0; dt < DH / 16; ++dt) {
            const LAS unsigned char* vr = Vl + (dt * 16 + fr) * VS + (kb + fq * 4) * 2;
            const u32x2 v0 = *(const LAS u32x2*)vr; const u32x2 v1 = *(const LAS u32x2*)(vr + 32);
            u32x4 vw; vw.x = v0.x; vw.y = v0.y; vw.z = v1.x; vw.w = v1.y;
            o[dt] = __builtin_amdgcn_mfma_f32_16x16x32_bf16(__builtin_bit_cast(bf16x8, vw), pf, o[dt], 0, 0, 0);
        }
    }
    const float inv = 1.0f / den;
#pragma unroll
    for (int dt = 0; dt < DH / 16; ++dt) { uint2 w; w.x = pack2(o[dt][0] * inv, o[dt][1] * inv); w.y = pack2(o[dt][2] * inv, o[dt][3] * inv); *(uint2*)(orow + dt * 16 + fq * 4) = w; }
    if (lse_out && fq == 0) *lse_out = m + __logf(den);
}

struct DilItem { int b, h, pp, d, r, nb; };
DI DilItem dil_decode(int item) { DilItem I; const int sub = item & 31; I.pp = (item >> 5) % 3; const int bh = item / 96; I.b = bh / 12; I.h = bh % 12;
    if (I.pp == 0) { I.d = 1; I.r = 0; I.nb = sub; } else if (I.pp == 1) { I.d = 4; I.r = sub >> 3; I.nb = sub & 7; } else { I.d = 16; I.r = sub >> 1; I.nb = sub & 1; } return I; }
DI void dil_load(const int ctx_tid, const PView& p, int item, u32x4 (&kq)[4], u32x2 (&vq)[8], bf16x8 (&qf)[2], float& btv) {
    const char* Zb = (const char*)(p.ws + OFF_Z); const DilItem I = dil_decode(item);
    const unsigned strideB = (unsigned)I.d * (unsigned)(NINP * 2);
    const unsigned base0 = ((unsigned)(I.b * SEQ + I.r) * (unsigned)NINP + (unsigned)(I.h * 64)) * 2u;
    const int m0 = 128 * (I.nb - 1);
    { const int w = ctx_tid >> 6, lane = ctx_tid & 63; const int qi = 16 * w + (lane & 15);
      const char* qrow = Zb + (base0 + (unsigned)(m0 + 128 + qi) * strideB + (unsigned)((lane >> 4) * 16)); qf[0] = *(const bf16x8*)(qrow); qf[1] = *(const bf16x8*)(qrow + 64); }
    { const int u = ctx_tid - 31; const int uc = u < 0 ? 0 : (u > 128 ? 128 : u); const float bv = ((const float*)(p.ws + OFF_BT))[(I.pp * 12 + I.h) * 132 + (128 - uc)]; btv = (u >= 0 && u <= 128) ? bv : -1e30f; }
    { const int key = ctx_tid >> 1, hf = ctx_tid & 1; const int mk = m0 + key; const unsigned msk = mk < 0 ? 0u : 0xffffffffu;
      const char* zr = Zb + (base0 + (unsigned)(mk < 0 ? 0 : mk) * strideB + (unsigned)((768 + hf * 32) * 2));
#pragma unroll
      for (int i = 0; i < 4; ++i) kq[i] = *(const u32x4*)(zr + i * 16) & msk; }
    { const int kg = ctx_tid >> 4, dg = ctx_tid & 15; const int mk0 = m0 + kg * 8; const unsigned msk = mk0 < 0 ? 0u : 0xffffffffu;
      const char* zv = Zb + (base0 + (unsigned)(mk0 < 0 ? 0 : mk0) * strideB + (unsigned)((1536 + dg * 4) * 2));
#pragma unroll
      for (int k = 0; k < 8; ++k) vq[k] = *(const u32x2*)(zv + (unsigned)k * strideB) & msk; }
}
DI void dil_stage(const int ctx_tid, const PView& p, int item, const u32x4 (&kq)[4], const u32x2 (&vq)[8], const float btv, LAS unsigned char* lds) {
    constexpr int KS = 144, VS = 528; const DilItem I = dil_decode(item);
    LAS unsigned char* Kl = lds; LAS unsigned char* Vl = lds + 256 * KS; LAS float* btl = (LAS float*)(lds + 256 * KS + 64 * VS);
    const int tid = ctx_tid, key = tid >> 1, hf = tid & 1;
    if (tid < 192) btl[tid] = btv;
#pragma unroll
    for (int i = 0; i < 4; ++i) *(LAS u32x4*)(Kl + key * KS + hf * 64 + i * 16) = kq[i];
    { const int kg = tid >> 4, dg = tid & 15; u32x4 o[4];
#pragma unroll
      for (int i = 0; i < 4; ++i) {
          o[0][i] = __builtin_amdgcn_perm(vq[2 * i + 1].x, vq[2 * i].x, 0x05040100u); o[1][i] = __builtin_amdgcn_perm(vq[2 * i + 1].x, vq[2 * i].x, 0x07060302u);
          o[2][i] = __builtin_amdgcn_perm(vq[2 * i + 1].y, vq[2 * i].y, 0x05040100u); o[3][i] = __builtin_amdgcn_perm(vq[2 * i + 1].y, vq[2 * i].y, 0x07060302u); }
#pragma unroll
      for (int d = 0; d < 4; ++d) *(LAS u32x4*)(Vl + (dg * 4 + d) * VS + kg * 16) = o[d]; }
}
DI void dil_compute(const int ctx_tid, const int ctx_bid, const int ctx_g, const PView& p, int item, const bf16x8 (&qf)[2], LAS unsigned char* lds) {
    constexpr int KS = 144, VS = 528; const DilItem I = dil_decode(item);
    unsigned char* ws = p.ws; const bf16_t* Z = (const bf16_t*)(ws + OFF_Z);
    LAS unsigned char* Kl = lds; LAS unsigned char* Vl = lds + 256 * KS; LAS float* btl = (LAS float*)(lds + 256 * KS + 64 * VS);
    const int w = ctx_tid >> 6, lane = ctx_tid & 63;
    const int qi = 16 * w + (lane & 15); const int tq = I.b * SEQ + (128 * I.nb + qi) * I.d + I.r;
    bf16_t* AP = (bf16_t*)(ws + OFF_AP); float* LSE = (float*)(ws + OFF_LSE);
    attn_wave<64, 5, true>(ctx_tid, ctx_bid, ctx_g, Kl, KS, Vl, VS, qf, w >> 1, 0.125f, qi, I.nb == 0, btl,
                           AP + ((size_t)I.pp * T + tq) * 768 + I.h * 64, LSE + ((size_t)I.pp * T + tq) * 12 + I.h);
}
DI void cross_item(const int ctx_tid, const int ctx_bid, const int ctx_g, const PView& p, int item, const bool restage, LAS unsigned char* lds) {
#ifdef NO_CROSS
    return;
#endif
    unsigned char* ws = p.ws; const bf16_t* KV = (const bf16_t*)(ws + OFF_KV); const bf16_t* Q = (const bf16_t*)(ws + OFF_Q); bf16_t* O = (bf16_t*)(ws + OFF_O);
    const int tid = ctx_tid, w = tid >> 6, lane = tid & 63;
    const int kv = item & 15, qb = item >> 4, b = kv >> 2, mh = kv & 3;
    constexpr int KS = 272, VS = 528;
    LAS unsigned char* Kl = lds; LAS unsigned char* Vl = lds + 256 * KS;
    const int tq = b * SEQ + qb * 128 + 16 * w + (lane & 15);
    bf16x8 qf[4];
#pragma unroll
    for (int ks = 0; ks < 4; ++ks) qf[ks] = *(const bf16x8*)(Q + (size_t)tq * 512 + mh * 128 + ks * 32 + (lane >> 4) * 8);
    if (restage) {
        { const int key = tid >> 1, hf = tid & 1; const bf16_t* kr = KV + (size_t)(b * 256 + key) * 1024 + mh * 128 + hf * 64;
          u32x4 kq[8];
#pragma unroll
          for (int i = 0; i < 8; ++i) kq[i] = *(const u32x4*)(kr + i * 8);
          const int kg = tid >> 4, dg = tid & 15; u32x4 vq[8];
#pragma unroll
          for (int k = 0; k < 8; ++k) vq[k] = *(const u32x4*)(KV + (size_t)(b * 256 + kg * 8 + k) * 1024 + 512 + mh * 128 + dg * 8);
#pragma unroll
          for (int i = 0; i < 8; ++i) *(LAS u32x4*)(Kl + key * KS + hf * 128 + i * 16) = kq[i];
#pragma unroll
          for (int c = 0; c < 4; ++c) {
              u32x4 lo, hi;
#pragma unroll
              for (int i = 0; i < 4; ++i) { lo[i] = __builtin_amdgcn_perm(vq[2 * i + 1][c], vq[2 * i][c], 0x05040100u); hi[i] = __builtin_amdgcn_perm(vq[2 * i + 1][c], vq[2 * i][c], 0x07060302u); }
              *(LAS u32x4*)(Vl + (dg * 8 + 2 * c) * VS + kg * 16) = lo; *(LAS u32x4*)(Vl + (dg * 8 + 2 * c + 1) * VS + kg * 16) = hi; } }
        __syncthreads();
    }
    attn_wave<128, 8, false>(ctx_tid, ctx_bid, ctx_g, Kl, KS, Vl, VS, qf, 0, 0.08838834764831845f, 0, false, nullptr, O + (size_t)tq * 512 + mh * 128, nullptr);
    __syncthreads();
}

DI void sgu_item(const int ctx_tid, const int ctx_bid, const int ctx_g, const PView& p, int l, int chunk, LAS unsigned char* lds) {
#ifdef NO_SGU
    return;
#endif
    unsigned char* ws = p.ws; const bf16_t* Z = (const bf16_t*)(ws + OFF_Z); bf16_t* MIX = (bf16_t*)(ws + OFF_MIX); const bf16_t* WS = (const bf16_t*)(ws + OFF_WS);
    const float* ng = p.in[8] + (size_t)l * 512; const float* sb = p.in[10] + (size_t)l * 1024; const float* og = p.in[11] + (size_t)l * 512;
    const int tid = ctx_tid, w = tid >> 6, lane = tid & 63, fr = lane & 15, fq = lane >> 4;
    constexpr int GS = 520;
    constexpr int GT = 136;
    LAS bf16_t* G = (LAS bf16_t*)lds;
    float gain8[8];
#pragma unroll
    for (int e = 0; e < 8; ++e) gain8[e] = ng[lane + 64 * e];
#pragma unroll 1
    for (int i0 = 0; i0 < 16; i0 += 4) {
        unsigned short raw[4][8];
#pragma unroll
        for (int ii = 0; ii < 4; ++ii) { const size_t tok = (size_t)chunk * 128 + 16 * w + i0 + ii;
#pragma unroll
            for (int e = 0; e < 8; ++e) raw[ii][e] = __builtin_nontemporal_load(Z + tok * NINP + 2816 + lane + 64 * e); }
#pragma unroll
        for (int ii = 0; ii < 4; ++ii) { const int j = 16 * w + i0 + ii;
            float f[8]; float s = 0.f;
#pragma unroll
            for (int e = 0; e < 8; ++e) { f[e] = gelu_t(bf2f(raw[ii][e])); s += f[e]; }
            const float mean = wsum(s) * (1.0f / 512.0f); float q = 0.f;
#pragma unroll
            for (int e = 0; e < 8; ++e) { f[e] -= mean; q += f[e] * f[e]; }
            const float rs = rsqrtf(wsum(q) * (1.0f / 512.0f) + 1e-6f);
#pragma unroll
            for (int e = 0; e < 8; ++e) G[(lane + 64 * e) * GT + j] = f2bf(f[e] * rs * gain8[e]); } }
    __syncthreads();
    bf16x8 bfr[4][4];
#pragma unroll
    for (int nt = 0; nt < 4; ++nt)
#pragma unroll
        for (int ks = 0; ks < 4; ++ks) bfr[nt][ks] = *(const LAS bf16x8*)(G + (w * 64 + nt * 16 + fr) * GT + ks * 32 + fq * 8);
    __syncthreads();
    unsigned short uc[4][4], un[4][4]; float bc4[4], bn4[4];
#pragma unroll
    for (int j = 0; j < 4; ++j) { const int i = fq * 4 + j; const size_t tok = (size_t)chunk * 128 + i; bc4[j] = sb[w * 128 + i];
#pragma unroll
        for (int nt = 0; nt < 4; ++nt) uc[j][nt] = __builtin_nontemporal_load(Z + tok * NINP + 2304 + w * 64 + nt * 16 + fr); }
#pragma unroll 1
    for (int it = 0; it < 8; ++it) {
        { const int itn = it < 7 ? it + 1 : 7;
#pragma unroll
          for (int j = 0; j < 4; ++j) { const int i = itn * 16 + fq * 4 + j; const size_t tok = (size_t)chunk * 128 + i; bn4[j] = sb[w * 128 + i];
#pragma unroll
            for (int nt = 0; nt < 4; ++nt) un[j][nt] = __builtin_nontemporal_load(Z + tok * NINP + 2304 + w * 64 + nt * 16 + fr); } }
        f32x4 acc[4];
#pragma unroll
        for (int nt = 0; nt < 4; ++nt) acc[nt] = (f32x4){0.f, 0.f, 0.f, 0.f};
#pragma unroll
        for (int ks = 0; ks < 4; ++ks) if (ks * 32 <= it * 16 + 15) {
            const bf16x8 a = *(const bf16x8*)(WS + (size_t)(w * 128 + it * 16 + fr) * 128 + ks * 32 + fq * 8);
#pragma unroll
            for (int nt = 0; nt < 4; ++nt) acc[nt] = __builtin_amdgcn_mfma_f32_16x16x32_bf16(a, bfr[nt][ks], acc[nt], 0, 0, 0); }
#pragma unroll
        for (int j = 0; j < 4; ++j) { const int i = it * 16 + fq * 4 + j;
#pragma unroll
            for (int nt = 0; nt < 4; ++nt) { const int c = w * 64 + nt * 16 + fr; const float u = gelu_t(bf2f(uc[j][nt]));
                G[i * GS + c] = f2bf(u * (acc[nt][j] + bc4[j])); } }
#pragma unroll
        for (int j = 0; j < 4; ++j) { bc4[j] = bn4[j];
#pragma unroll
            for (int nt = 0; nt < 4; ++nt) uc[j][nt] = un[j][nt]; }
    }
    __syncthreads();
    float og8[8];
#pragma unroll
    for (int e = 0; e < 8; ++e) og8[e] = og[lane * 8 + e];
    for (int i = 0; i < 16; ++i) { const int j = 16 * w + i; const size_t tok = (size_t)chunk * 128 + j;
        float f[8]; { const u32x4 lv = *(const LAS u32x4*)(G + j * GS + lane * 8); unpack8(make_uint4(lv.x, lv.y, lv.z, lv.w), f); } float q = 0.f;
#pragma unroll
        for (int e = 0; e < 8; ++e) q += f[e] * f[e];
        const float rs = rsqrtf(wsum(q) * (1.0f / 512.0f) + 1e-6f);
#pragma unroll
        for (int e = 0; e < 8; ++e) f[e] = f[e] * rs * og8[e];
        *(uint4*)(MIX + tok * DM + 768 + lane * 8) = pack8(f); }
    __syncthreads();
}

struct ScanRegs { u32x4 zr, zrp, zk, zkp, zv, zvp, aq, eq; };
constexpr int SSTEP = 392;
DI float rsum8(float x) { x += dppf<0xB1>(x); x += dppf<0x4E>(x); x += dppf<0x141>(x); return x; }
DI void scan_load(ScanRegs& R, const bf16_t* Z, const bf16_t* RWA, const bf16_t* RWD, int b, int h, int t, int l8) {
    const size_t tok = (size_t)b * SEQ + t; const bf16_t* zr = Z + tok * NINP + 3328 + h * 64 + l8 * 8;
    const bf16_t* zq = t > 0 ? zr - NINP : zr;
    R.zr = *(const u32x4*)(zr); R.zk = *(const u32x4*)(zr + 768); R.zv = *(const u32x4*)(zr + 1536);
    const unsigned msk = t > 0 ? 0xffffffffu : 0u;
    R.zrp = *(const u32x4*)(zq) & msk; R.zkp = *(const u32x4*)(zq + 768) & msk; R.zvp = *(const u32x4*)(zq + 1536) & msk;
    R.aq = *(const u32x4*)(RWA + tok * 768 + h * 64 + l8 * 8); R.eq = *(const u32x4*)(RWD + tok * 768 + h * 64 + l8 * 8);
}
DI void unpack8v(const u32x4 w, float (&f)[8]) { f[0] = bflo(w.x); f[1] = bfhi(w.x); f[2] = bflo(w.y); f[3] = bfhi(w.y); f[4] = bflo(w.z); f[5] = bfhi(w.z); f[6] = bflo(w.w); f[7] = bfhi(w.w); }
DI void lerp8(const u32x4 c, const u32x4 pv, const float* mu, float (&o)[8]) {
    float cc[8], pp[8]; unpack8v(c, cc); unpack8v(pv, pp);
#pragma unroll
    for (int e = 0; e < 8; ++e) o[e] = cc[e] + (pp[e] - cc[e]) * mu[e];
}
DI void phase_scan(const int ctx_tid, const int ctx_bid, const int ctx_g, const PView& p, int l, int sb, LAS unsigned char* lds) {
#ifdef NO_SCAN
    return;
#endif
    unsigned char* ws = p.ws; const bf16_t* Z = (const bf16_t*)(ws + OFF_Z); const bf16_t* RWA = (const bf16_t*)(ws + OFF_RWA); const bf16_t* RWD = (const bf16_t*)(ws + OFF_RWD);
    float* YR = (float*)(ws + OFF_YR); float* BON = (float*)(ws + OFF_BON);
    const int tid = ctx_tid, w = tid >> 6, lane = tid & 63, l8 = lane & 7;
    const int part = sb & 1, bh = sb >> 1, b = bh / 12, h = bh % 12;
    const int row0 = part * 32, nscan = 4;
    const bool scanner = w < nscan;
    const int half = part;
    const int ts = (tid & 255) >> 3;
    const int row = row0 + (w & 3) * 8 + (lane >> 3);
    LAS float* buf = (LAS float*)lds;
    if (w >= 4) {
        const float* mub = p.in[12] + (size_t)l * 2688 + h * 64 + l8 * 8;
        float mur[8], muk[8], muv[8], kk8[8], ka8[8], rk8[8];
#pragma unroll
        for (int e = 0; e < 8; ++e) { mur[e] = mub[e]; muk[e] = mub[768 + e]; muv[e] = mub[1536 + e];
            kk8[e] = p.in[18][(size_t)l * 768 + h * 64 + l8 * 8 + e]; ka8[e] = p.in[19][(size_t)l * 768 + h * 64 + l8 * 8 + e]; rk8[e] = p.in[20][(size_t)l * 768 + h * 64 + l8 * 8 + e]; }
        ScanRegs R;
        auto process = [&](int stage, int t) {
            float r8[8], k8[8], v8[8]; lerp8(R.zr, R.zrp, mur, r8); lerp8(R.zk, R.zkp, muk, k8); lerp8(R.zv, R.zvp, muv, v8);
            float a8[8], w8[8]; unpack8v(R.aq, a8); unpack8v(R.eq, w8);
#pragma unroll
            for (int e = 0; e < 8; ++e) w8[e] = __expf(-w8[e]);
            float kkv[8], n2 = 0.f;
#pragma unroll
            for (int e = 0; e < 8; ++e) { kkv[e] = k8[e] * kk8[e]; n2 += kkv[e] * kkv[e]; }
            n2 = rsum8(n2); const float inv = 1.0f / fmaxf(sqrtf(n2), 1e-12f);
            float kp[8], bb[8], nk[8], bon = 0.f;
#pragma unroll
            for (int e = 0; e < 8; ++e) { const float kh = kkv[e] * inv; nk[e] = -kh; bb[e] = kh * a8[e]; kp[e] = k8[e] * (1.0f + (a8[e] - 1.0f) * ka8[e]);
                bon += r8[e] * kp[e] * rk8[e]; }
            bon = rsum8(bon);
            LAS float* d = buf + (stage * 32 + ts) * SSTEP + l8 * 8;
#pragma unroll
            for (int q = 0; q < 2; ++q) {
                *(LAS f32x4*)(d + q * 4) = (f32x4){w8[q * 4], w8[q * 4 + 1], w8[q * 4 + 2], w8[q * 4 + 3]}; *(LAS f32x4*)(d + 64 + q * 4) = (f32x4){nk[q * 4], nk[q * 4 + 1], nk[q * 4 + 2], nk[q * 4 + 3]};
                *(LAS f32x4*)(d + 128 + q * 4) = (f32x4){bb[q * 4], bb[q * 4 + 1], bb[q * 4 + 2], bb[q * 4 + 3]}; *(LAS f32x4*)(d + 192 + q * 4) = (f32x4){kp[q * 4], kp[q * 4 + 1], kp[q * 4 + 2], kp[q * 4 + 3]};
                *(LAS f32x4*)(d + 256 + q * 4) = (f32x4){r8[q * 4], r8[q * 4 + 1], r8[q * 4 + 2], r8[q * 4 + 3]}; *(LAS f32x4*)(d + 320 + q * 4) = (f32x4){v8[q * 4], v8[q * 4 + 1], v8[q * 4 + 2], v8[q * 4 + 3]}; }
            if (l8 == 0 && half == 0) BON[((size_t)b * SEQ + t) * 12 + h] = bon;
        };
        scan_load(R, Z, RWA, RWD, b, h, ts, l8);
        process(0, ts);
        scan_load(R, Z, RWA, RWD, b, h, 32 + ts, l8);
        __syncthreads();
        for (int ci = 0; ci < SEQ / 32; ++ci) {
            if (ci + 1 < SEQ / 32) { process((ci + 1) & 1, (ci + 1) * 32 + ts); if (ci + 2 < SEQ / 32) scan_load(R, Z, RWA, RWD, b, h, (ci + 2) * 32 + ts, l8); }
            __syncthreads();
        }
    } else if (!scanner) {
        __syncthreads();
        for (int ci = 0; ci < SEQ / 32; ++ci) __syncthreads();
    } else {
        __builtin_amdgcn_s_setprio(3);
        f32x2 S[4];
#pragma unroll
        for (int i = 0; i < 4; ++i) S[i] = (f32x2){0.f, 0.f};
        __syncthreads();
        for (int ci = 0; ci < SEQ / 32; ++ci) {
            const int t0 = ci * 32;
            const LAS float* sbuf = buf + (ci & 1) * 32 * SSTEP;
            float yk[4];
            const LAS float* d0 = sbuf + l8 * 8;
            f32x4 W0 = *(const LAS f32x4*)(d0), W1 = *(const LAS f32x4*)(d0 + 4), N0 = *(const LAS f32x4*)(d0 + 64), N1 = *(const LAS f32x4*)(d0 + 68), B0 = *(const LAS f32x4*)(d0 + 128), B1 = *(const LAS f32x4*)(d0 + 132),
                  K0 = *(const LAS f32x4*)(d0 + 192), K1 = *(const LAS f32x4*)(d0 + 196), R0 = *(const LAS f32x4*)(d0 + 256), R1 = *(const LAS f32x4*)(d0 + 260);
            float vv = sbuf[320 + row];
            const bool b0 = (l8 & 1) != 0, b1 = (l8 & 2) != 0, b2 = (l8 & 4) != 0;
#pragma unroll
            for (int hh = 0; hh < 4; ++hh) {
                float pp[8];
#pragma unroll
                for (int s8 = 0; s8 < 8; ++s8) {
                    const int s = hh * 8 + s8; const int sn = s < 31 ? s + 1 : 31;
                    const LAS float* dn = sbuf + sn * SSTEP + l8 * 8;
                    const f32x4 nW0 = *(const LAS f32x4*)(dn), nW1 = *(const LAS f32x4*)(dn + 4), nN0 = *(const LAS f32x4*)(dn + 64), nN1 = *(const LAS f32x4*)(dn + 68), nB0 = *(const LAS f32x4*)(dn + 128), nB1 = *(const LAS f32x4*)(dn + 132),
                                nK0 = *(const LAS f32x4*)(dn + 192), nK1 = *(const LAS f32x4*)(dn + 196), nR0 = *(const LAS f32x4*)(dn + 256), nR1 = *(const LAS f32x4*)(dn + 260);
                    const float nvv = sbuf[sn * SSTEP + 320 + row];
                    const f32x2 d1v = (S[0] * (f32x2){N0.x, N0.y} + S[1] * (f32x2){N0.z, N0.w}) + (S[2] * (f32x2){N1.x, N1.y} + S[3] * (f32x2){N1.z, N1.w});
                    const float sa = rsum8(d1v.x + d1v.y);
                    const f32x2 sa2 = {sa, sa}, vv2 = {vv, vv};
                    S[0] = S[0] * (f32x2){W0.x, W0.y} + (sa2 * (f32x2){B0.x, B0.y} + vv2 * (f32x2){K0.x, K0.y});
                    S[1] = S[1] * (f32x2){W0.z, W0.w} + (sa2 * (f32x2){B0.z, B0.w} + vv2 * (f32x2){K0.z, K0.w});
                    S[2] = S[2] * (f32x2){W1.x, W1.y} + (sa2 * (f32x2){B1.x, B1.y} + vv2 * (f32x2){K1.x, K1.y});
                    S[3] = S[3] * (f32x2){W1.z, W1.w} + (sa2 * (f32x2){B1.z, B1.w} + vv2 * (f32x2){K1.z, K1.w});
                    const f32x2 yv = (S[0] * (f32x2){R0.x, R0.y} + S[1] * (f32x2){R0.z, R0.w}) + (S[2] * (f32x2){R1.x, R1.y} + S[3] * (f32x2){R1.z, R1.w});
                    pp[s8] = yv.x + yv.y;
                    W0 = nW0; W1 = nW1; N0 = nN0; N1 = nN1; B0 = nB0; B1 = nB1; K0 = nK0; K1 = nK1; R0 = nR0; R1 = nR1; vv = nvv;
                }
                float q4[4], r2[2];
#pragma unroll
                for (int i = 0; i < 4; ++i) q4[i] = (b0 ? pp[2 * i + 1] : pp[2 * i]) + dppf<0xB1>(b0 ? pp[2 * i] : pp[2 * i + 1]);
#pragma unroll
                for (int i = 0; i < 2; ++i) r2[i] = (b1 ? q4[2 * i + 1] : q4[2 * i]) + dppf<0x4E>(b1 ? q4[2 * i] : q4[2 * i + 1]);
                { const float keep = b2 ? r2[1] : r2[0], send = b2 ? r2[0] : r2[1];
                  int xr = __builtin_amdgcn_update_dpp(0, __float_as_int(send), 0x104, 0xF, 0x5, false);
                  xr = __builtin_amdgcn_update_dpp(xr, __float_as_int(send), 0x114, 0xF, 0xA, false);
                  yk[hh] = keep + __int_as_float(xr); }
            }
            { float* yo = YR + ((size_t)b * SEQ + t0 + l8) * 768 + h * 64 + row;
#pragma unroll
              for (int hh = 0; hh < 4; ++hh) yo[(size_t)hh * 8 * 768] = yk[hh]; }
            __syncthreads();
        }
        __builtin_amdgcn_s_setprio(0);
    }
}

template <int PART>
DI void phase_mixpost(const int ctx_tid, const int ctx_bid, const int ctx_g, const PView& p, int l, int gw, int nw, const bool xm = false) {
#ifdef NO_POST
    return;
#endif
    unsigned char* ws = p.ws; const bf16_t* Z = (const bf16_t*)(ws + OFF_Z); const bf16_t* AP = (const bf16_t*)(ws + OFF_AP); const float* LSE = (const float*)(ws + OFF_LSE);
    const bf16_t* RWG = (const bf16_t*)(ws + OFF_RWG); const float* YR = (const float*)(ws + OFF_YR); const float* BON = (const float*)(ws + OFF_BON); bf16_t* MIX = (bf16_t*)(ws + OFF_MIX);
    const float* aog = p.in[7] + (size_t)l * 768; const float* muv = p.in[12] + (size_t)l * 2688 + 1536; const float* lg = p.in[21] + (size_t)l * 768; const float* lb = p.in[22] + (size_t)l * 768;
    const int lane = ctx_tid & 63;
    const int hq = lane >> 4, dq = (lane & 15) * 4;
    f32x4 g_a[3], g_mu[3], g_lg[3], g_lb[3];
#pragma unroll
    for (int i = 0; i < 3; ++i) { const int c = (hq + 4 * i) * 64 + dq; g_a[i] = *(const f32x4*)(aog + c); g_mu[i] = *(const f32x4*)(muv + c); g_lg[i] = *(const f32x4*)(lg + c); g_lb[i] = *(const f32x4*)(lb + c); }
    for (int ti = 0; ; ++ti) { const int t = xm ? xcd_row(ctx_bid, __builtin_amdgcn_readfirstlane(ctx_tid >> 6), ctx_g, ti) : gw + ti * nw; if (t >= T) break;
        const bool hasp = (t % SEQ) != 0;
        if (PART == 1) {
            u32x2 ap[3][3]; float lse[3][3];
#pragma unroll
            for (int i = 0; i < 3; ++i) { const int j = hq + 4 * i, c = j * 64 + dq;
#pragma unroll
                for (int q = 0; q < 3; ++q) { lse[q][i] = LSE[((size_t)q * T + t) * 12 + j]; ap[q][i] = __builtin_nontemporal_load((const u32x2*)(AP + ((size_t)q * T + t) * 768 + c)); } }
            f32x4 oa[3]; float ss = 0.f;
#pragma unroll
            for (int i = 0; i < 3; ++i) {
                const float l0 = lse[0][i], l1 = lse[1][i], l2 = lse[2][i];
                const float mx = fmaxf(l0, fmaxf(l1, l2)); const float e0 = __expf(l0 - mx), e1 = __expf(l1 - mx), e2 = __expf(l2 - mx); const float inv = 1.0f / (e0 + e1 + e2);
                const f32x4 a0 = {bflo(ap[0][i].x), bfhi(ap[0][i].x), bflo(ap[0][i].y), bfhi(ap[0][i].y)}, a1 = {bflo(ap[1][i].x), bfhi(ap[1][i].x), bflo(ap[1][i].y), bfhi(ap[1][i].y)}, a2 = {bflo(ap[2][i].x), bfhi(ap[2][i].x), bflo(ap[2][i].y), bfhi(ap[2][i].y)};
                oa[i] = (a0 * e0 + a1 * e1 + a2 * e2) * inv; ss += oa[i][0] * oa[i][0] + oa[i][1] * oa[i][1] + oa[i][2] * oa[i][2] + oa[i][3] * oa[i][3]; }
            const float rs = rsqrtf(wsum(ss) * (1.0f / 768.0f) + 1e-6f);
#pragma unroll
            for (int i = 0; i < 3; ++i) { const int c = (hq + 4 * i) * 64 + dq; const f32x4 o1 = oa[i] * rs * g_a[i];
                u32x2 w1; w1.x = pack2(o1[0], o1[1]); w1.y = pack2(o1[2], o1[3]); *(u32x2*)(MIX + (size_t)t * DM + c) = w1; }
        } else {
            u32x2 rg[3], zc[3], zp[3]; float bon[3]; f32x4 yr[3];
#pragma unroll
            for (int i = 0; i < 3; ++i) { const int j = hq + 4 * i, c = j * 64 + dq;
                bon[i] = BON[(size_t)t * 12 + j]; yr[i] = __builtin_nontemporal_load((const f32x4*)(YR + (size_t)t * 768 + c)); rg[i] = __builtin_nontemporal_load((const u32x2*)(RWG + (size_t)t * 768 + c));
                zc[i] = __builtin_nontemporal_load((const u32x2*)(Z + (size_t)t * NINP + 4864 + c)); zp[i] = hasp ? __builtin_nontemporal_load((const u32x2*)(Z + (size_t)(t - 1) * NINP + 4864 + c)) : (u32x2){0u, 0u}; }
#pragma unroll
            for (int i = 0; i < 3; ++i) {
                const f32x4 y = yr[i]; const float mean = rsum16((y[0] + y[1]) + (y[2] + y[3])) * (1.0f / 64.0f); const f32x4 yc = y - mean;
                const float var = rsum16((yc[0] * yc[0] + yc[1] * yc[1]) + (yc[2] * yc[2] + yc[3] * yc[3])) * (1.0f / 64.0f);
                f32x4 yn = yc * rsqrtf(var + 64e-5f) * g_lg[i] + g_lb[i];
                const f32x4 vc = {bflo(zc[i].x), bfhi(zc[i].x), bflo(zc[i].y), bfhi(zc[i].y)}, vp = {bflo(zp[i].x), bfhi(zp[i].x), bflo(zp[i].y), bfhi(zp[i].y)};
                const f32x4 vs = vc + (vp - vc) * g_mu[i];
                yn += vs * bon[i];
                const f32x4 gg = {bflo(rg[i].x), bfhi(rg[i].x), bflo(rg[i].y), bfhi(rg[i].y)};
                const f32x4 o2 = yn * gg; const int c = (hq + 4 * i) * 64 + dq;
                u32x2 w2; w2.x = pack2(o2[0], o2[1]); w2.y = pack2(o2[2], o2[3]); *(u32x2*)(MIX + (size_t)t * DM + 1280 + c) = w2; }
        }
    }
}

DI void phase_convfix(const int ctx_tid, const int ctx_bid, const int ctx_g, const PView& p, int l) {
#ifdef NO_CONV
    return;
#endif
    unsigned char* ws = p.ws; bf16_t* ACT = (bf16_t*)(ws + OFF_ACT); const float* HALO = (const float*)(ws + OFF_HALO); const float* PART = (const float*)(ws + OFF_PART);
    const float* cw = p.in[27] + (size_t)l * 3 * NUP;
    const int gt = ctx_bid * 512 + ctx_tid, ng = ctx_g * 512;
    for (int it = gt; it < (T / 128) * 2 * (DFF / 4); it += ng) {
        const int c = (it % (DFF / 4)) * 4, gr = it / (DFF / 4), r = gr & 1, g = gr >> 1;
        const int colp = (c >> 7) * 256 + (c & 127);
        f32x4 pg = *(const f32x4*)(PART + ((size_t)g * 2 + r) * NUP + colp), pv = *(const f32x4*)(PART + ((size_t)g * 2 + r) * NUP + colp + 128);
        if ((g * 128) % SEQ != 0) {
            const f32x4 g1 = *(const f32x4*)(HALO + ((size_t)(g - 1) * 2 + 1) * NUP + colp), v1 = *(const f32x4*)(HALO + ((size_t)(g - 1) * 2 + 1) * NUP + colp + 128);
            const f32x4 g2 = *(const f32x4*)(HALO + ((size_t)(g - 1) * 2) * NUP + colp), v2 = *(const f32x4*)(HALO + ((size_t)(g - 1) * 2) * NUP + colp + 128);
            const f32x4 wg0 = *(const f32x4*)(cw + c), wg1 = *(const f32x4*)(cw + NUP + c), wv0 = *(const f32x4*)(cw + DFF + c), wv1 = *(const f32x4*)(cw + NUP + DFF + c);
            if (r == 0) { pg += wg1 * g1 + wg0 * g2; pv += wv1 * v1 + wv0 * v2; } else { pg += wg0 * g1; pv += wv0 * v1; }
        }
        uint2 w; w.x = pack2(gelu_t(pg[0]) * pv[0], gelu_t(pg[1]) * pv[1]); w.y = pack2(gelu_t(pg[2]) * pv[2], gelu_t(pg[3]) * pv[3]);
        *(uint2*)(ACT + (size_t)(g * 128 + r) * DFF + c) = w;
    }
}

DI void run_gemm_bf16(const int ctx_tid, const int ctx_bid, const int ctx_g, LAS unsigned char* lds, const bf16_t* A, const bf16_t* Bt, int M, int N, int K, bf16_t* O, int ldc, int G, int c) {
#ifdef NO_GEMM
    return;
#endif
    pg8::Gemm g{A, Bt, M, N, K}; pg8::StaticOrder S; S.init(M, N, G, c); pg8::EpiBf16 E{O, ldc};
    pg8::gemm_phase<pg8::EpiBf16, pg8::StaticOrder, false>(ctx_tid, lds, g, S, E, nullptr);
}
DI void run_gemm_f32(const int ctx_tid, const int ctx_bid, const int ctx_g, LAS unsigned char* lds, const bf16_t* A, const bf16_t* Bt, int M, int N, int K, float* C, int ldc, int G, int c) {
#ifdef NO_GEMM
    return;
#endif
    pg8::Gemm g{A, Bt, M, N, K}; pg8::StaticOrder S; S.init(M, N, G, c); pg8::EpiF32 E{C, ldc, nullptr};
    pg8::gemm_phase<pg8::EpiF32, pg8::StaticOrder, false>(ctx_tid, lds, g, S, E, nullptr);
}

DI void run_gemm_conv(const int ctx_tid, const int ctx_bid, const int ctx_g, LAS unsigned char* lds, const bf16_t* A, const bf16_t* Bt, int M, int N, int K, bf16_t* ACT, const float* cw, const float* cb, float* HALO, float* PARTB, int G, int c) {
#ifdef NO_GEMM
    return;
#endif
    pg8::Gemm g{A, Bt, M, N, K}; pg8::StaticOrder S; S.init(M, N, G, c); pg8::EpiConv E{ACT, cw, cb, HALO, PARTB, DFF, NUP};
    pg8::gemm_phase<pg8::EpiConv, pg8::StaticOrder, false>(ctx_tid, lds, g, S, E, nullptr);
}
#define XB_TMO      128
#define XB_XCNT(j)  (256  + 64 * (j))
#define XB_XSUB(j)  (1280 + 64 * (j))
#define XB_XGEN(j)  (2304 + 64 * (j))
#define XB_TOP      3328
#define XB_TOPGEN   3392
#define XCD_BAR_WORDS 3456
#define XB_SPIN_CAP (1u << 18)

__device__ __forceinline__ unsigned xb_ld(unsigned* p)              { return __hip_atomic_load(p, __ATOMIC_RELAXED, __HIP_MEMORY_SCOPE_AGENT); }
__device__ __forceinline__ unsigned xb_add(unsigned* p, unsigned v) { return __hip_atomic_fetch_add(p, v, __ATOMIC_RELAXED, __HIP_MEMORY_SCOPE_AGENT); }
__device__ __forceinline__ unsigned xb_xcc_id() { return (unsigned)__builtin_amdgcn_s_getreg((3 << 11) | 20) & 0xFu; }
#define XB_SPIN(cond, bar) do { unsigned _sp = 0; while (cond) { __builtin_amdgcn_s_sleep(1); \
    if ((++_sp & 255u) == 0u) { if (xb_ld(&(bar)[XB_TMO])) break; if (_sp > XB_SPIN_CAP) { atomicAdd(&(bar)[XB_TMO], 1u); break; } } } } while (0)
struct XcdBarrier {
    unsigned* bar; unsigned x;
    volatile LAS unsigned* st;
};

__device__ __forceinline__ XcdBarrier xcd_barrier_post(unsigned* bar, volatile LAS unsigned* st, const bool tid0) {
    XcdBarrier b; b.bar = bar; b.x = xb_xcc_id(); b.st = st;
    if (tid0) (void)xb_add(&bar[XB_XCNT(b.x)], 1u);
    return b;
}
__device__ __forceinline__ void xcd_barrier_complete(unsigned* bar, unsigned x, unsigned& nloc, unsigned& nx) {
    const unsigned G = gridDim.x * gridDim.y * gridDim.z;
    unsigned sum, cnt, mine, sp = 0u;
    for (;;) {
        sum = 0u; cnt = 0u; mine = 0u;
#pragma unroll
        for (unsigned j = 0; j < 16; ++j) { const unsigned c = xb_ld(&bar[XB_XCNT(j)]); sum += c; cnt += (c > 0u) ? 1u : 0u; mine = (j == x) ? c : mine; }
        if (sum == G) break;
        __builtin_amdgcn_s_sleep(1);
        if ((++sp & 255u) == 0u) { if (xb_ld(&bar[XB_TMO])) break; if (sp > XB_SPIN_CAP) { atomicAdd(&bar[XB_TMO], 1u); break; } }
    }
    nloc = mine > 0u ? mine : 1u; nx = cnt > 0u ? cnt : 1u;
}

__device__ __forceinline__ void xcd_barrier(const XcdBarrier& b, const bool tid0) {
    asm volatile("s_waitcnt vmcnt(0)" ::: "memory");
    __syncthreads();
    if (tid0) {
        unsigned* bar = b.bar;
        __builtin_amdgcn_s_waitcnt(0);
        unsigned nloc = b.st[0], nx = b.st[1];
        if (nloc == 0u) { xcd_barrier_complete(bar, b.x, nloc, nx); b.st[0] = nloc; b.st[1] = nx; }
        const unsigned old = xb_add(&bar[XB_XSUB(b.x)], 1u);
        const unsigned gen = old / nloc;
        if (old + 1u == (gen + 1u) * nloc) {
            __builtin_amdgcn_fence(__ATOMIC_RELEASE, "agent");
            asm volatile("s_waitcnt vmcnt(0)" ::: "memory");
            const unsigned og = xb_add(&bar[XB_TOP], 1u);
            const unsigned tg = og / nx;
            if (og + 1u == (tg + 1u) * nx) xb_add(&bar[XB_TOPGEN], 1u);
            else XB_SPIN(xb_ld(&bar[XB_TOPGEN]) == tg, bar);
            __builtin_amdgcn_fence(__ATOMIC_ACQUIRE, "agent");
            xb_add(&bar[XB_XGEN(b.x)], 1u);
            asm volatile("s_waitcnt vmcnt(0)" ::: "memory");
        } else {
            XB_SPIN(xb_ld(&bar[XB_XGEN(b.x)]) == gen, bar);
            __builtin_amdgcn_fence(__ATOMIC_ACQUIRE, "agent");
            asm volatile("s_waitcnt vmcnt(0)" ::: "memory");
        }
    }
    __syncthreads();
}

DI void sub_barrier(unsigned* cnt, unsigned target, const bool tid0) {
    asm volatile("s_waitcnt vmcnt(0)" ::: "memory");
    __syncthreads();
    if (tid0) {
        __builtin_amdgcn_fence(__ATOMIC_RELEASE, "agent"); asm volatile("s_waitcnt vmcnt(0)" ::: "memory");
        (void)__hip_atomic_fetch_add(cnt, 1u, __ATOMIC_RELAXED, __HIP_MEMORY_SCOPE_AGENT);
        unsigned sp = 0;
        while (__hip_atomic_load(cnt, __ATOMIC_RELAXED, __HIP_MEMORY_SCOPE_AGENT) < target) { __builtin_amdgcn_s_sleep(2); if (++sp > (1u << 22)) break; }
        __builtin_amdgcn_fence(__ATOMIC_ACQUIRE, "agent"); asm volatile("s_waitcnt vmcnt(0)" ::: "memory");
    }
    __syncthreads();
}
__global__ __launch_bounds__(512, 2) void mega(Params pin, int ph_lo, int ph_hi) {
    extern __shared__ __attribute__((aligned(16))) unsigned char shm[];
    LAS unsigned char* lds = (LAS unsigned char*)shm;
    const int gridDim_x0 = (int)gridDim.x;
    const int wave_sgpr = __builtin_amdgcn_readfirstlane((int)(threadIdx.x >> 6));
    volatile LAS unsigned* xb_st = (volatile LAS unsigned*)(lds + LDS_BYTES - 16);
    if (threadIdx.x == 0) { xb_st[0] = 0u; xb_st[1] = 0u; xb_st[2] = 0u; xb_st[3] = 0u; }
    __syncthreads();
    XcdBarrier xb; xb.bar = (unsigned*)(pin.ws + OFF_CTL); xb.x = 0; xb.st = xb_st;
    if (ph_hi - ph_lo > 1) xb = xcd_barrier_post((unsigned*)(pin.ws + OFF_CTL), xb_st, threadIdx.x == 0);
    if (ph_lo < 0) cg::this_grid().sync();
    for (int ph = ph_lo; ph < ph_hi; ++ph) {
        if (ph == NPL && ph > ph_lo) continue;
        if (ph > ph_lo) {
            xcd_barrier(xb, wave_sgpr == 0 && (int)__builtin_amdgcn_mbcnt_hi(~0u, __builtin_amdgcn_mbcnt_lo(~0u, 0u)) == 0);
#ifdef EXTRA_SYNCS
            for (int es = 0; es < EXTRA_SYNCS; ++es) xcd_barrier(xb, wave_sgpr == 0 && (int)__builtin_amdgcn_mbcnt_hi(~0u, __builtin_amdgcn_mbcnt_lo(~0u, 0u)) == 0);
#endif
        }
        const int l = ph / NPL, lp = ph % NPL;
        const int nrep = ((REP_MASK >> lp) & 1) ? 2 : 1;
        for (int rep = 0; rep < nrep; ++rep) {
        if (rep) xcd_barrier(xb, wave_sgpr == 0 && (int)__builtin_amdgcn_mbcnt_hi(~0u, __builtin_amdgcn_mbcnt_lo(~0u, 0u)) == 0);
        size_t zero = 0; asm volatile("" : "+s"(zero));
        int wv_ = wave_sgpr; asm volatile("" : "+s"(wv_));
        int ctx_tid = wv_ * 64 + (int)__builtin_amdgcn_mbcnt_hi(~0u, __builtin_amdgcn_mbcnt_lo(~0u, 0u)); asm volatile("" : "+v"(ctx_tid));
        int ctx_bid = blockIdx.x; asm volatile("" : "+s"(ctx_bid));
        int ctx_g = (int)gridDim_x0; asm volatile("" : "+s"(ctx_g));
        const int bid = ctx_bid, G = ctx_g;
        PView p; p.in.pp = &pin; p.in.zero = zero; p.out = pin.out + zero; p.ws = pin.ws + zero;
        unsigned char* ws = p.ws; bf16_t* HB = (bf16_t*)(ws + OFF_HB);
        const float* gains = p.in[3] + (size_t)l * 6 * DM;
        int gk = 0; const bf16_t* gA = nullptr; const bf16_t* gB = nullptr; int gM = 0, gN = 0, gK = 0, gld = 0, gG = G, gc = bid; void* gO = nullptr;
        switch (lp) {
        case 0: phase_cvt(ctx_tid, ctx_bid, ctx_g, p, l, lds); break;
        case 1: gk = 1; gA = HB; gB = (const bf16_t*)(ws + OFF_WIN) + (size_t)3072 * DM; gM = T; gN = NINP - 3072; gK = DM; gO = (bf16_t*)(ws + OFF_Z) + 3072; gld = NINP; break;
        case 2: phase_rwkv_prep(ctx_tid, ctx_bid, ctx_g, p, l, lds); break;
        case 3:
            if (bid < SCAN_BLOCKS) { if (!(rep && P3_MODE == 2)) phase_scan(ctx_tid, ctx_bid, ctx_g, p, l, bid, lds); }
            else if (!(rep && P3_MODE == 1)) { gk = 1; gA = HB; gB = (const bf16_t*)(ws + OFF_WIN); gM = T; gN = 3072; gK = DM; gO = ws + OFF_Z; gld = NINP; gG = G - SCAN_BLOCKS; gc = bid - SCAN_BLOCKS; }
            break;
        case 4: phase_mixpost<2>(ctx_tid, ctx_bid, ctx_g, p, l, ctx_bid * 8 + __builtin_amdgcn_readfirstlane(ctx_tid >> 6), ctx_g * 8, true); break;
        case 5: gk = 1; gA = (const bf16_t*)(ws + OFF_MIX); gB = (const bf16_t*)(ws + OFF_WOUT); gM = T; gN = DM; gK = DM; gO = ws + OFF_Y; gld = DM; break;
        case 6: if (l == 0) phase_resid<true, false>(ctx_tid, ctx_bid, ctx_g, (const bf16_t*)(ws + OFF_Y), p.in[0], ws + OFF_XB, gains + DM, gains + 2 * DM, HB);
                else phase_resid<false, false>(ctx_tid, ctx_bid, ctx_g, (const bf16_t*)(ws + OFF_Y), ws + OFF_XB, ws + OFF_XB, gains + DM, gains + 2 * DM, HB);
                break;
        case 7: { const int nh = G / 2;
            if (bid < nh) { gk = 1; gA = HB; gB = (const bf16_t*)(ws + OFF_WQ); gM = T; gN = 512; gK = DM; gO = ws + OFF_Q; gld = 512; gG = nh; gc = bid; }
            else { gk = 1; gA = (const bf16_t*)(ws + OFF_MEMN); gB = (const bf16_t*)(ws + OFF_WKV); gM = 1024; gN = 1024; gK = DM; gO = ws + OFF_KV; gld = 1024; gG = G - nh; gc = bid - nh; } } break;
        case 8: { int last_kv = -1; for (int it = bid; it < 512; it += G) { cross_item(ctx_tid, ctx_bid, ctx_g, p, it, (it & 15) != last_kv, lds); last_kv = it & 15; } } break;
        case 9: gk = 1; gA = (const bf16_t*)(ws + OFF_O); gB = (const bf16_t*)(ws + OFF_WO); gM = T; gN = DM; gK = 512; gO = ws + OFF_Y; gld = DM; break;
        case 10: phase_resid<false, false>(ctx_tid, ctx_bid, ctx_g, (const bf16_t*)(ws + OFF_Y), ws + OFF_XB, ws + OFF_XB, gains + 3 * DM, gains + 4 * DM, HB); break;
        case 11: gk = 3; gA = HB; gB = (const bf16_t*)(ws + OFF_WUP); gM = T; gN = NUP; gK = DM; gO = ws + OFF_ACT; break;
        case 12: phase_convfix(ctx_tid, ctx_bid, ctx_g, p, l); break;
        case 13: gk = 1; gA = (const bf16_t*)(ws + OFF_ACT); gB = (const bf16_t*)(ws + OFF_WDN); gM = T; gN = DM; gK = DFF; gO = ws + OFF_Y; gld = DM; break;
        case 14: if (l + 1 < 2) phase_resid<false, false>(ctx_tid, ctx_bid, ctx_g, (const bf16_t*)(ws + OFF_Y), ws + OFF_XB, ws + OFF_XB, gains + 5 * DM, gains + 6 * DM, HB);
                 else phase_resid<false, true>(ctx_tid, ctx_bid, ctx_g, (const bf16_t*)(ws + OFF_Y), ws + OFF_XB, p.out, gains + 5 * DM, nullptr, HB);
                 if (l == 0 && ph_hi - ph_lo > 1) phase_cvt(ctx_tid, ctx_bid, ctx_g, p, 1, lds);
                 break;
        }
        if (gk == 1) run_gemm_bf16(ctx_tid, ctx_bid, ctx_g, lds, gA, gB, gM, gN, gK, (bf16_t*)gO, gld, gG, gc);
        else if (gk == 3) run_gemm_conv(ctx_tid, ctx_bid, ctx_g, lds, gA, gB, gM, gN, gK, (bf16_t*)gO, p.in[27] + (size_t)l * 3 * NUP, p.in[28] + (size_t)l * NUP, (float*)(ws + OFF_HALO), (float*)(ws + OFF_PART), gG, gc);
        if (lp == 3 && bid >= SCAN_BLOCKS && !(rep && P3_MODE == 1)) {
            const int nb = G - SCAN_BLOCKS; int it = bid - SCAN_BLOCKS;
            sub_barrier((unsigned*)(ws + OFF_CTL) + 3584 + 64 * (l * 2 + rep), (unsigned)nb, ctx_tid == 0);
#ifndef NO_SGU
            for (; it < 128; it += nb) sgu_item(ctx_tid, ctx_bid, ctx_g, p, l, it, lds);
#endif
#ifndef NO_DIL
            u32x4 kq[4]; u32x2 vq[8]; bf16x8 qc[2], qn[2]; float btv; int item = it - 128;
            dil_load(ctx_tid, p, item < 4608 ? item : 4607, kq, vq, qc, btv);
            for (; item < 4608; item += nb) {
                dil_stage(ctx_tid, p, item, kq, vq, btv, lds); __syncthreads();
                dil_load(ctx_tid, p, item + nb < 4608 ? item + nb : 4607, kq, vq, qn, btv);
                dil_compute(ctx_tid, ctx_bid, ctx_g, p, item, qc, lds); __syncthreads();
                qc[0] = qn[0]; qc[1] = qn[1]; }
#endif
            sub_barrier((unsigned*)(ws + OFF_CTL) + 3840 + 64 * (l * 2 + rep), (unsigned)nb, ctx_tid == 0);
            phase_mixpost<1>(ctx_tid, ctx_bid, ctx_g, p, l, (bid - SCAN_BLOCKS) * 8 + __builtin_amdgcn_readfirstlane(ctx_tid >> 6), nb * 8);
        }
        }
    }
}

#ifndef MK_SINGLE
#define MK_SINGLE 1
#endif
extern "C" void kernel_launch(void* const* d_in, const int* in_sizes, int n_in, void* d_out, int out_size, void* d_ws, size_t ws_size, hipStream_t stream) {
    (void)in_sizes; (void)out_size;
    if (n_in < 30 || ws_size < WS_NEED) { fprintf(stderr, "kernel_launch: bad arguments (n_in %d, ws %zu < %zu)\n", n_in, ws_size, (size_t)WS_NEED); return; }
    Params p{};
    for (int i = 0; i < 30; ++i) p.in[i] = (const float*)d_in[i];
    p.out = (float*)d_out; p.ws = (unsigned char*)d_ws;
    hipFuncSetAttribute((const void*)mega, hipFuncAttributeMaxDynamicSharedMemorySize, LDS_BYTES);
    int dev = 0, cus = 0, per_cu = 0;
    hipGetDevice(&dev); hipDeviceGetAttribute(&cus, hipDeviceAttributeMultiprocessorCount, dev);
    hipOccupancyMaxActiveBlocksPerMultiprocessor(&per_cu, mega, 512, LDS_BYTES);
    if (per_cu < 1) per_cu = 1;
    int grid = cus * per_cu; if (grid > 256) grid = 256; if (grid < 128) grid = 128;
    if (hipMemsetAsync((unsigned char*)d_ws + OFF_CTL, 0, CTL_BYTES, stream) != hipSuccess) { fprintf(stderr, "kernel_launch: memset of the barrier words failed\n"); return; }
#if MK_SINGLE
    int lo = 0, hi = 2 * NPL; void* args[] = {&p, &lo, &hi};
    hipError_t e = hipLaunchCooperativeKernel((void*)mega, dim3(grid), dim3(512), args, LDS_BYTES, stream);
    if (e != hipSuccess) fprintf(stderr, "cooperative launch failed: %s (grid %d)\n", hipGetErrorString(e), grid);
#else
    for (int ph = 0; ph < 2 * NPL; ++ph) hipLaunchKernelGGL(mega, dim3(grid), dim3(512), LDS_BYTES, stream, p, ph, ph + 1);
#endif
}
```

```cpp
#include <hip/hip_runtime.h>
#include <hip/hip_cooperative_groups.h>
#include <cstdio>
#include <cstdint>
namespace cg = cooperative_groups;
namespace pg8 {
#define PG8_LAS __attribute__((address_space(3)))
typedef unsigned short bf16_t;
typedef short bf16x8 __attribute__((ext_vector_type(8)));
typedef float f32x4 __attribute__((ext_vector_type(4)));
typedef unsigned u32x4 __attribute__((ext_vector_type(4)));
constexpr int BM = 256, BK = 64, HALF = 128, HTB = HALF * BK * 2  , STAGE_BYTES = 8 * HTB, NXCD = 8, WGM = 4;

__host__ __device__ __forceinline__ int lds_byte(int r, int c) { const int st = (r >> 4) * 2 + (c >> 5), rr = r & 15, cc = c & 31, ob = rr * 64 + cc * 2; return st * 1024 + (ob ^ (((ob >> 9) & 1) << 5)); }
__host__ __device__ __forceinline__ void stage_rc(int b, int& R, int& C) { const int st = b / 1024, sb = b % 1024, swz = sb ^ (((sb >> 9) & 1) << 5); R = (st >> 1) * 16 + swz / 64; C = (st & 1) * 32 + (swz % 64) / 2; }
__host__ __device__ __forceinline__ int perm32(int rho) { const int n = rho >> 4, i = rho & 15; return 8 * (i >> 2) + 4 * n + (i & 3); }

struct Unit { int pm, pn; };
struct Gemm { const bf16_t* A; const bf16_t* Bt; int M, N, K; };

struct StaticOrder {
    int nM, nN, nwg, G, c;
    __host__ __device__ void init(int M, int N, int G_, int c_) { nM = M / BM; nN = N / BM; nwg = nM * nN; G = G_; c = c_; }
    __host__ __device__ bool next(int i, Unit& u) const {
        const long L = (long)i * G + c; if (L >= nwg) return false;
        int wgid = (int)L; { const int q = nwg / NXCD, r = nwg % NXCD, xcd = wgid % NXCD, off = wgid / NXCD; wgid = (xcd < r ? xcd * (q + 1) : r * (q + 1) + (xcd - r) * q) + off; }
        const int nig = WGM * nN, gid = wgid / nig, fm = gid * WGM, gsz = (nM - fm) < WGM ? (nM - fm) : WGM;
        u.pm = fm + ((wgid % nig) % gsz); u.pn = (wgid % nig) / gsz; return true;
    }
    __device__ __forceinline__ void a_ready(const Unit&) const {}
    __device__ __forceinline__ void done(const Unit&) const {}
};
__device__ __forceinline__ unsigned cvt_pk_bf16(float lo, float hi) { unsigned r; asm volatile("v_cvt_pk_bf16_f32 %0, %1, %2" : "=v"(r) : "v"(lo), "v"(hi)); return r; }
struct EpiF32 {
    static constexpr bool PERM = false, AFTER_DRAIN = false, TOKPERM = false;
    float* C; int ldc; const float* bias;
    __device__ __forceinline__ void operator()(const f32x4 (&acc)[2][2][4][2], const Unit& u, int wr, int wc, int fr, int fq) const {
        const int row0 = u.pm * BM + wr * 64 + fr, col0 = u.pn * BM + wc * 32 + 4 * fq;
        f32x4 bv[2][2];
#pragma unroll
        for (int bj = 0; bj < 2; ++bj)
#pragma unroll
            for (int n = 0; n < 2; ++n) bv[bj][n] = bias ? *(const f32x4*)(bias + col0 + bj * HALF + n * 16) : (f32x4){0.f, 0.f, 0.f, 0.f};
#pragma unroll
        for (int ai = 0; ai < 2; ++ai)
#pragma unroll
            for (int m = 0; m < 4; ++m) { float* rowp = C + (size_t)(row0 + ai * HALF + m * 16) * ldc + col0;
#pragma unroll
                for (int bj = 0; bj < 2; ++bj)
#pragma unroll
                    for (int n = 0; n < 2; ++n) *(f32x4*)(rowp + bj * HALF + n * 16) = acc[ai][bj][m][n] + bv[bj][n]; }
    }
};
struct EpiBf16 {
    static constexpr bool PERM = true, AFTER_DRAIN = false, TOKPERM = false;
    bf16_t* O; int ldc;
    __device__ __forceinline__ void operator()(const f32x4 (&acc)[2][2][4][2], const Unit& u, int wr, int wc, int fr, int fq) const {
        const int row0 = u.pm * BM + wr * 64 + fr; const int col0 = u.pn * BM + wc * 32 + 8 * fq;
#pragma unroll
        for (int ai = 0; ai < 2; ++ai)
#pragma unroll
            for (int m = 0; m < 4; ++m) { bf16_t* rowp = O + (size_t)(row0 + ai * HALF + m * 16) * ldc + col0;
#pragma unroll
                for (int bj = 0; bj < 2; ++bj) { const f32x4 v0 = acc[ai][bj][m][0], v1 = acc[ai][bj][m][1];
                    u32x4 w; w.x = cvt_pk_bf16(v0[0], v0[1]); w.y = cvt_pk_bf16(v0[2], v0[3]); w.z = cvt_pk_bf16(v1[0], v1[1]); w.w = cvt_pk_bf16(v1[2], v1[3]);
                    *(u32x4*)(rowp + bj * HALF) = w; } }
    }
};

typedef unsigned u32x2 __attribute__((ext_vector_type(2)));
template <int CTRL> __device__ __forceinline__ float epi_dpp(float x) { return __int_as_float(__builtin_amdgcn_update_dpp(0, __float_as_int(x), CTRL, 0xF, 0xF, true)); }
__device__ __forceinline__ float epi_gelu_t(float x) { const float u = 0.7978845608028654f * (x + 0.044715f * x * x * x); return x * __builtin_amdgcn_rcpf(1.0f + __expf(-2.0f * u)); }
struct EpiConv {
    static constexpr bool PERM = true, AFTER_DRAIN = false, TOKPERM = true;
    bf16_t* ACT; const float* cw; const float* cb; float* HALO; float* PARTB; int dff, nup;
    __device__ __forceinline__ void operator()(const f32x4 (&acc)[2][2][4][2], const Unit& u, int wr, int wc, int fr, int fq) const {
        const int tok0 = u.pm * BM + (wr * 16 + fr) * 8;
        const int grp = u.pm * 2 + wr;
        const int cl = wc * 32 + fq * 8;
#pragma unroll
        for (int n = 0; n < 2; ++n) {
            const int ch = u.pn * 128 + cl + 4 * n;
            const int colp = u.pn * 256 + cl + 4 * n;
            const f32x4 bg = *(const f32x4*)(cb + ch), bv = *(const f32x4*)(cb + dff + ch);
            f32x4 wg[3], wv[3];
#pragma unroll
            for (int j = 0; j < 3; ++j) { wg[j] = *(const f32x4*)(cw + (size_t)j * nup + ch); wv[j] = *(const f32x4*)(cw + (size_t)j * nup + dff + ch); }
            f32x4 hg6, hg7, hv6, hv7;
#pragma unroll
            for (int e = 0; e < 4; ++e) { hg6[e] = epi_dpp<0x111>(acc[1][0][2][n][e]); hg7[e] = epi_dpp<0x111>(acc[1][0][3][n][e]); hv6[e] = epi_dpp<0x111>(acc[1][1][2][n][e]); hv7[e] = epi_dpp<0x111>(acc[1][1][3][n][e]); }
            if (fr == 15) {
                float* h = HALO + ((size_t)grp * 2) * nup + colp;
                *(f32x4*)(h) = acc[1][0][2][n]; *(f32x4*)(h + 128) = acc[1][1][2][n]; *(f32x4*)(h + nup) = acc[1][0][3][n]; *(f32x4*)(h + nup + 128) = acc[1][1][3][n]; }
            if (fr == 0) {
                float* q = PARTB + ((size_t)grp * 2) * nup + colp;
                *(f32x4*)(q) = bg + wg[2] * acc[0][0][0][n]; *(f32x4*)(q + 128) = bv + wv[2] * acc[0][1][0][n];
                *(f32x4*)(q + nup) = bg + wg[2] * acc[0][0][1][n] + wg[1] * acc[0][0][0][n]; *(f32x4*)(q + nup + 128) = bv + wv[2] * acc[0][1][1][n] + wv[1] * acc[0][1][0][n]; }
#pragma unroll
            for (int j = 0; j < 8; ++j) {
                const f32x4 g0 = acc[j >> 2][0][j & 3][n], v0 = acc[j >> 2][1][j & 3][n];
                const f32x4 g1 = j >= 1 ? acc[(j - 1 < 0 ? 0 : j - 1) >> 2][0][(j - 1 < 0 ? 0 : j - 1) & 3][n] : hg7, v1 = j >= 1 ? acc[(j - 1 < 0 ? 0 : j - 1) >> 2][1][(j - 1 < 0 ? 0 : j - 1) & 3][n] : hv7;
                const f32x4 g2 = j >= 2 ? acc[(j - 2 < 0 ? 0 : j - 2) >> 2][0][(j - 2 < 0 ? 0 : j - 2) & 3][n] : (j == 1 ? hg7 : hg6), v2 = j >= 2 ? acc[(j - 2 < 0 ? 0 : j - 2) >> 2][1][(j - 2 < 0 ? 0 : j - 2) & 3][n] : (j == 1 ? hv7 : hv6);
                const f32x4 gc = bg + wg[0] * g2 + wg[1] * g1 + wg[2] * g0, vc = bv + wv[0] * v2 + wv[1] * v1 + wv[2] * v0;
                if (j >= 2 || fr != 0) { u32x2 w; w.x = cvt_pk_bf16(epi_gelu_t(gc[0]) * vc[0], epi_gelu_t(gc[1]) * vc[1]); w.y = cvt_pk_bf16(epi_gelu_t(gc[2]) * vc[2], epi_gelu_t(gc[3]) * vc[3]);
                    *(u32x2*)(ACT + (size_t)(tok0 + j) * dff + ch) = w; }
            }
        }
    }
};
template <class Epi, class Sched, bool STAMP = false>
__device__ __forceinline__ void gemm_phase(const int tid_in, PG8_LAS unsigned char* lds, const Gemm g, const Sched& S, const Epi& E, unsigned long long* stamps) {
    const int tid = tid_in, wid = __builtin_amdgcn_readfirstlane(tid >> 6), lane = tid & 63, wr = wid >> 2, wc = wid & 3, fr = lane & 15, fq = lane >> 4;
    const int K = g.K, nt = K / BK;
    int ts_lo = 0, ts_hi = 0, nts = 0; const unsigned long long rt_entry = STAMP ? (unsigned long long)wall_clock64() : 0ull;
#define PG8_STAMP() do { if (STAMP && wid == 0 && nts < 64) { const unsigned long long _c = (unsigned long long)clock64(); \
        ts_lo = (lane == nts) ? (int)(unsigned)_c : ts_lo; ts_hi = (lane == nts) ? (int)(unsigned)(_c >> 32) : ts_hi; ++nts; } } while (0)
    PG8_STAMP();
    unsigned voffA[2], voffB[2];
#pragma unroll
    for (int i = 0; i < 2; ++i) { int R, C; stage_rc(tid * 16 + i * 8192, R, C); const int Rb = Epi::PERM ? ((R & ~31) + perm32(R & 31)) : R;
        const int Ra = Epi::TOKPERM ? ((((R >> 6) * 16 + (R & 15)) * 8) + ((R >> 4) & 3)) : R;
        voffA[i] = (unsigned)(Ra * K + C) * 2u; voffB[i] = (unsigned)(Rb * K + C) * 2u; }
    const size_t kstep = (size_t)(BK * 2);
    const size_t hstep = (size_t)HALF * K * 2;
    const size_t hstepA = Epi::TOKPERM ? (size_t)4 * K * 2 : hstep;
    const size_t tstep = 2 * hstep;
    const unsigned ldsw = (unsigned)wid * 1024u;
    const int aoff = lds_byte(wr * 64 + fr, fq * 8), boff = lds_byte(wc * 32 + fr, fq * 8);
#define PG8_SA(b, h) (((b) * 2 + (h)) * HTB)
#define PG8_SB(b, h) ((4 + (b) * 2 + (h)) * HTB)
#define PG8_STAGE(bufoff, gbase, voff) do { _Pragma("unroll") for (int _i = 0; _i < 2; ++_i) \
        __builtin_amdgcn_global_load_lds((const unsigned*)((const char*)(gbase) + (voff)[_i]), (PG8_LAS unsigned*)(lds + (bufoff) + ldsw + _i * 8192), 16, 0, 0); } while (0)
#define PG8_LDA(dst, b, h) do { _Pragma("unroll") for (int m = 0; m < 4; ++m) _Pragma("unroll") for (int k = 0; k < 2; ++k) dst[m][k] = *(const PG8_LAS bf16x8*)(lds + PG8_SA(b, h) + aoff + m * 2048 + k * 1024); } while (0)
#define PG8_LDB(dst, b, h) do { _Pragma("unroll") for (int n = 0; n < 2; ++n) _Pragma("unroll") for (int k = 0; k < 2; ++k) dst[n][k] = *(const PG8_LAS bf16x8*)(lds + PG8_SB(b, h) + boff + n * 2048 + k * 1024); } while (0)
#define PG8_MMA(ai, bj, At, Bt) do { __builtin_amdgcn_s_setprio(1); _Pragma("unroll") for (int m = 0; m < 4; ++m) _Pragma("unroll") for (int n = 0; n < 2; ++n) _Pragma("unroll") for (int k = 0; k < 2; ++k) \
        acc[ai][bj][m][n] = __builtin_amdgcn_mfma_f32_16x16x32_bf16(Bt[n][k], At[m][k], acc[ai][bj][m][n], 0, 0, 0); __builtin_amdgcn_s_setprio(0); } while (0)
#define PG8_WAIT_V(n) asm volatile("s_waitcnt vmcnt(" #n ")" ::: "memory")
#define PG8_WAIT_L(n) asm volatile("s_waitcnt lgkmcnt(" #n ")" ::: "memory")
#define PG8_BAR __builtin_amdgcn_s_barrier()
#define PG8_SCHED __builtin_amdgcn_sched_barrier(0)
    Unit cur, nxt; int ui = 0;
    if (!S.next(0, cur)) return;
    f32x4 acc[2][2][4][2];
#pragma unroll
    for (int a = 0; a < 2; ++a)
#pragma unroll
        for (int b = 0; b < 2; ++b)
#pragma unroll
            for (int m = 0; m < 4; ++m)
#pragma unroll
                for (int n = 0; n < 2; ++n) acc[a][b][m][n] = (f32x4){0.f, 0.f, 0.f, 0.f};
    bf16x8 At[4][2], B0[2][2], B1[2][2];
    const char* cA = (const char*)g.A + (size_t)cur.pm * tstep; const char* cB = (const char*)g.Bt + (size_t)cur.pn * tstep;
    S.a_ready(cur);
    PG8_STAGE(PG8_SB(0, 0), cB, voffB); PG8_STAGE(PG8_SA(0, 0), cA, voffA); PG8_STAGE(PG8_SB(0, 1), cB + hstep, voffB); PG8_STAGE(PG8_SA(0, 1), cA + hstepA, voffA);
    if (wr == 1) PG8_BAR;
    PG8_WAIT_V(4); PG8_BAR;
    PG8_STAGE(PG8_SB(1, 0), cB + kstep, voffB); PG8_STAGE(PG8_SA(1, 0), cA + kstep, voffA); PG8_STAGE(PG8_SB(1, 1), cB + hstep + kstep, voffB);
    PG8_WAIT_V(6); PG8_BAR;
    PG8_STAMP();
    for (;;) {
        const bool has_next = S.next(ui + 1, nxt);
        const char* nA = has_next ? (const char*)g.A + (size_t)nxt.pm * tstep : cA; const char* nB = has_next ? (const char*)g.Bt + (size_t)nxt.pn * tstep : cB;
        for (int t = 0; t < nt; t += 2) {
            const bool last = (t == nt - 2);
            const char* a1 = cA + (size_t)(t + 1) * kstep;
            const char* a2 = last ? nA : cA + (size_t)(t + 2) * kstep; const char* b2 = last ? nB : cB + (size_t)(t + 2) * kstep;
            const char* a3 = a2 + kstep; const char* b3 = b2 + kstep;
            if (last && has_next) S.a_ready(nxt);
            PG8_LDB(B0, 0, 0); PG8_SCHED; PG8_LDA(At, 0, 0); PG8_STAGE(PG8_SA(1, 1), a1 + hstepA, voffA);
            PG8_WAIT_L(8); PG8_BAR; PG8_WAIT_L(0); PG8_MMA(0, 0, At, B0); PG8_BAR; PG8_SCHED;
            PG8_LDB(B1, 0, 1); PG8_STAGE(PG8_SB(0, 0), b2, voffB);
            PG8_BAR; PG8_WAIT_L(0); PG8_MMA(0, 1, At, B1); PG8_BAR;
            PG8_LDA(At, 0, 1); PG8_STAGE(PG8_SA(0, 0), a2, voffA);
            PG8_BAR; PG8_WAIT_L(0); PG8_MMA(1, 0, At, B0); PG8_BAR; PG8_SCHED;
            PG8_STAGE(PG8_SB(0, 1), b2 + hstep, voffB);
            PG8_WAIT_V(6); PG8_BAR; PG8_MMA(1, 1, At, B1); PG8_BAR;
            PG8_LDB(B0, 1, 0); PG8_SCHED; PG8_LDA(At, 1, 0); PG8_STAGE(PG8_SA(0, 1), a2 + hstepA, voffA);
            PG8_WAIT_L(8); PG8_BAR; PG8_WAIT_L(0); PG8_MMA(0, 0, At, B0); PG8_BAR; PG8_SCHED;
            PG8_LDB(B1, 1, 1); PG8_STAGE(PG8_SB(1, 0), b3, voffB);
            PG8_BAR; PG8_WAIT_L(0); PG8_MMA(0, 1, At, B1); PG8_BAR;
            PG8_LDA(At, 1, 1); PG8_STAGE(PG8_SA(1, 0), a3, voffA);
            PG8_BAR; PG8_WAIT_L(0); PG8_MMA(1, 0, At, B0); PG8_BAR; PG8_SCHED;
            PG8_STAGE(PG8_SB(1, 1), b3 + hstep, voffB);
            PG8_WAIT_V(6); PG8_BAR; PG8_MMA(1, 1, At, B1); PG8_BAR;
        }
        PG8_STAMP();
        if constexpr (!Epi::AFTER_DRAIN) { E(acc, cur, wr, wc, fr, fq); S.done(cur); }
        PG8_STAMP();
        if (!has_next) break;
#pragma unroll
        for (int a = 0; a < 2; ++a)
#pragma unroll
            for (int b = 0; b < 2; ++b)
#pragma unroll
                for (int m = 0; m < 4; ++m)
#pragma unroll
                    for (int n = 0; n < 2; ++n) acc[a][b][m][n] = (f32x4){0.f, 0.f, 0.f, 0.f};
        cur = nxt; cA = nA; cB = nB; ++ui;
    }
    PG8_WAIT_V(0);
    if (wr == 0) PG8_BAR;
    PG8_BAR;
    if constexpr (Epi::AFTER_DRAIN) { E.fused(acc, cur, wr, wc, fr, fq, lds, wid, lane); S.done(cur); }
    PG8_STAMP();
    if (STAMP && wid == 0) { stamps[lane] = lane < nts ? (((unsigned long long)(unsigned)ts_hi << 32) | (unsigned)ts_lo) : 0ull;
        if (lane == 62) stamps[62] = rt_entry; if (lane == 63) stamps[63] = (unsigned long long)wall_clock64(); }
#undef PG8_STAMP
#undef PG8_SA
#undef PG8_SB
#undef PG8_STAGE
#undef PG8_LDA
#undef PG8_LDB
#undef PG8_MMA
#undef PG8_WAIT_V
#undef PG8_WAIT_L
#undef PG8_BAR
#undef PG8_SCHED
}
}
#ifndef REP_MASK
#define REP_MASK 0
#endif
#ifndef P3_MODE
#define P3_MODE 0
#endif
typedef unsigned short bf16_t;
typedef pg8::bf16x8 bf16x8;
typedef pg8::f32x4 f32x4;
typedef pg8::u32x2 u32x2;
typedef unsigned u32x4 __attribute__((ext_vector_type(4)));
typedef float f32x2 __attribute__((ext_vector_type(2)));
#define DI __device__ __forceinline__
#define LAS __attribute__((address_space(3)))

constexpr int T = 16384, DM = 2048, SEQ = 4096, NIN = 6016, NINP = 6144, DFF = 5632, NUP = 11264;
constexpr int NPL = 15;
constexpr int LDS_BYTES = 147456;
constexpr int SCAN_BLOCKS = 96;
constexpr size_t al256(size_t x) { return (x + 255) & ~(size_t)255; }
constexpr size_t OFF_CTL = 0;
constexpr size_t CTL_BYTES = 16384;
constexpr size_t OFF_WIN = OFF_CTL + CTL_BYTES;
constexpr size_t OFF_WOUT = OFF_WIN + (size_t)NINP * DM * 2;
constexpr size_t OFF_WQ = OFF_WOUT + (size_t)DM * DM * 2;
constexpr size_t OFF_WKV = OFF_WQ + (size_t)512 * DM * 2;
constexpr size_t OFF_WO = OFF_WKV + (size_t)1024 * DM * 2;
constexpr size_t OFF_WUP = OFF_WO + (size_t)DM * 512 * 2;
constexpr size_t OFF_WDN = OFF_WUP + (size_t)NUP * DM * 2;
constexpr size_t OFF_LW = OFF_WDN + (size_t)DM * DFF * 2;
constexpr size_t OFF_LA = OFF_LW + (size_t)768 * 64 * 2;
constexpr size_t OFF_LG = OFF_LA + (size_t)768 * 64 * 2;
constexpr size_t OFF_WS = OFF_LG + (size_t)768 * 256 * 2;
constexpr size_t OFF_BT = OFF_WS + (size_t)8 * 128 * 128 * 2;
constexpr size_t OFF_MEMN = al256(OFF_BT + 3 * 12 * 132 * 4);
constexpr size_t OFF_HB = OFF_MEMN + (size_t)1024 * DM * 2;
constexpr size_t OFF_XB = OFF_HB + (size_t)T * DM * 2;
constexpr size_t OFF_R = OFF_XB + (size_t)T * DM * 2;
constexpr size_t OFF_Z = OFF_R;
constexpr size_t OFF_AP = OFF_Z + (size_t)T * NINP * 2;
constexpr size_t OFF_LSE = OFF_AP + (size_t)3 * T * 768 * 2;
constexpr size_t OFF_RWA = OFF_LSE + (size_t)3 * T * 12 * 4;
constexpr size_t OFF_RWD = OFF_RWA + (size_t)T * 768 * 2;
constexpr size_t OFF_RWG = OFF_RWD + (size_t)T * 768 * 2;
constexpr size_t OFF_YR = OFF_RWG + (size_t)T * 768 * 2;
constexpr size_t OFF_BON = OFF_YR + (size_t)T * 768 * 4;
constexpr size_t OFF_MIX = OFF_BON + (size_t)T * 12 * 4;
constexpr size_t OFF_END1 = OFF_MIX + (size_t)T * DM * 2;
constexpr size_t OFF_Y = OFF_R;
constexpr size_t OFF_Q = OFF_Y + (size_t)T * DM * 4;
constexpr size_t OFF_O = OFF_Q + (size_t)T * 512 * 2;
constexpr size_t OFF_KV = OFF_O + (size_t)T * 512 * 2;
constexpr size_t OFF_ACT = OFF_Y + (size_t)T * DM * 4;
constexpr size_t OFF_HALO = OFF_ACT + (size_t)T * DFF * 2;
constexpr size_t OFF_PART = OFF_HALO + (size_t)(T / 128) * 2 * NUP * 4;
constexpr size_t OFF_END2 = OFF_PART + (size_t)(T / 128) * 2 * NUP * 4;
constexpr size_t WS_NEED = OFF_END1 > OFF_END2 ? OFF_END1 : OFF_END2;
static_assert(OFF_Y + (size_t)T * DM * 4 <= OFF_MIX, "Y must not overlap MIX");

struct Params { const float* in[30]; float* out; unsigned char* ws; };
struct InArr { const Params* pp; size_t zero; DI const float* operator[](int i) const { return pp->in[i] + zero; } };
struct PView { InArr in; float* out; unsigned char* ws; };

DI float bf2f(unsigned b) { return __uint_as_float(b << 16); }
DI float bflo(unsigned w) { return __uint_as_float(w << 16); }
DI float bfhi(unsigned w) { return __uint_as_float(w & 0xffff0000u); }
typedef __bf16 bf16x2_t __attribute__((ext_vector_type(2)));
DI unsigned pack2(float lo, float hi) { const f32x2 v = {lo, hi}; const bf16x2_t r = __builtin_convertvector(v, bf16x2_t); return __builtin_bit_cast(unsigned, r); }
DI bf16_t f2bf(float f) { return (bf16_t)(pack2(f, 0.f) & 0xffffu); }

template <int C> DI float dppf(float x) { return __int_as_float(__builtin_amdgcn_update_dpp(0, __float_as_int(x), C, 0xF, 0xF, true)); }
DI float rsum16(float x) { x += dppf<0xB1>(x); x += dppf<0x4E>(x); x += dppf<0x141>(x); x += dppf<0x140>(x); return x; }
DI float swz16(float x) { return __int_as_float(__builtin_amdgcn_ds_swizzle(__float_as_int(x), 0x401F)); }
DI float wsum(float x) { x = rsum16(x); x += swz16(x); return __int_as_float(__builtin_amdgcn_readlane(__float_as_int(x), 0)) + __int_as_float(__builtin_amdgcn_readlane(__float_as_int(x), 32)); }
DI float xor32(float x, int tid) { return __int_as_float(__builtin_amdgcn_ds_bpermute(((tid ^ 32) & 63) << 2, __float_as_int(x))); }
DI float gelu_t(float x) { const float u = 0.7978845608028654f * (x + 0.044715f * x * x * x); return x * __builtin_amdgcn_rcpf(1.0f + __expf(-2.0f * u)); }
DI float sigm(float x) { return __builtin_amdgcn_rcpf(1.0f + __expf(-x)); }
DI void unpack8(const uint4 w, float (&f)[8]) { f[0] = bflo(w.x); f[1] = bfhi(w.x); f[2] = bflo(w.y); f[3] = bfhi(w.y); f[4] = bflo(w.z); f[5] = bfhi(w.z); f[6] = bflo(w.w); f[7] = bfhi(w.w); }
DI uint4 pack8(const float (&f)[8]) { uint4 w; w.x = pack2(f[0], f[1]); w.y = pack2(f[2], f[3]); w.z = pack2(f[4], f[5]); w.w = pack2(f[6], f[7]); return w; }

template <int KT>
DI void cvt_job(const int ctx_tid, const int ctx_bid, const int ctx_g, const float* W, bf16_t* Bt, int K, int N, int Npad, int mode, int& tile_base, LAS float* tile) {
    constexpr int NL = KT / 32;
    const int tk = K / KT, tn = Npad / 64, nt = tk * tn, G = ctx_g, tid = ctx_tid, w = tid >> 6, lane = tid & 63;
    const int first = (ctx_bid - (tile_base % G) + G) % G;
    const int r = tid >> 4, c4 = (tid & 15) * 4;
    auto tile_src = [&](int ti, int& n0, int& k0, int& src, bool& valid) { const int ik = ti % tk, in_ = ti / tk; n0 = in_ * 64; k0 = ik * KT; src = n0; valid = n0 < N;
        if (mode == 1) { const int pn = n0 / 256, bj = (n0 % 256) / 128, off = n0 % 128; src = bj * DFF + pn * 128 + off; valid = true; } };
    float4 cur[NL], nxt[NL], nx2[NL];
    auto tile_load = [&](int ti, float4 (&v)[NL]) { int n0, k0, src; bool valid; tile_src(ti < nt ? ti : first, n0, k0, src, valid);
#pragma unroll
        for (int i = 0; i < NL; ++i) { if (valid) { const f32x4 t = __builtin_nontemporal_load((const f32x4*)(W + (size_t)(k0 + r + 32 * i) * N + src + c4)); v[i] = make_float4(t.x, t.y, t.z, t.w); } else v[i] = make_float4(0.f, 0.f, 0.f, 0.f); } };
    if (first < nt) { tile_load(first, cur); tile_load(first + G, nxt); }
    for (int ti = first; ti < nt; ti += G) {
        int n0, k0, src; bool valid; tile_src(ti, n0, k0, src, valid);
        tile_load(ti + 2 * G, nx2);
#pragma unroll
        for (int i = 0; i < NL; ++i) { LAS float* d = tile + (r + 32 * i) * 65 + c4; d[0] = cur[i].x; d[1] = cur[i].y; d[2] = cur[i].z; d[3] = cur[i].w; }
        __syncthreads();
        { constexpr int KW = KT / 8;
          bf16_t* o = Bt + (size_t)(n0 + lane) * K + k0 + w * KW;
#pragma unroll
          for (int q = 0; q < KW / 8; ++q) { float f[8];
#pragma unroll
            for (int j = 0; j < 8; ++j) f[j] = tile[(w * KW + q * 8 + j) * 65 + lane];
            *(uint4*)(o + q * 8) = pack8(f); } }
        __syncthreads();
#pragma unroll
        for (int i = 0; i < NL; ++i) { cur[i] = nxt[i]; nxt[i] = nx2[i]; }
    }
    tile_base += nt;
}
DI int xcd_row(const int bid, const int wave, const int G, const int i) {
    if (G == 256) return i < 8 ? 2048 * (bid & 7) + ((bid >> 3) * 8 + wave) + 256 * i : T;
    return bid * 8 + wave + i * G * 8;
}
DI void rmsnorm_rows_bf16(const int ctx_tid, const int ctx_bid, const int ctx_g, const float* X, const float* gain, bf16_t* O, int rows) {
    const int lane = ctx_tid & 63, wv = ctx_tid >> 6; const bool xm = (rows == T) && (ctx_g == 256);
    for (int ri = 0; ; ++ri) { const int r = xm ? xcd_row(ctx_bid, wv, 256, ri) : ctx_bid * 8 + wv + ri * ctx_g * 8; if (r >= rows) break;
        const float* x = X + (size_t)r * DM; float4 v[8]; float ss = 0.f;
#pragma unroll
        for (int i = 0; i < 8; ++i) { v[i] = *(const float4*)(x + (i * 64 + lane) * 4); ss += v[i].x * v[i].x + v[i].y * v[i].y + v[i].z * v[i].z + v[i].w * v[i].w; }
        const float rs = rsqrtf(wsum(ss) * (1.0f / DM) + 1e-6f);
#pragma unroll
        for (int i = 0; i < 8; ++i) { const float4 g = *(const float4*)(gain + (i * 64 + lane) * 4); uint2 w; w.x = pack2(v[i].x * rs * g.x, v[i].y * rs * g.y); w.y = pack2(v[i].z * rs * g.z, v[i].w * rs * g.w);
            *(uint2*)(O + (size_t)r * DM + (i * 64 + lane) * 4) = w; }
    }
}
DI int t5_bucket(int dist) {
    if (dist < 16) return dist;
    int bkt = 16;
    bkt += dist >= 22; bkt += dist >= 30; bkt += dist >= 40; bkt += dist >= 54; bkt += dist >= 73; bkt += dist >= 99; bkt += dist >= 134; bkt += dist >= 182;
    bkt += dist >= 246; bkt += dist >= 332; bkt += dist >= 450; bkt += dist >= 609; bkt += dist >= 825; bkt += dist >= 1117; bkt += dist >= 1513;
    return bkt;
}
DI void phase_cvt(const int ctx_tid, const int ctx_bid, const int ctx_g, const PView& p, int l, LAS unsigned char* lds) {
#ifdef NO_CVT
    return;
#endif
    unsigned char* ws = p.ws; LAS float* tile = (LAS float*)lds; int tb = 0;
    cvt_job<256>(ctx_tid, ctx_bid, ctx_g, p.in[5] + (size_t)l * DM * NIN, (bf16_t*)(ws + OFF_WIN), DM, NIN, NINP, 0, tb, tile);
    cvt_job<256>(ctx_tid, ctx_bid, ctx_g, p.in[26] + (size_t)l * DM * NUP, (bf16_t*)(ws + OFF_WUP), DM, NUP, NUP, 1, tb, tile);
    cvt_job<256>(ctx_tid, ctx_bid, ctx_g, p.in[29] + (size_t)l * DFF * DM, (bf16_t*)(ws + OFF_WDN), DFF, DM, DM, 0, tb, tile);
    cvt_job<256>(ctx_tid, ctx_bid, ctx_g, p.in[6] + (size_t)l * DM * DM, (bf16_t*)(ws + OFF_WOUT), DM, DM, DM, 0, tb, tile);
    cvt_job<256>(ctx_tid, ctx_bid, ctx_g, p.in[23] + (size_t)l * DM * 512, (bf16_t*)(ws + OFF_WQ), DM, 512, 512, 0, tb, tile);
    cvt_job<256>(ctx_tid, ctx_bid, ctx_g, p.in[24] + (size_t)l * DM * 1024, (bf16_t*)(ws + OFF_WKV), DM, 1024, 1024, 0, tb, tile);
    cvt_job<256>(ctx_tid, ctx_bid, ctx_g, p.in[25] + (size_t)l * 512 * DM, (bf16_t*)(ws + OFF_WO), 512, DM, DM, 0, tb, tile);
    cvt_job<64>(ctx_tid, ctx_bid, ctx_g, p.in[14] + (size_t)l * 64 * 768, (bf16_t*)(ws + OFF_LW), 64, 768, 768, 0, tb, tile);
    cvt_job<64>(ctx_tid, ctx_bid, ctx_g, p.in[16] + (size_t)l * 64 * 768, (bf16_t*)(ws + OFF_LA), 64, 768, 768, 0, tb, tile);
    cvt_job<256>(ctx_tid, ctx_bid, ctx_g, p.in[17] + (size_t)l * 256 * 768, (bf16_t*)(ws + OFF_LG), 256, 768, 768, 0, tb, tile);
    const int gt = ctx_bid * 512 + ctx_tid, ng = ctx_g * 512;
    { const float* sw = p.in[9] + (size_t)l * 8 * 128 * 128; bf16_t* o = (bf16_t*)(ws + OFF_WS);
      for (int i = gt; i < 8 * 128 * 128; i += ng) { const int jj = i & 127, ii = (i >> 7) & 127; o[i] = f2bf(jj <= ii ? sw[i] : 0.f); } }
    if (l == 0) { float* bt = (float*)(ws + OFF_BT);
      for (int i = gt; i < 3 * 12 * 129; i += ng) { const int delta = i % 129, h = (i / 129) % 12, pp = i / (129 * 12); const int d = pp == 0 ? 1 : (pp == 1 ? 4 : 16);
        bt[(pp * 12 + h) * 132 + delta] = p.in[2][t5_bucket(delta * d) * 12 + h]; } }
    rmsnorm_rows_bf16(ctx_tid, ctx_bid, ctx_g, p.in[1], p.in[4] + (size_t)l * DM, (bf16_t*)(ws + OFF_MEMN), 1024);
    if (l == 0) rmsnorm_rows_bf16(ctx_tid, ctx_bid, ctx_g, p.in[0], p.in[3], (bf16_t*)(ws + OFF_HB), T);
}

template <bool XIN_F32, bool XOUT_F32>
DI void phase_resid(const int ctx_tid, const int ctx_bid, const int ctx_g, const bf16_t* Y, const void* xi_, void* xo_, const float* ga, const float* gb, bf16_t* HB) {
#ifdef NO_RESID
    return;
#endif
    const int lane = ctx_tid & 63, wv = ctx_tid >> 6;
    for (int ri = 0, r = xcd_row(ctx_bid, wv, ctx_g, 0); r < T; r = xcd_row(ctx_bid, wv, ctx_g, ++ri)) {
        float4 xv[8], xin[8]; float ss = 0.f;
#pragma unroll
        for (int i = 0; i < 8; ++i) { const int c = (i * 64 + lane) * 4; const u32x2 yq = __builtin_nontemporal_load((const u32x2*)(Y + (size_t)r * DM + c)); float4 y; y.x = bflo(yq.x); y.y = bfhi(yq.x); y.z = bflo(yq.y); y.w = bfhi(yq.y); xv[i] = y; ss += y.x * y.x + y.y * y.y + y.z * y.z + y.w * y.w;
            if (XIN_F32) { const f32x4 t = __builtin_nontemporal_load((const f32x4*)((const float*)xi_ + (size_t)r * DM + c)); xin[i] = make_float4(t.x, t.y, t.z, t.w); }
            else { const u32x2 xq = __builtin_nontemporal_load((const u32x2*)((const bf16_t*)xi_ + (size_t)r * DM + c)); xin[i].x = bflo(xq.x); xin[i].y = bfhi(xq.x); xin[i].z = bflo(xq.y); xin[i].w = bfhi(xq.y); } }
        const float rs = rsqrtf(wsum(ss) * (1.0f / DM) + 1e-6f); float s2 = 0.f;
#pragma unroll
        for (int i = 0; i < 8; ++i) { const int c = (i * 64 + lane) * 4; const float4 g = *(const float4*)(ga + c); const float4 x = xin[i];
            float4 o; o.x = x.x + xv[i].x * rs * g.x; o.y = x.y + xv[i].y * rs * g.y; o.z = x.z + xv[i].z * rs * g.z; o.w = x.w + xv[i].w * rs * g.w;
            if (XOUT_F32) __builtin_nontemporal_store((f32x4){o.x, o.y, o.z, o.w}, (f32x4*)((float*)xo_ + (size_t)r * DM + c));
            else { uint2 w; w.x = pack2(o.x, o.y); w.y = pack2(o.z, o.w); *(uint2*)((bf16_t*)xo_ + (size_t)r * DM + c) = w; }
            xv[i] = o; s2 += o.x * o.x + o.y * o.y + o.z * o.z + o.w * o.w; }
        if (gb) { const float r2 = rsqrtf(wsum(s2) * (1.0f / DM) + 1e-6f);
#pragma unroll
            for (int i = 0; i < 8; ++i) { const int c = (i * 64 + lane) * 4; const float4 g = *(const float4*)(gb + c); uint2 w; w.x = pack2(xv[i].x * r2 * g.x, xv[i].y * r2 * g.y); w.y = pack2(xv[i].z * r2 * g.z, xv[i].w * r2 * g.w);
                *(uint2*)(HB + (size_t)r * DM + c) = w; } }
    }
}

DI void phase_rwkv_prep(const int ctx_tid, const int ctx_bid, const int ctx_g, const PView& p, int l, LAS unsigned char* lds) {
#ifdef NO_PREP
    return;
#endif
    unsigned char* ws = p.ws; const bf16_t* Z = (const bf16_t*)(ws + OFF_Z);
    const float* mu = p.in[12] + (size_t)l * 2688 + 2304; const float* w0 = p.in[13] + (size_t)l * 768; const float* a0 = p.in[15] + (size_t)l * 768;
    const bf16_t* LW = (const bf16_t*)(ws + OFF_LW); const bf16_t* LA = (const bf16_t*)(ws + OFF_LA); const bf16_t* LG = (const bf16_t*)(ws + OFF_LG);
    bf16_t* RWA = (bf16_t*)(ws + OFF_RWA); bf16_t* RWD = (bf16_t*)(ws + OFF_RWD); bf16_t* RWG = (bf16_t*)(ws + OFF_RWG);
    const int tid = ctx_tid, lane = tid & 63, w = tid >> 6, fr = lane & 15, fq = lane >> 4;
    constexpr int AST = 392;
    LAS bf16_t* A = (LAS bf16_t*)lds;
    for (int item = ctx_bid; item < T / 64; item += ctx_g) {
        { uint2 cur[4][3], prv[4][3];
#pragma unroll
          for (int r = 0; r < 4; ++r) { const int idx = tid + 512 * r, row = idx >> 5, cs = (idx & 31) * 12; const int t = item * 64 + row; const bool hasp = (t % SEQ) != 0;
            const bf16_t* zr = Z + (size_t)t * NINP + 5632 + cs;
#pragma unroll
            for (int q = 0; q < 3; ++q) { cur[r][q] = *(const uint2*)(zr + q * 4); prv[r][q] = make_uint2(0u, 0u); if (hasp) prv[r][q] = *(const uint2*)(zr - NINP + q * 4); } }
#pragma unroll
          for (int r = 0; r < 4; ++r) { const int idx = tid + 512 * r, row = idx >> 5, cs = (idx & 31) * 12;
#pragma unroll
            for (int q = 0; q < 3; ++q) { const float c4[4] = {bflo(cur[r][q].x), bfhi(cur[r][q].x), bflo(cur[r][q].y), bfhi(cur[r][q].y)}, p4[4] = {bflo(prv[r][q].x), bfhi(prv[r][q].x), bflo(prv[r][q].y), bfhi(prv[r][q].y)};
#pragma unroll
              for (int e = 0; e < 4; ++e) { const int c = cs + q * 4 + e; float v = c4[e] + (p4[e] - c4[e]) * mu[c];
                  if (c < 64) v = 1.0f - 2.0f * __builtin_amdgcn_rcpf(__expf(2.0f * v) + 1.0f); else if (c >= 128) v = sigm(v);
                  A[row * AST + c] = f2bf(v); } } } }
        __syncthreads();
        const int t0 = item * 64;
        bf16x8 bc[12]; float wz, az;
#pragma unroll 1
        for (int nt = 0; nt < 6; ++nt) {
            const int n0 = w * 96 + nt * 16, c = n0 + fr;
#pragma unroll
            for (int ks = 0; ks < 2; ++ks) { bc[ks] = *(const bf16x8*)(LW + (size_t)(n0 + fr) * 64 + ks * 32 + fq * 8); bc[2 + ks] = *(const bf16x8*)(LA + (size_t)(n0 + fr) * 64 + ks * 32 + fq * 8); }
#pragma unroll
            for (int ks = 0; ks < 8; ++ks) bc[4 + ks] = *(const bf16x8*)(LG + (size_t)(n0 + fr) * 256 + ks * 32 + fq * 8);
            wz = w0[c]; az = a0[c];
#pragma unroll 1
            for (int mt = 0; mt < 4; ++mt) {
                const LAS bf16_t* Ar = A + (mt * 16 + fr) * AST + fq * 8; const int tb = t0 + mt * 16 + fq * 4;
                f32x4 accw = {0.f, 0.f, 0.f, 0.f}, acca = {0.f, 0.f, 0.f, 0.f}, accg = {0.f, 0.f, 0.f, 0.f};
#pragma unroll
                for (int ks = 0; ks < 2; ++ks) { accw = __builtin_amdgcn_mfma_f32_16x16x32_bf16(*(const LAS bf16x8*)(Ar + ks * 32), bc[ks], accw, 0, 0, 0);
                                                 acca = __builtin_amdgcn_mfma_f32_16x16x32_bf16(*(const LAS bf16x8*)(Ar + 64 + ks * 32), bc[2 + ks], acca, 0, 0, 0); }
#pragma unroll
                for (int ks = 0; ks < 8; ++ks) accg = __builtin_amdgcn_mfma_f32_16x16x32_bf16(*(const LAS bf16x8*)(Ar + 128 + ks * 32), bc[4 + ks], accg, 0, 0, 0);
#pragma unroll
                for (int j = 0; j < 4; ++j) { const float u = wz + accw[j];
                    RWD[(size_t)(tb + j) * 768 + c] = f2bf(0.6065306597126334f * sigm(u)); RWA[(size_t)(tb + j) * 768 + c] = f2bf(sigm(az + acca[j])); RWG[(size_t)(tb + j) * 768 + c] = f2bf(accg[j]); }
            }
        }
        __syncthreads();
    }
}

template <int DH, int NSTEP, bool MASK>
DI void attn_wave(const int ctx_tid, const int ctx_bid, const int ctx_g, const LAS unsigned char* Kl, int KS, const LAS unsigned char* Vl, int VS, const bf16x8 (&qf)[DH / 32], int step0, float scale,
                  int qi, bool first_block, const LAS float* btab, bf16_t* orow, float* lse_out) {
    const int lane = ctx_tid & 63, fr = lane & 15, fq = lane >> 4;
    f32x4 s[NSTEP][2];
#pragma unroll
    for (int st = 0; st < NSTEP; ++st)
#pragma unroll
        for (int hf = 0; hf < 2; ++hf) {
            const int key0 = (step0 + st) * 32 + hf * 16; f32x4 acc = {0.f, 0.f, 0.f, 0.f};
#pragma unroll
            for (int ks = 0; ks < DH / 32; ++ks) { const bf16x8 kf = *(const LAS bf16x8*)(Kl + (key0 + fr) * KS + (ks * 32 + fq * 8) * 2);
                acc = __builtin_amdgcn_mfma_f32_16x16x32_bf16(kf, qf[ks], acc, 0, 0, 0); }
            s[st][hf] = acc;
        }
    float m = -3.0e38f;
    const int kjb = step0 * 32 + fq * 4, tb0 = kjb - qi + 31;
#pragma unroll
    for (int st = 0; st < NSTEP; ++st)
#pragma unroll
        for (int hf = 0; hf < 2; ++hf)
#pragma unroll
            for (int j = 0; j < 4; ++j) {
                float v = s[st][hf][j] * scale;
                if (MASK) v += btab[tb0 + st * 32 + hf * 16 + j];
                s[st][hf][j] = v;
            }
    if (MASK && first_block) {
#pragma unroll
        for (int st = 0; st < NSTEP; ++st)
#pragma unroll
            for (int hf = 0; hf < 2; ++hf)
#pragma unroll
                for (int j = 0; j < 4; ++j) s[st][hf][j] = (kjb + (st * 32 + hf * 16 + j) >= 128) ? s[st][hf][j] : -1e30f; }
#pragma unroll
    for (int st = 0; st < NSTEP; ++st)
#pragma unroll
        for (int hf = 0; hf < 2; ++hf)
#pragma unroll
            for (int j = 0; j < 4; ++j) m = fmaxf(m, s[st][hf][j]);
    m = fmaxf(m, swz16(m)); m = fmaxf(m, xor32(m, ctx_tid));
    float den = 0.f;
#pragma unroll
    for (int st = 0; st < NSTEP; ++st)
#pragma unroll
        for (int hf = 0; hf < 2; ++hf)
#pragma unroll
            for (int j = 0; j < 4; ++j) { const float e = __expf(s[st][hf][j] - m); s[st][hf][j] = e; den += e; }
    den += swz16(den); den += xor32(den, ctx_tid);
    f32x4 o[DH / 16];
#pragma unroll
    for (int dt = 0; dt < DH / 16; ++dt) o[dt] = (f32x4){0.f, 0.f, 0.f, 0.f};
#pragma unroll
    for (int st = 0; st < NSTEP; ++st) {
        uint4 pw; pw.x = pack2(s[st][0][0], s[st][0][1]); pw.y = pack2(s[st][0][2], s[st][0][3]); pw.z = pack2(s[st][1][0], s[st][1][1]); pw.w = pack2(s[st][1][2], s[st][1][3]);
        const bf16x8 pf = __builtin_bit_cast(bf16x8, pw);
        const int kb = (step0 + st) * 32;
#pragma unroll
        for (int dt = 0; dt < DH / 16; ++dt) {
            const LAS unsigned char* vr = Vl + (dt * 16 + fr) * VS + (kb + fq * 4) * 2;
            const u32x2 v0 = *(const LAS u32x2*)vr; const u32x2 v1 = *(const LAS u32x2*)(vr + 32);
            u32x4 vw; vw.x = v0.x; vw.y = v0.y; vw.z = v1.x; vw.w = v1.y;
            o[dt] = __builtin_amdgcn_mfma_f32_16x16x32_bf16(__builtin_bit_cast(bf16x8, vw), pf, o[dt], 0, 0, 0);
        }
    }
    const float inv = 1.0f / den;
#pragma unroll
    for (int dt = 0; dt < DH / 16; ++dt) { uint2 w; w.x = pack2(o[dt][0] * inv, o[dt][1] * inv); w.y = pack2(o[dt][2] * inv, o[dt][3] * inv); *(uint2*)(orow + dt * 16 + fq * 4) = w; }
    if (lse_out && fq == 0) *lse_out = m + __logf(den);
}

struct DilItem { int b, h, pp, d, r, nb; };
DI DilItem dil_decode(int item) { DilItem I; const int sub = item & 31; I.pp = (item >> 5) % 3; const int bh = item / 96; I.b = bh / 12; I.h = bh % 12;
    if (I.pp == 0) { I.d = 1; I.r = 0; I.nb = sub; } else if (I.pp == 1) { I.d = 4; I.r = sub >> 3; I.nb = sub & 7; } else { I.d = 16; I.r = sub >> 1; I.nb = sub & 1; } return I; }
DI void dil_load(const int ctx_tid, const PView& p, int item, u32x4 (&kq)[4], u32x2 (&vq)[8], bf16x8 (&qf)[2], float& btv) {
    const char* Zb = (const char*)(p.ws + OFF_Z); const DilItem I = dil_decode(item);
    const unsigned strideB = (unsigned)I.d * (unsigned)(NINP * 2);
    const unsigned base0 = ((unsigned)(I.b * SEQ + I.r) * (unsigned)NINP + (unsigned)(I.h * 64)) * 2u;
    const int m0 = 128 * (I.nb - 1);
    { const int w = ctx_tid >> 6, lane = ctx_tid & 63; const int qi = 16 * w + (lane & 15);
      const char* qrow = Zb + (base0 + (unsigned)(m0 + 128 + qi) * strideB + (unsigned)((lane >> 4) * 16)); qf[0] = *(const bf16x8*)(qrow); qf[1] = *(const bf16x8*)(qrow + 64); }
    { const int u = ctx_tid - 31; const int uc = u < 0 ? 0 : (u > 128 ? 128 : u); const float bv = ((const float*)(p.ws + OFF_BT))[(I.pp * 12 + I.h) * 132 + (128 - uc)]; btv = (u >= 0 && u <= 128) ? bv : -1e30f; }
    { const int key = ctx_tid >> 1, hf = ctx_tid & 1; const int mk = m0 + key; const unsigned msk = mk < 0 ? 0u : 0xffffffffu;
      const char* zr = Zb + (base0 + (unsigned)(mk < 0 ? 0 : mk) * strideB + (unsigned)((768 + hf * 32) * 2));
#pragma unroll
      for (int i = 0; i < 4; ++i) kq[i] = *(const u32x4*)(zr + i * 16) & msk; }
    { const int kg = ctx_tid >> 4, dg = ctx_tid & 15; const int mk0 = m0 + kg * 8; const unsigned msk = mk0 < 0 ? 0u : 0xffffffffu;
      const char* zv = Zb + (base0 + (unsigned)(mk0 < 0 ? 0 : mk0) * strideB + (unsigned)((1536 + dg * 4) * 2));
#pragma unroll
      for (int k = 0; k < 8; ++k) vq[k] = *(const u32x2*)(zv + (unsigned)k * strideB) & msk; }
}
DI void dil_stage(const int ctx_tid, const PView& p, int item, const u32x4 (&kq)[4], const u32x2 (&vq)[8], const float btv, LAS unsigned char* lds) {
    constexpr int KS = 144, VS = 528; const DilItem I = dil_decode(item);
    LAS unsigned char* Kl = lds; LAS unsigned char* Vl = lds + 256 * KS; LAS float* btl = (LAS float*)(lds + 256 * KS + 64 * VS);
    const int tid = ctx_tid, key = tid >> 1, hf = tid & 1;
    if (tid < 192) btl[tid] = btv;
#pragma unroll
    for (int i = 0; i < 4; ++i) *(LAS u32x4*)(Kl + key * KS + hf * 64 + i * 16) = kq[i];
    { const int kg = tid >> 4, dg = tid & 15; u32x4 o[4];
#pragma unroll
      for (int i = 0; i < 4; ++i) {
          o[0][i] = __builtin_amdgcn_perm(vq[2 * i + 1].x, vq[2 * i].x, 0x05040100u); o[1][i] = __builtin_amdgcn_perm(vq[2 * i + 1].x, vq[2 * i].x, 0x07060302u);
          o[2][i] = __builtin_amdgcn_perm(vq[2 * i + 1].y, vq[2 * i].y, 0x05040100u); o[3][i] = __builtin_amdgcn_perm(vq[2 * i + 1].y, vq[2 * i].y, 0x07060302u); }
#pragma unroll
      for (int d = 0; d < 4; ++d) *(LAS u32x4*)(Vl + (dg * 4 + d) * VS + kg * 16) = o[d]; }
}
DI void dil_compute(const int ctx_tid, const int ctx_bid, const int ctx_g, const PView& p, int item, const bf16x8 (&qf)[2], LAS unsigned char* lds) {
    constexpr int KS = 144, VS = 528; const DilItem I = dil_decode(item);
    unsigned char* ws = p.ws; const bf16_t* Z = (const bf16_t*)(ws + OFF_Z);
    LAS unsigned char* Kl = lds; LAS unsigned char* Vl = lds + 256 * KS; LAS float* btl = (LAS float*)(lds + 256 * KS + 64 * VS);
    const int w = ctx_tid >> 6, lane = ctx_tid & 63;
    const int qi = 16 * w + (lane & 15); const int tq = I.b * SEQ + (128 * I.nb + qi) * I.d + I.r;
    bf16_t* AP = (bf16_t*)(ws + OFF_AP); float* LSE = (float*)(ws + OFF_LSE);
    attn_wave<64, 5, true>(ctx_tid, ctx_bid, ctx_g, Kl, KS, Vl, VS, qf, w >> 1, 0.125f, qi, I.nb == 0, btl,
                           AP + ((size_t)I.pp * T + tq) * 768 + I.h * 64, LSE + ((size_t)I.pp * T + tq) * 12 + I.h);
}
DI void cross_item(const int ctx_tid, const int ctx_bid, const int ctx_g, const PView& p, int item, const bool restage, LAS unsigned char* lds) {
#ifdef NO_CROSS
    return;
#endif
    unsigned char* ws = p.ws; const bf16_t* KV = (const bf16_t*)(ws + OFF_KV); const bf16_t* Q = (const bf16_t*)(ws + OFF_Q); bf16_t* O = (bf16_t*)(ws + OFF_O);
    const int tid = ctx_tid, w = tid >> 6, lane = tid & 63;
    const int kv = item & 15, qb = item >> 4, b = kv >> 2, mh = kv & 3;
    constexpr int KS = 272, VS = 528;
    LAS unsigned char* Kl = lds; LAS unsigned char* Vl = lds + 256 * KS;
    const int tq = b * SEQ + qb * 128 + 16 * w + (lane & 15);
    bf16x8 qf[4];
#pragma unroll
    for (int ks = 0; ks < 4; ++ks) qf[ks] = *(const bf16x8*)(Q + (size_t)tq * 512 + mh * 128 + ks * 32 + (lane >> 4) * 8);
    if (restage) {
        { const int key = tid >> 1, hf = tid & 1; const bf16_t* kr = KV + (size_t)(b * 256 + key) * 1024 + mh * 128 + hf * 64;
          u32x4 kq[8];
#pragma unroll
          for (int i = 0; i < 8; ++i) kq[i] = *(const u32x4*)(kr + i * 8);
          const int kg = tid >> 4, dg = tid & 15; u32x4 vq[8];
#pragma unroll
          for (int k = 0; k < 8; ++k) vq[k] = *(const u32x4*)(KV + (size_t)(b * 256 + kg * 8 + k) * 1024 + 512 + mh * 128 + dg * 8);
#pragma unroll
          for (int i = 0; i < 8; ++i) *(LAS u32x4*)(Kl + key * KS + hf * 128 + i * 16) = kq[i];
#pragma unroll
          for (int c = 0; c < 4; ++c) {
              u32x4 lo, hi;
#pragma unroll
              for (int i = 0; i < 4; ++i) { lo[i] = __builtin_amdgcn_perm(vq[2 * i + 1][c], vq[2 * i][c], 0x05040100u); hi[i] = __builtin_amdgcn_perm(vq[2 * i + 1][c], vq[2 * i][c], 0x07060302u); }
              *(LAS u32x4*)(Vl + (dg * 8 + 2 * c) * VS + kg * 16) = lo; *(LAS u32x4*)(Vl + (dg * 8 + 2 * c + 1) * VS + kg * 16) = hi; } }
        __syncthreads();
    }
    attn_wave<128, 8, false>(ctx_tid, ctx_bid, ctx_g, Kl, KS, Vl, VS, qf, 0, 0.08838834764831845f, 0, false, nullptr, O + (size_t)tq * 512 + mh * 128, nullptr);
    __syncthreads();
}

DI void sgu_item(const int ctx_tid, const int ctx_bid, const int ctx_g, const PView& p, int l, int chunk, LAS unsigned char* lds) {
#ifdef NO_SGU
    return;
#endif
    unsigned char* ws = p.ws; const bf16_t* Z = (const bf16_t*)(ws + OFF_Z); bf16_t* MIX = (bf16_t*)(ws + OFF_MIX); const bf16_t* WS = (const bf16_t*)(ws + OFF_WS);
    const float* ng = p.in[8] + (size_t)l * 512; const float* sb = p.in[10] + (size_t)l * 1024; const float* og = p.in[11] + (size_t)l * 512;
    const int tid = ctx_tid, w = tid >> 6, lane = tid & 63, fr = lane & 15, fq = lane >> 4;
    constexpr int GS = 520;
    constexpr int GT = 136;
    LAS bf16_t* G = (LAS bf16_t*)lds;
    float gain8[8];
#pragma unroll
    for (int e = 0; e < 8; ++e) gain8[e] = ng[lane + 64 * e];
#pragma unroll 1
    for (int i0 = 0; i0 < 16; i0 += 4) {
        unsigned short raw[4][8];
#pragma unroll
        for (int ii = 0; ii < 4; ++ii) { const size_t tok = (size_t)chunk * 128 + 16 * w + i0 + ii;
#pragma unroll
            for (int e = 0; e < 8; ++e) raw[ii][e] = __builtin_nontemporal_load(Z + tok * NINP + 2816 + lane + 64 * e); }
#pragma unroll
        for (int ii = 0; ii < 4; ++ii) { const int j = 16 * w + i0 + ii;
            float f[8]; float s = 0.f;
#pragma unroll
            for (int e = 0; e < 8; ++e) { f[e] = gelu_t(bf2f(raw[ii][e])); s += f[e]; }
            const float mean = wsum(s) * (1.0f / 512.0f); float q = 0.f;
#pragma unroll
            for (int e = 0; e < 8; ++e) { f[e] -= mean; q += f[e] * f[e]; }
            const float rs = rsqrtf(wsum(q) * (1.0f / 512.0f) + 1e-6f);
#pragma unroll
            for (int e = 0; e < 8; ++e) G[(lane + 64 * e) * GT + j] = f2bf(f[e] * rs * gain8[e]); } }
    __syncthreads();
    bf16x8 bfr[4][4];
#pragma unroll
    for (int nt = 0; nt < 4; ++nt)
#pragma unroll
        for (int ks = 0; ks < 4; ++ks) bfr[nt][ks] = *(const LAS bf16x8*)(G + (w * 64 + nt * 16 + fr) * GT + ks * 32 + fq * 8);
    __syncthreads();
    unsigned short uc[4][4], un[4][4]; float bc4[4], bn4[4];
#pragma unroll
    for (int j = 0; j < 4; ++j) { const int i = fq * 4 + j; const size_t tok = (size_t)chunk * 128 + i; bc4[j] = sb[w * 128 + i];
#pragma unroll
        for (int nt = 0; nt < 4; ++nt) uc[j][nt] = __builtin_nontemporal_load(Z + tok * NINP + 2304 + w * 64 + nt * 16 + fr); }
#pragma unroll 1
    for (int it = 0; it < 8; ++it) {
        { const int itn = it < 7 ? it + 1 : 7;
#pragma unroll
          for (int j = 0; j < 4; ++j) { const int i = itn * 16 + fq * 4 + j; const size_t tok = (size_t)chunk * 128 + i; bn4[j] = sb[w * 128 + i];
#pragma unroll
            for (int nt = 0; nt < 4; ++nt) un[j][nt] = __builtin_nontemporal_load(Z + tok * NINP + 2304 + w * 64 + nt * 16 + fr); } }
        f32x4 acc[4];
#pragma unroll
        for (int nt = 0; nt < 4; ++nt) acc[nt] = (f32x4){0.f, 0.f, 0.f, 0.f};
#pragma unroll
        for (int ks = 0; ks < 4; ++ks) if (ks * 32 <= it * 16 + 15) {
            const bf16x8 a = *(const bf16x8*)(WS + (size_t)(w * 128 + it * 16 + fr) * 128 + ks * 32 + fq * 8);
#pragma unroll
            for (int nt = 0; nt < 4; ++nt) acc[nt] = __builtin_amdgcn_mfma_f32_16x16x32_bf16(a, bfr[nt][ks], acc[nt], 0, 0, 0); }
#pragma unroll
        for (int j = 0; j < 4; ++j) { const int i = it * 16 + fq * 4 + j;
#pragma unroll
            for (int nt = 0; nt < 4; ++nt) { const int c = w * 64 + nt * 16 + fr; const float u = gelu_t(bf2f(uc[j][nt]));
                G[i * GS + c] = f2bf(u * (acc[nt][j] + bc4[j])); } }
#pragma unroll
        for (int j = 0; j < 4; ++j) { bc4[j] = bn4[j];
#pragma unroll
            for (int nt = 0; nt < 4; ++nt) uc[j][nt] = un[j][nt]; }
    }
    __syncthreads();
    float og8[8];
#pragma unroll
    for (int e = 0; e < 8; ++e) og8[e] = og[lane * 8 + e];
    for (int i = 0; i < 16; ++i) { const int j = 16 * w + i; const size_t tok = (size_t)chunk * 128 + j;
        float f[8]; { const u32x4 lv = *(const LAS u32x4*)(G + j * GS + lane * 8); unpack8(make_uint4(lv.x, lv.y, lv.z, lv.w), f); } float q = 0.f;
#pragma unroll
        for (int e = 0; e < 8; ++e) q += f[e] * f[e];
        const float rs = rsqrtf(wsum(q) * (1.0f / 512.0f) + 1e-6f);
#pragma unroll
        for (int e = 0; e < 8; ++e) f[e] = f[e] * rs * og8[e];
        *(uint4*)(MIX + tok * DM + 768 + lane * 8) = pack8(f); }
    __syncthreads();
}

struct ScanRegs { u32x4 zr, zrp, zk, zkp, zv, zvp, aq, eq; };
constexpr int SSTEP = 392;
DI float rsum8(float x) { x += dppf<0xB1>(x); x += dppf<0x4E>(x); x += dppf<0x141>(x); return x; }
DI void scan_load(ScanRegs& R, const bf16_t* Z, const bf16_t* RWA, const bf16_t* RWD, int b, int h, int t, int l8) {
    const size_t tok = (size_t)b * SEQ + t; const bf16_t* zr = Z + tok * NINP + 3328 + h * 64 + l8 * 8;
    const bf16_t* zq = t > 0 ? zr - NINP : zr;
    R.zr = *(const u32x4*)(zr); R.zk = *(const u32x4*)(zr + 768); R.zv = *(const u32x4*)(zr + 1536);
    const unsigned msk = t > 0 ? 0xffffffffu : 0u;
    R.zrp = *(const u32x4*)(zq) & msk; R.zkp = *(const u32x4*)(zq + 768) & msk; R.zvp = *(const u32x4*)(zq + 1536) & msk;
    R.aq = *(const u32x4*)(RWA + tok * 768 + h * 64 + l8 * 8); R.eq = *(const u32x4*)(RWD + tok * 768 + h * 64 + l8 * 8);
}
DI void unpack8v(const u32x4 w, float (&f)[8]) { f[0] = bflo(w.x); f[1] = bfhi(w.x); f[2] = bflo(w.y); f[3] = bfhi(w.y); f[4] = bflo(w.z); f[5] = bfhi(w.z); f[6] = bflo(w.w); f[7] = bfhi(w.w); }
DI void lerp8(const u32x4 c, const u32x4 pv, const float* mu, float (&o)[8]) {
    float cc[8], pp[8]; unpack8v(c, cc); unpack8v(pv, pp);
#pragma unroll
    for (int e = 0; e < 8; ++e) o[e] = cc[e] + (pp[e] - cc[e]) * mu[e];
}
DI void phase_scan(const int ctx_tid, const int ctx_bid, const int ctx_g, const PView& p, int l, int sb, LAS unsigned char* lds) {
#ifdef NO_SCAN
    return;
#endif
    unsigned char* ws = p.ws; const bf16_t* Z = (const bf16_t*)(ws + OFF_Z); const bf16_t* RWA = (const bf16_t*)(ws + OFF_RWA); const bf16_t* RWD = (const bf16_t*)(ws + OFF_RWD);
    float* YR = (float*)(ws + OFF_YR); float* BON = (float*)(ws + OFF_BON);
    const int tid = ctx_tid, w = tid >> 6, lane = tid & 63, l8 = lane & 7;
    const int part = sb & 1, bh = sb >> 1, b = bh / 12, h = bh % 12;
    const int row0 = part * 32, nscan = 4;
    const bool scanner = w < nscan;
    const int half = part;
    const int ts = (tid & 255) >> 3;
    const int row = row0 + (w & 3) * 8 + (lane >> 3);
    LAS float* buf = (LAS float*)lds;
    if (w >= 4) {
        const float* mub = p.in[12] + (size_t)l * 2688 + h * 64 + l8 * 8;
        float mur[8], muk[8], muv[8], kk8[8], ka8[8], rk8[8];
#pragma unroll
        for (int e = 0; e < 8; ++e) { mur[e] = mub[e]; muk[e] = mub[768 + e]; muv[e] = mub[1536 + e];
            kk8[e] = p.in[18][(size_t)l * 768 + h * 64 + l8 * 8 + e]; ka8[e] = p.in[19][(size_t)l * 768 + h * 64 + l8 * 8 + e]; rk8[e] = p.in[20][(size_t)l * 768 + h * 64 + l8 * 8 + e]; }
        ScanRegs R;
        auto process = [&](int stage, int t) {
            float r8[8], k8[8], v8[8]; lerp8(R.zr, R.zrp, mur, r8); lerp8(R.zk, R.zkp, muk, k8); lerp8(R.zv, R.zvp, muv, v8);
            float a8[8], w8[8]; unpack8v(R.aq, a8); unpack8v(R.eq, w8);
#pragma unroll
            for (int e = 0; e < 8; ++e) w8[e] = __expf(-w8[e]);
            float kkv[8], n2 = 0.f;
#pragma unroll
            for (int e = 0; e < 8; ++e) { kkv[e] = k8[e] * kk8[e]; n2 += kkv[e] * kkv[e]; }
            n2 = rsum8(n2); const float inv = 1.0f / fmaxf(sqrtf(n2), 1e-12f);
            float kp[8], bb[8], nk[8], bon = 0.f;
#pragma unroll
            for (int e = 0; e < 8; ++e) { const float kh = kkv[e] * inv; nk[e] = -kh; bb[e] = kh * a8[e]; kp[e] = k8[e] * (1.0f + (a8[e] - 1.0f) * ka8[e]);
                bon += r8[e] * kp[e] * rk8[e]; }
            bon = rsum8(bon);
            LAS float* d = buf + (stage * 32 + ts) * SSTEP + l8 * 8;
#pragma unroll
            for (int q = 0; q < 2; ++q) {
                *(LAS f32x4*)(d + q * 4) = (f32x4){w8[q * 4], w8[q * 4 + 1], w8[q * 4 + 2], w8[q * 4 + 3]}; *(LAS f32x4*)(d + 64 + q * 4) = (f32x4){nk[q * 4], nk[q * 4 + 1], nk[q * 4 + 2], nk[q * 4 + 3]};
                *(LAS f32x4*)(d + 128 + q * 4) = (f32x4){bb[q * 4], bb[q * 4 + 1], bb[q * 4 + 2], bb[q * 4 + 3]}; *(LAS f32x4*)(d + 192 + q * 4) = (f32x4){kp[q * 4], kp[q * 4 + 1], kp[q * 4 + 2], kp[q * 4 + 3]};
                *(LAS f32x4*)(d + 256 + q * 4) = (f32x4){r8[q * 4], r8[q * 4 + 1], r8[q * 4 + 2], r8[q * 4 + 3]}; *(LAS f32x4*)(d + 320 + q * 4) = (f32x4){v8[q * 4], v8[q * 4 + 1], v8[q * 4 + 2], v8[q * 4 + 3]}; }
            if (l8 == 0 && half == 0) BON[((size_t)b * SEQ + t) * 12 + h] = bon;
        };
        scan_load(R, Z, RWA, RWD, b, h, ts, l8);
        process(0, ts);
        scan_load(R, Z, RWA, RWD, b, h, 32 + ts, l8);
        __syncthreads();
        for (int ci = 0; ci < SEQ / 32; ++ci) {
            if (ci + 1 < SEQ / 32) { process((ci + 1) & 1, (ci + 1) * 32 + ts); if (ci + 2 < SEQ / 32) scan_load(R, Z, RWA, RWD, b, h, (ci + 2) * 32 + ts, l8); }
            __syncthreads();
        }
    } else if (!scanner) {
        __syncthreads();
        for (int ci = 0; ci < SEQ / 32; ++ci) __syncthreads();
    } else {
        __builtin_amdgcn_s_setprio(3);
        f32x2 S[4];
#pragma unroll
        for (int i = 0; i < 4; ++i) S[i] = (f32x2){0.f, 0.f};
        __syncthreads();
        for (int ci = 0; ci < SEQ / 32; ++ci) {
            const int t0 = ci * 32;
            const LAS float* sbuf = buf + (ci & 1) * 32 * SSTEP;
            float yk[4];
            const LAS float* d0 = sbuf + l8 * 8;
            f32x4 W0 = *(const LAS f32x4*)(d0), W1 = *(const LAS f32x4*)(d0 + 4), N0 = *(const LAS f32x4*)(d0 + 64), N1 = *(const LAS f32x4*)(d0 + 68), B0 = *(const LAS f32x4*)(d0 + 128), B1 = *(const LAS f32x4*)(d0 + 132),
                  K0 = *(const LAS f32x4*)(d0 + 192), K1 = *(const LAS f32x4*)(d0 + 196), R0 = *(const LAS f32x4*)(d0 + 256), R1 = *(const LAS f32x4*)(d0 + 260);
            float vv = sbuf[320 + row];
            const bool b0 = (l8 & 1) != 0, b1 = (l8 & 2) != 0, b2 = (l8 & 4) != 0;
#pragma unroll
            for (int hh = 0; hh < 4; ++hh) {
                float pp[8];
#pragma unroll
                for (int s8 = 0; s8 < 8; ++s8) {
                    const int s = hh * 8 + s8; const int sn = s < 31 ? s + 1 : 31;
                    const LAS float* dn = sbuf + sn * SSTEP + l8 * 8;
                    const f32x4 nW0 = *(const LAS f32x4*)(dn), nW1 = *(const LAS f32x4*)(dn + 4), nN0 = *(const LAS f32x4*)(dn + 64), nN1 = *(const LAS f32x4*)(dn + 68), nB0 = *(const LAS f32x4*)(dn + 128), nB1 = *(const LAS f32x4*)(dn + 132),
                                nK0 = *(const LAS f32x4*)(dn + 192), nK1 = *(const LAS f32x4*)(dn + 196), nR0 = *(const LAS f32x4*)(dn + 256), nR1 = *(const LAS f32x4*)(dn + 260);
                    const float nvv = sbuf[sn * SSTEP + 320 + row];
                    const f32x2 d1v = (S[0] * (f32x2){N0.x, N0.y} + S[1] * (f32x2){N0.z, N0.w}) + (S[2] * (f32x2){N1.x, N1.y} + S[3] * (f32x2){N1.z, N1.w});
                    const float sa = rsum8(d1v.x + d1v.y);
                    const f32x2 sa2 = {sa, sa}, vv2 = {vv, vv};
                    S[0] = S[0] * (f32x2){W0.x, W0.y} + (sa2 * (f32x2){B0.x, B0.y} + vv2 * (f32x2){K0.x, K0.y});
                    S[1] = S[1] * (f32x2){W0.z, W0.w} + (sa2 * (f32x2){B0.z, B0.w} + vv2 * (f32x2){K0.z, K0.w});
                    S[2] = S[2] * (f32x2){W1.x, W1.y} + (sa2 * (f32x2){B1.x, B1.y} + vv2 * (f32x2){K1.x, K1.y});
                    S[3] = S[3] * (f32x2){W1.z, W1.w} + (sa2 * (f32x2){B1.z, B1.w} + vv2 * (f32x2){K1.z, K1.w});
                    const f32x2 yv = (S[0] * (f32x2){R0.x, R0.y} + S[1] * (f32x2){R0.z, R0.w}) + (S[2] * (f32x2){R1.x, R1.y} + S[3] * (f32x2){R1.z, R1.w});
                    pp[s8] = yv.x + yv.y;
                    W0 = nW0; W1 = nW1; N0 = nN0; N1 = nN1; B0 = nB0; B1 = nB1; K0 = nK0; K1 = nK1; R0 = nR0; R1 = nR1; vv = nvv;
                }
                float q4[4], r2[2];
#pragma unroll
                for (int i = 0; i < 4; ++i) q4[i] = (b0 ? pp[2 * i + 1] : pp[2 * i]) + dppf<0xB1>(b0 ? pp[2 * i] : pp[2 * i + 1]);
#pragma unroll
                for (int i = 0; i < 2; ++i) r2[i] = (b1 ? q4[2 * i + 1] : q4[2 * i]) + dppf<0x4E>(b1 ? q4[2 * i] : q4[2 * i + 1]);
                { const float keep = b2 ? r2[1] : r2[0], send = b2 ? r2[0] : r2[1];
                  int xr = __builtin_amdgcn_update_dpp(0, __float_as_int(send), 0x104, 0xF, 0x5, false);
                  xr = __builtin_amdgcn_update_dpp(xr, __float_as_int(send), 0x114, 0xF, 0xA, false);
                  yk[hh] = keep + __int_as_float(xr); }
            }
            { float* yo = YR + ((size_t)b * SEQ + t0 + l8) * 768 + h * 64 + row;
#pragma unroll
              for (int hh = 0; hh < 4; ++hh) yo[(size_t)hh * 8 * 768] = yk[hh]; }
            __syncthreads();
        }
        __builtin_amdgcn_s_setprio(0);
    }
}

template <int PART>
DI void phase_mixpost(const int ctx_tid, const int ctx_bid, const int ctx_g, const PView& p, int l, int gw, int nw, const bool xm = false) {
#ifdef NO_POST
    return;
#endif
    unsigned char* ws = p.ws; const bf16_t* Z = (const bf16_t*)(ws + OFF_Z); const bf16_t* AP = (const bf16_t*)(ws + OFF_AP); const float* LSE = (const float*)(ws + OFF_LSE);
    const bf16_t* RWG = (const bf16_t*)(ws + OFF_RWG); const float* YR = (const float*)(ws + OFF_YR); const float* BON = (const float*)(ws + OFF_BON); bf16_t* MIX = (bf16_t*)(ws + OFF_MIX);
    const float* aog = p.in[7] + (size_t)l * 768; const float* muv = p.in[12] + (size_t)l * 2688 + 1536; const float* lg = p.in[21] + (size_t)l * 768; const float* lb = p.in[22] + (size_t)l * 768;
    const int lane = ctx_tid & 63;
    const int hq = lane >> 4, dq = (lane & 15) * 4;
    f32x4 g_a[3], g_mu[3], g_lg[3], g_lb[3];
#pragma unroll
    for (int i = 0; i < 3; ++i) { const int c = (hq + 4 * i) * 64 + dq; g_a[i] = *(const f32x4*)(aog + c); g_mu[i] = *(const f32x4*)(muv + c); g_lg[i] = *(const f32x4*)(lg + c); g_lb[i] = *(const f32x4*)(lb + c); }
    for (int ti = 0; ; ++ti) { const int t = xm ? xcd_row(ctx_bid, __builtin_amdgcn_readfirstlane(ctx_tid >> 6), ctx_g, ti) : gw + ti * nw; if (t >= T) break;
        const bool hasp = (t % SEQ) != 0;
        if (PART == 1) {
            u32x2 ap[3][3]; float lse[3][3];
#pragma unroll
            for (int i = 0; i < 3; ++i) { const int j = hq + 4 * i, c = j * 64 + dq;
#pragma unroll
                for (int q = 0; q < 3; ++q) { lse[q][i] = __builtin_nontemporal_load(LSE + ((size_t)q * T + t) * 12 + j); ap[q][i] = __builtin_nontemporal_load((const u32x2*)(AP + ((size_t)q * T + t) * 768 + c)); } }
            f32x4 oa[3]; float ss = 0.f;
#pragma unroll
            for (int i = 0; i < 3; ++i) {
                const float l0 = lse[0][i], l1 = lse[1][i], l2 = lse[2][i];
                const float mx = fmaxf(l0, fmaxf(l1, l2)); const float e0 = __expf(l0 - mx), e1 = __expf(l1 - mx), e2 = __expf(l2 - mx); const float inv = 1.0f / (e0 + e1 + e2);
                const f32x4 a0 = {bflo(ap[0][i].x), bfhi(ap[0][i].x), bflo(ap[0][i].y), bfhi(ap[0][i].y)}, a1 = {bflo(ap[1][i].x), bfhi(ap[1][i].x), bflo(ap[1][i].y), bfhi(ap[1][i].y)}, a2 = {bflo(ap[2][i].x), bfhi(ap[2][i].x), bflo(ap[2][i].y), bfhi(ap[2][i].y)};
                oa[i] = (a0 * e0 + a1 * e1 + a2 * e2) * inv; ss += oa[i][0] * oa[i][0] + oa[i][1] * oa[i][1] + oa[i][2] * oa[i][2] + oa[i][3] * oa[i][3]; }
            const float rs = rsqrtf(wsum(ss) * (1.0f / 768.0f) + 1e-6f);
#pragma unroll
            for (int i = 0; i < 3; ++i) { const int c = (hq + 4 * i) * 64 + dq; const f32x4 o1 = oa[i] * rs * g_a[i];
                u32x2 w1; w1.x = pack2(o1[0], o1[1]); w1.y = pack2(o1[2], o1[3]); *(u32x2*)(MIX + (size_t)t * DM + c) = w1; }
        } else {
            u32x2 rg[3], zc[3], zp[3]; float bon[3]; f32x4 yr[3];
#pragma unroll
            for (int i = 0; i < 3; ++i) { const int j = hq + 4 * i, c = j * 64 + dq;
                bon[i] = __builtin_nontemporal_load(BON + (size_t)t * 12 + j); yr[i] = __builtin_nontemporal_load((const f32x4*)(YR + (size_t)t * 768 + c)); rg[i] = __builtin_nontemporal_load((const u32x2*)(RWG + (size_t)t * 768 + c));
                zc[i] = __builtin_nontemporal_load((const u32x2*)(Z + (size_t)t * NINP + 4864 + c)); zp[i] = hasp ? __builtin_nontemporal_load((const u32x2*)(Z + (size_t)(t - 1) * NINP + 4864 + c)) : (u32x2){0u, 0u}; }
#pragma unroll
            for (int i = 0; i < 3; ++i) {
                const f32x4 y = yr[i]; const float mean = rsum16((y[0] + y[1]) + (y[2] + y[3])) * (1.0f / 64.0f); const f32x4 yc = y - mean;
                const float var = rsum16((yc[0] * yc[0] + yc[1] * yc[1]) + (yc[2] * yc[2] + yc[3] * yc[3])) * (1.0f / 64.0f);
                f32x4 yn = yc * rsqrtf(var + 64e-5f) * g_lg[i] + g_lb[i];
                const f32x4 vc = {bflo(zc[i].x), bfhi(zc[i].x), bflo(zc[i].y), bfhi(zc[i].y)}, vp = {bflo(zp[i].x), bfhi(zp[i].x), bflo(zp[i].y), bfhi(zp[i].y)};
                const f32x4 vs = vc + (vp - vc) * g_mu[i];
                yn += vs * bon[i];
                const f32x4 gg = {bflo(rg[i].x), bfhi(rg[i].x), bflo(rg[i].y), bfhi(rg[i].y)};
                const f32x4 o2 = yn * gg; const int c = (hq + 4 * i) * 64 + dq;
                u32x2 w2; w2.x = pack2(o2[0], o2[1]); w2.y = pack2(o2[2], o2[3]); *(u32x2*)(MIX + (size_t)t * DM + 1280 + c) = w2; }
        }
    }
}

DI void phase_convfix(const int ctx_tid, const int ctx_bid, const int ctx_g, const PView& p, int l) {
#ifdef NO_CONV
    return;
#endif
    unsigned char* ws = p.ws; bf16_t* ACT = (bf16_t*)(ws + OFF_ACT); const float* HALO = (const float*)(ws + OFF_HALO); const float* PART = (const float*)(ws + OFF_PART);
    const float* cw = p.in[27] + (size_t)l * 3 * NUP;
    const int gt = ctx_bid * 512 + ctx_tid, ng = ctx_g * 512;
    for (int it = gt; it < (T / 128) * 2 * (DFF / 4); it += ng) {
        const int c = (it % (DFF / 4)) * 4, gr = it / (DFF / 4), r = gr & 1, g = gr >> 1;
        const int colp = (c >> 7) * 256 + (c & 127);
        f32x4 pg = *(const f32x4*)(PART + ((size_t)g * 2 + r) * NUP + colp), pv = *(const f32x4*)(PART + ((size_t)g * 2 + r) * NUP + colp + 128);
        if ((g * 128) % SEQ != 0) {
            const f32x4 g1 = *(const f32x4*)(HALO + ((size_t)(g - 1) * 2 + 1) * NUP + colp), v1 = *(const f32x4*)(HALO + ((size_t)(g - 1) * 2 + 1) * NUP + colp + 128);
            const f32x4 g2 = *(const f32x4*)(HALO + ((size_t)(g - 1) * 2) * NUP + colp), v2 = *(const f32x4*)(HALO + ((size_t)(g - 1) * 2) * NUP + colp + 128);
            const f32x4 wg0 = *(const f32x4*)(cw + c), wg1 = *(const f32x4*)(cw + NUP + c), wv0 = *(const f32x4*)(cw + DFF + c), wv1 = *(const f32x4*)(cw + NUP + DFF + c);
            if (r == 0) { pg += wg1 * g1 + wg0 * g2; pv += wv1 * v1 + wv0 * v2; } else { pg += wg0 * g1; pv += wv0 * v1; }
        }
        uint2 w; w.x = pack2(gelu_t(pg[0]) * pv[0], gelu_t(pg[1]) * pv[1]); w.y = pack2(gelu_t(pg[2]) * pv[2], gelu_t(pg[3]) * pv[3]);
        *(uint2*)(ACT + (size_t)(g * 128 + r) * DFF + c) = w;
    }
}

DI void run_gemm_bf16(const int ctx_tid, const int ctx_bid, const int ctx_g, LAS unsigned char* lds, const bf16_t* A, const bf16_t* Bt, int M, int N, int K, bf16_t* O, int ldc, int G, int c) {
#ifdef NO_GEMM
    return;
#endif
    pg8::Gemm g{A, Bt, M, N, K}; pg8::StaticOrder S; S.init(M, N, G, c); pg8::EpiBf16 E{O, ldc};
    pg8::gemm_phase<pg8::EpiBf16, pg8::StaticOrder, false>(ctx_tid, lds, g, S, E, nullptr);
}
DI void run_gemm_f32(const int ctx_tid, const int ctx_bid, const int ctx_g, LAS unsigned char* lds, const bf16_t* A, const bf16_t* Bt, int M, int N, int K, float* C, int ldc, int G, int c) {
#ifdef NO_GEMM
    return;
#endif
    pg8::Gemm g{A, Bt, M, N, K}; pg8::StaticOrder S; S.init(M, N, G, c); pg8::EpiF32 E{C, ldc, nullptr};
    pg8::gemm_phase<pg8::EpiF32, pg8::StaticOrder, false>(ctx_tid, lds, g, S, E, nullptr);
}

DI void run_gemm_conv(const int ctx_tid, const int ctx_bid, const int ctx_g, LAS unsigned char* lds, const bf16_t* A, const bf16_t* Bt, int M, int N, int K, bf16_t* ACT, const float* cw, const float* cb, float* HALO, float* PARTB, int G, int c) {
#ifdef NO_GEMM
    return;
#endif
    pg8::Gemm g{A, Bt, M, N, K}; pg8::StaticOrder S; S.init(M, N, G, c); pg8::EpiConv E{ACT, cw, cb, HALO, PARTB, DFF, NUP};
    pg8::gemm_phase<pg8::EpiConv, pg8::StaticOrder, false>(ctx_tid, lds, g, S, E, nullptr);
}
#define XB_TMO      128
#define XB_XCNT(j)  (256  + 64 * (j))
#define XB_XSUB(j)  (1280 + 64 * (j))
#define XB_XGEN(j)  (2304 + 64 * (j))
#define XB_TOP      3328
#define XB_TOPGEN   3392
#define XCD_BAR_WORDS 3456
#define XB_SPIN_CAP (1u << 18)

__device__ __forceinline__ unsigned xb_ld(unsigned* p)              { return __hip_atomic_load(p, __ATOMIC_RELAXED, __HIP_MEMORY_SCOPE_AGENT); }
__device__ __forceinline__ unsigned xb_add(unsigned* p, unsigned v) { return __hip_atomic_fetch_add(p, v, __ATOMIC_RELAXED, __HIP_MEMORY_SCOPE_AGENT); }
__device__ __forceinline__ unsigned xb_xcc_id() { return (unsigned)__builtin_amdgcn_s_getreg((3 << 11) | 20) & 0xFu; }
#define XB_SPIN(cond, bar) do { unsigned _sp = 0; while (cond) { __builtin_amdgcn_s_sleep(1); \
    if ((++_sp & 255u) == 0u) { if (xb_ld(&(bar)[XB_TMO])) break; if (_sp > XB_SPIN_CAP) { atomicAdd(&(bar)[XB_TMO], 1u); break; } } } } while (0)
struct XcdBarrier {
    unsigned* bar; unsigned x;
    volatile LAS unsigned* st;
};

__device__ __forceinline__ XcdBarrier xcd_barrier_post(unsigned* bar, volatile LAS unsigned* st, const bool tid0) {
    XcdBarrier b; b.bar = bar; b.x = xb_xcc_id(); b.st = st;
    if (tid0) (void)xb_add(&bar[XB_XCNT(b.x)], 1u);
    return b;
}
__device__ __forceinline__ void xcd_barrier_complete(unsigned* bar, unsigned x, unsigned& nloc, unsigned& nx) {
    const unsigned G = gridDim.x * gridDim.y * gridDim.z;
    unsigned sum, cnt, mine, sp = 0u;
    for (;;) {
        sum = 0u; cnt = 0u; mine = 0u;
#pragma unroll
        for (unsigned j = 0; j < 16; ++j) { const unsigned c = xb_ld(&bar[XB_XCNT(j)]); sum += c; cnt += (c > 0u) ? 1u : 0u; mine = (j == x) ? c : mine; }
        if (sum == G) break;
        __builtin_amdgcn_s_sleep(1);
        if ((++sp & 255u) == 0u) { if (xb_ld(&bar[XB_TMO])) break; if (sp > XB_SPIN_CAP) { atomicAdd(&bar[XB_TMO], 1u); break; } }
    }
    nloc = mine > 0u ? mine : 1u; nx = cnt > 0u ? cnt : 1u;
}

__device__ __forceinline__ void xcd_barrier(const XcdBarrier& b, const bool tid0) {
    asm volatile("s_waitcnt vmcnt(0)" ::: "memory");
    __syncthreads();
    if (tid0) {
        unsigned* bar = b.bar;
        __builtin_amdgcn_s_waitcnt(0);
        unsigned nloc = b.st[0], nx = b.st[1];
        if (nloc == 0u) { xcd_barrier_complete(bar, b.x, nloc, nx); b.st[0] = nloc; b.st[1] = nx; }
        const unsigned old = xb_add(&bar[XB_XSUB(b.x)], 1u);
        const unsigned gen = old / nloc;
        if (old + 1u == (gen + 1u) * nloc) {
            __builtin_amdgcn_fence(__ATOMIC_RELEASE, "agent");
            asm volatile("s_waitcnt vmcnt(0)" ::: "memory");
            const unsigned og = xb_add(&bar[XB_TOP], 1u);
            const unsigned tg = og / nx;
            if (og + 1u == (tg + 1u) * nx) xb_add(&bar[XB_TOPGEN], 1u);
            else XB_SPIN(xb_ld(&bar[XB_TOPGEN]) == tg, bar);
            __builtin_amdgcn_fence(__ATOMIC_ACQUIRE, "agent");
            xb_add(&bar[XB_XGEN(b.x)], 1u);
            asm volatile("s_waitcnt vmcnt(0)" ::: "memory");
        } else {
            XB_SPIN(xb_ld(&bar[XB_XGEN(b.x)]) == gen, bar);
            __builtin_amdgcn_fence(__ATOMIC_ACQUIRE, "agent");
            asm volatile("s_waitcnt vmcnt(0)" ::: "memory");
        }
    }
    __syncthreads();
}

DI void sub_barrier(unsigned* cnt, unsigned target, const bool tid0) {
    asm volatile("s_waitcnt vmcnt(0)" ::: "memory");
    __syncthreads();
    if (tid0) {
        __builtin_amdgcn_fence(__ATOMIC_RELEASE, "agent"); asm volatile("s_waitcnt vmcnt(0)" ::: "memory");
        (void)__hip_atomic_fetch_add(cnt, 1u, __ATOMIC_RELAXED, __HIP_MEMORY_SCOPE_AGENT);
        unsigned sp = 0;
        while (__hip_atomic_load(cnt, __ATOMIC_RELAXED, __HIP_MEMORY_SCOPE_AGENT) < target) { __builtin_amdgcn_s_sleep(2); if (++sp > (1u << 22)) break; }
        __builtin_amdgcn_fence(__ATOMIC_ACQUIRE, "agent"); asm volatile("s_waitcnt vmcnt(0)" ::: "memory");
    }
    __syncthreads();
}
__global__ __launch_bounds__(512, 2) void mega(Params pin, int ph_lo, int ph_hi) {
    extern __shared__ __attribute__((aligned(16))) unsigned char shm[];
    LAS unsigned char* lds = (LAS unsigned char*)shm;
    const int gridDim_x0 = (int)gridDim.x;
    const int wave_sgpr = __builtin_amdgcn_readfirstlane((int)(threadIdx.x >> 6));
    volatile LAS unsigned* xb_st = (volatile LAS unsigned*)(lds + LDS_BYTES - 16);
    if (threadIdx.x == 0) { xb_st[0] = 0u; xb_st[1] = 0u; xb_st[2] = 0u; xb_st[3] = 0u; }
    __syncthreads();
    XcdBarrier xb; xb.bar = (unsigned*)(pin.ws + OFF_CTL); xb.x = 0; xb.st = xb_st;
    if (ph_hi - ph_lo > 1) xb = xcd_barrier_post((unsigned*)(pin.ws + OFF_CTL), xb_st, threadIdx.x == 0);
    if (ph_lo < 0) cg::this_grid().sync();
    for (int ph = ph_lo; ph < ph_hi; ++ph) {
        if (ph == NPL && ph > ph_lo) continue;
        if (ph > ph_lo) {
            xcd_barrier(xb, wave_sgpr == 0 && (int)__builtin_amdgcn_mbcnt_hi(~0u, __builtin_amdgcn_mbcnt_lo(~0u, 0u)) == 0);
#ifdef EXTRA_SYNCS
            for (int es = 0; es < EXTRA_SYNCS; ++es) xcd_barrier(xb, wave_sgpr == 0 && (int)__builtin_amdgcn_mbcnt_hi(~0u, __builtin_amdgcn_mbcnt_lo(~0u, 0u)) == 0);
#endif
        }
        const int l = ph / NPL, lp = ph % NPL;
        const int nrep = ((REP_MASK >> lp) & 1) ? 2 : 1;
        for (int rep = 0; rep < nrep; ++rep) {
        if (rep) xcd_barrier(xb, wave_sgpr == 0 && (int)__builtin_amdgcn_mbcnt_hi(~0u, __builtin_amdgcn_mbcnt_lo(~0u, 0u)) == 0);
        size_t zero = 0; asm volatile("" : "+s"(zero));
        int wv_ = wave_sgpr; asm volatile("" : "+s"(wv_));
        int ctx_tid = wv_ * 64 + (int)__builtin_amdgcn_mbcnt_hi(~0u, __builtin_amdgcn_mbcnt_lo(~0u, 0u)); asm volatile("" : "+v"(ctx_tid));
        int ctx_bid = blockIdx.x; asm volatile("" : "+s"(ctx_bid));
        int ctx_g = (int)gridDim_x0; asm volatile("" : "+s"(ctx_g));
        const int bid = ctx_bid, G = ctx_g;
        PView p; p.in.pp = &pin; p.in.zero = zero; p.out = pin.out + zero; p.ws = pin.ws + zero;
        unsigned char* ws = p.ws; bf16_t* HB = (bf16_t*)(ws + OFF_HB);
        const float* gains = p.in[3] + (size_t)l * 6 * DM;
        int gk = 0; const bf16_t* gA = nullptr; const bf16_t* gB = nullptr; int gM = 0, gN = 0, gK = 0, gld = 0, gG = G, gc = bid; void* gO = nullptr;
        switch (lp) {
        case 0: phase_cvt(ctx_tid, ctx_bid, ctx_g, p, l, lds); break;
        case 1: gk = 1; gA = HB; gB = (const bf16_t*)(ws + OFF_WIN) + (size_t)3072 * DM; gM = T; gN = NINP - 3072; gK = DM; gO = (bf16_t*)(ws + OFF_Z) + 3072; gld = NINP; break;
        case 2: phase_rwkv_prep(ctx_tid, ctx_bid, ctx_g, p, l, lds); break;
        case 3:
            if (bid < SCAN_BLOCKS) { if (!(rep && P3_MODE == 2)) phase_scan(ctx_tid, ctx_bid, ctx_g, p, l, bid, lds); }
            else if (!(rep && P3_MODE == 1)) { gk = 1; gA = HB; gB = (const bf16_t*)(ws + OFF_WIN); gM = T; gN = 3072; gK = DM; gO = ws + OFF_Z; gld = NINP; gG = G - SCAN_BLOCKS; gc = bid - SCAN_BLOCKS; }
            break;
        case 4: phase_mixpost<2>(ctx_tid, ctx_bid, ctx_g, p, l, ctx_bid * 8 + __builtin_amdgcn_readfirstlane(ctx_tid >> 6), ctx_g * 8, true); break;
        case 5: gk = 1; gA = (const bf16_t*)(ws + OFF_MIX); gB = (const bf16_t*)(ws + OFF_WOUT); gM = T; gN = DM; gK = DM; gO = ws + OFF_Y; gld = DM; break;
        case 6: if (l == 0) phase_resid<true, false>(ctx_tid, ctx_bid, ctx_g, (const bf16_t*)(ws + OFF_Y), p.in[0], ws + OFF_XB, gains + DM, gains + 2 * DM, HB);
                else phase_resid<false, false>(ctx_tid, ctx_bid, ctx_g, (const bf16_t*)(ws + OFF_Y), ws + OFF_XB, ws + OFF_XB, gains + DM, gains + 2 * DM, HB);
                break;
        case 7: { const int nh = G / 2;
            if (bid < nh) { gk = 1; gA = HB; gB = (const bf16_t*)(ws + OFF_WQ); gM = T; gN = 512; gK = DM; gO = ws + OFF_Q; gld = 512; gG = nh; gc = bid; }
            else { gk = 1; gA = (const bf16_t*)(ws + OFF_MEMN); gB = (const bf16_t*)(ws + OFF_WKV); gM = 1024; gN = 1024; gK = DM; gO = ws + OFF_KV; gld = 1024; gG = G - nh; gc = bid - nh; } } break;
        case 8: { int last_kv = -1; for (int it = bid; it < 512; it += G) { cross_item(ctx_tid, ctx_bid, ctx_g, p, it, (it & 15) != last_kv, lds); last_kv = it & 15; } } break;
        case 9: gk = 1; gA = (const bf16_t*)(ws + OFF_O); gB = (const bf16_t*)(ws + OFF_WO); gM = T; gN = DM; gK = 512; gO = ws + OFF_Y; gld = DM; break;
        case 10: phase_resid<false, false>(ctx_tid, ctx_bid, ctx_g, (const bf16_t*)(ws + OFF_Y), ws + OFF_XB, ws + OFF_XB, gains + 3 * DM, gains + 4 * DM, HB); break;
        case 11: gk = 3; gA = HB; gB = (const bf16_t*)(ws + OFF_WUP); gM = T; gN = NUP; gK = DM; gO = ws + OFF_ACT; break;
        case 12: phase_convfix(ctx_tid, ctx_bid, ctx_g, p, l); break;
        case 13: gk = 1; gA = (const bf16_t*)(ws + OFF_ACT); gB = (const bf16_t*)(ws + OFF_WDN); gM = T; gN = DM; gK = DFF; gO = ws + OFF_Y; gld = DM; break;
        case 14: if (l + 1 < 2) phase_resid<false, false>(ctx_tid, ctx_bid, ctx_g, (const bf16_t*)(ws + OFF_Y), ws + OFF_XB, ws + OFF_XB, gains + 5 * DM, gains + 6 * DM, HB);
                 else phase_resid<false, true>(ctx_tid, ctx_bid, ctx_g, (const bf16_t*)(ws + OFF_Y), ws + OFF_XB, p.out, gains + 5 * DM, nullptr, HB);
                 if (l == 0 && ph_hi - ph_lo > 1) phase_cvt(ctx_tid, ctx_bid, ctx_g, p, 1, lds);
                 break;
        }
        if (gk == 1) run_gemm_bf16(ctx_tid, ctx_bid, ctx_g, lds, gA, gB, gM, gN, gK, (bf16_t*)gO, gld, gG, gc);
        else if (gk == 3) run_gemm_conv(ctx_tid, ctx_bid, ctx_g, lds, gA, gB, gM, gN, gK, (bf16_t*)gO, p.in[27] + (size_t)l * 3 * NUP, p.in[28] + (size_t)l * NUP, (float*)(ws + OFF_HALO), (float*)(ws + OFF_PART), gG, gc);
        if (lp == 3 && bid >= SCAN_BLOCKS && !(rep && P3_MODE == 1)) {
            const int nb = G - SCAN_BLOCKS; int it = bid - SCAN_BLOCKS;
            sub_barrier((unsigned*)(ws + OFF_CTL) + 3584 + 64 * (l * 2 + rep), (unsigned)nb, ctx_tid == 0);
#ifndef NO_SGU
            for (; it < 128; it += nb) sgu_item(ctx_tid, ctx_bid, ctx_g, p, l, it, lds);
#endif
#ifndef NO_DIL
            u32x4 kq[4]; u32x2 vq[8]; bf16x8 qc[2], qn[2]; float btv; int item = it - 128;
            dil_load(ctx_tid, p, item < 4608 ? item : 4607, kq, vq, qc, btv);
            for (; item < 4608; item += nb) {
                dil_stage(ctx_tid, p, item, kq, vq, btv, lds); __syncthreads();
                dil_load(ctx_tid, p, item + nb < 4608 ? item + nb : 4607, kq, vq, qn, btv);
                dil_compute(ctx_tid, ctx_bid, ctx_g, p, item, qc, lds); __syncthreads();
                qc[0] = qn[0]; qc[1] = qn[1]; }
#endif
            sub_barrier((unsigned*)(ws + OFF_CTL) + 3840 + 64 * (l * 2 + rep), (unsigned)nb, ctx_tid == 0);
            phase_mixpost<1>(ctx_tid, ctx_bid, ctx_g, p, l, (bid - SCAN_BLOCKS) * 8 + __builtin_amdgcn_readfirstlane(ctx_tid >> 6), nb * 8);
        }
        }
    }
}

#ifndef MK_SINGLE
#define MK_SINGLE 1
#endif
extern "C" void kernel_launch(void* const* d_in, const int* in_sizes, int n_in, void* d_out, int out_size, void* d_ws, size_t ws_size, hipStream_t stream) {
    (void)in_sizes; (void)out_size;
    if (n_in < 30 || ws_size < WS_NEED) { fprintf(stderr, "kernel_launch: bad arguments (n_in %d, ws %zu < %zu)\n", n_in, ws_size, (size_t)WS_NEED); return; }
    Params p{};
    for (int i = 0; i < 30; ++i) p.in[i] = (const float*)d_in[i];
    p.out = (float*)d_out; p.ws = (unsigned char*)d_ws;
    hipFuncSetAttribute((const void*)mega, hipFuncAttributeMaxDynamicSharedMemorySize, LDS_BYTES);
    int dev = 0, cus = 0, per_cu = 0;
    hipGetDevice(&dev); hipDeviceGetAttribute(&cus, hipDeviceAttributeMultiprocessorCount, dev);
    hipOccupancyMaxActiveBlocksPerMultiprocessor(&per_cu, mega, 512, LDS_BYTES);
    if (per_cu < 1) per_cu = 1;
    int grid = cus * per_cu; if (grid > 256) grid = 256; if (grid < 128) grid = 128;
    if (hipMemsetAsync((unsigned char*)d_ws + OFF_CTL, 0, CTL_BYTES, stream) != hipSuccess) { fprintf(stderr, "kernel_launch: memset of the barrier words failed\n"); return; }
#if MK_SINGLE
    int lo = 0, hi = 2 * NPL; void* args[] = {&p, &lo, &hi};
    hipError_t e = hipLaunchCooperativeKernel((void*)mega, dim3(grid), dim3(512), args, LDS_BYTES, stream);
    if (e != hipSuccess) fprintf(stderr, "cooperative launch failed: %s (grid %d)\n", hipGetErrorString(e), grid);
#else
    for (int ph = 0; ph < 2 * NPL; ++ph) hipLaunchKernelGGL(mega, dim3(grid), dim3(512), LDS_BYTES, stream, p, ph, ph + 1);
#endif
}
```
